# Optimizing an MI355X kernel written in HIP

```python
import math
import jax, jax.numpy as jnp
from jax import lax
import numpy as np

D_MODEL = 2048
BATCH = 2
SEQ = 8192
DEPTH = 2

GRID_W = 64
CTX_LEN = 256

GM_HEADS = 4
GM_HEAD_DIM = 128
GM_WIDTH = GM_HEADS * GM_HEAD_DIM
GM_CHUNK = 128
SSM_HEADS = 8
SSM_HEAD_DIM = 64
SSM_INNER = SSM_HEADS * SSM_HEAD_DIM
SSM_GROUPS = 2
SSM_STATE = 128
SSM_CONV = 5
SSM_CHUNK = 128
DT_MIN = 1e-3
DT_MAX = 1e-1
MLA_HEADS = 8
QK_NOPE = 128
QK_ROPE = 64
V_DIM = 128
Q_LORA = 768
KV_LORA = 256
MLA_WIDTH = MLA_HEADS * V_DIM
ROPE_BASE = 10000.0
ATTN_BLOCK = 128

MIX_WIDTH = GM_WIDTH + SSM_INNER + MLA_WIDTH

N_EXPERTS = 64
TOP_K = 8
N_EXPERT_GROUPS = 8
TOPK_GROUPS = 4
EXPERT_FF = 512
SHARED_FF = 512
ROUTED_SCALE = 2.5
EXPERT_BLOCK = 256

DN_ALPHA = (2 * DEPTH) ** 0.25
DN_BETA = (8 * DEPTH) ** -0.25
LN_EPS = 1e-5
RMS_EPS = 1e-6

XBC_WIDTH = SSM_INNER + 2 * SSM_GROUPS * SSM_STATE
OFF_GM = 0
OFF_Q = OFF_GM + 2 * GM_WIDTH
OFF_Z = OFF_Q + Q_LORA
OFF_XBC = OFF_Z + SSM_INNER
OFF_DT = OFF_XBC + XBC_WIDTH
OFF_KV = OFF_DT + 2 * SSM_HEADS
OFF_KR = OFF_KV + KV_LORA
IN_WIDTH = OFF_KR + QK_ROPE
T_DT = OFF_DT - OFF_XBC
T_KV = OFF_KV - OFF_XBC
T_KR = OFF_KR - OFF_XBC

F32 = jnp.float32

kernel_name = 'hybrid_gmlp_ssd_mla_moe_diffusion_block'


def layer_norm(x, g, b):
    xf = x.astype(F32)
    mu = jnp.mean(xf, -1, keepdims=True)
    var = jnp.mean(jnp.square(xf - mu), -1, keepdims=True)
    return ((xf - mu) * lax.rsqrt(var + LN_EPS) * g.astype(F32) + b.astype(F32)).astype(x.dtype)


def rms_norm(x, g):
    xf = x.astype(F32)
    return (xf * lax.rsqrt(jnp.mean(jnp.square(xf), -1, keepdims=True) + RMS_EPS) * g.astype(F32)).astype(x.dtype)


def gated_group_rms_norm(y, z, g):
    yz = (y * jax.nn.silu(z)).astype(F32)
    grp = yz.reshape(*yz.shape[:-1], SSM_GROUPS, SSM_INNER // SSM_GROUPS)
    grp = grp * lax.rsqrt(jnp.mean(jnp.square(grp), -1, keepdims=True) + RMS_EPS)
    return (grp.reshape(yz.shape) * g.astype(F32)).astype(y.dtype)


def axial_rope_tables(n_tokens):
    rows = n_tokens // GRID_W
    row = jnp.repeat(jnp.arange(rows), GRID_W)
    col = jnp.tile(jnp.arange(GRID_W), rows)
    half = QK_ROPE // 2
    inv = 1.0 / (ROPE_BASE ** (jnp.arange(0, half, 2, dtype=F32) / half))
    ang = jnp.stack([row[:, None] * inv, col[:, None] * inv], axis=1)
    return jnp.cos(ang), jnp.sin(ang)


def apply_axial_rope(x, cos, sin):
    xs = x.astype(F32).reshape(*x.shape[:-1], 2, 2, QK_ROPE // 4)
    x1, x2 = xs[..., 0, :], xs[..., 1, :]
    out = jnp.stack([x1 * cos - x2 * sin, x2 * cos + x1 * sin], axis=-2)
    return out.reshape(x.shape).astype(x.dtype)


def split_tail(t):
    return t[..., :T_DT], t[..., T_DT:T_KV], t[..., T_KV:T_KR], t[..., T_KR:]


def chunk_gmlp(uv, p):
    uv = jax.nn.gelu(uv, approximate=False)
    u, v = uv[..., :GM_WIDTH], uv[..., GM_WIDTH:]
    v = layer_norm(v, p['g_v'], p['b_v'])
    b, l, _ = v.shape
    vc = v.reshape(b, l // GM_CHUNK, GM_CHUNK, GM_HEADS, GM_HEAD_DIM)
    s = jnp.einsum('hts,bcshd->bcthd', p['w_sp'], vc) + p['b_sp'].T[:, :, None]
    return u * s.reshape(b, l, GM_WIDTH)


def centred_conv_silu(u, w, bias):
    y = lax.conv_general_dilated(u, w[:, None, :].astype(u.dtype), window_strides=(1,),
                                 padding=[(SSM_CONV // 2, SSM_CONV // 2)],
                                 dimension_numbers=('NWC', 'WIO', 'NWC'),
                                 feature_group_count=u.shape[-1])
    return jax.nn.silu(y + bias)


def ssm_inputs(xbc, dt_raw, p):
    u = centred_conv_silu(xbc, p['conv_w'], p['conv_b'])
    lead = u.shape[:-1]
    gs = SSM_GROUPS * SSM_STATE
    rep = SSM_HEADS // SSM_GROUPS
    xh = u[..., :SSM_INNER].reshape(*lead, SSM_HEADS, SSM_HEAD_DIM)
    bm = jnp.repeat(u[..., SSM_INNER:SSM_INNER + gs].reshape(*lead, SSM_GROUPS, SSM_STATE), rep, axis=-2)
    cm = jnp.repeat(u[..., SSM_INNER + gs:].reshape(*lead, SSM_GROUPS, SSM_STATE), rep, axis=-2)
    dt = jax.nn.softplus(dt_raw.astype(F32).reshape(*lead, 2, SSM_HEADS) + p['dt_bias'].astype(F32))
    return xh, bm, cm, dt


def ssd_scan(xh, dt, a, bm, cm, h0, need_y):
    b, l, h, pd = xh.shape
    n = bm.shape[-1]
    nc, q = l // SSM_CHUNK, SSM_CHUNK
    xdt = (xh.astype(F32) * dt[..., None]).reshape(b, nc, q, h, pd)
    bc = bm.astype(F32).reshape(b, nc, q, h, n)
    acs = jnp.cumsum(jnp.moveaxis((dt * a).reshape(b, nc, q, h), 3, 1), axis=-1)
    states = jnp.einsum('bclhn,bhcl,bclhp->bchpn', bc, jnp.exp(acs[..., -1:] - acs), xdt)
    chunk_decay = jnp.exp(acs[..., -1])

    def step(carry, inp):
        st, dec = inp
        return carry * dec[..., None, None] + st, carry

    h_final, h_prev = lax.scan(step, h0.astype(F32),
                               (jnp.moveaxis(states, 1, 0), jnp.moveaxis(chunk_decay, 2, 0)))
    if not need_y:
        return None, h_final
    h_prev = jnp.moveaxis(h_prev, 0, 1)
    cc = cm.astype(F32).reshape(b, nc, q, h, n)
    seg = acs[..., :, None] - acs[..., None, :]
    mask = jnp.tril(jnp.ones((q, q), dtype=bool))
    lmat = jnp.exp(jnp.where(mask, seg, -jnp.inf))
    y = (jnp.einsum('bclhn,bcshn,bhcls,bcshp->bclhp', cc, bc, lmat, xdt)
         + jnp.einsum('bclhn,bchpn,bhcl->bclhp', cc, h_prev, jnp.exp(acs)))
    return y.reshape(b, l, h, pd).astype(xh.dtype), h_final


def bidirectional_ssd(lat, ctx_in, a_log, d_skip, ctx_out):
    a = -jnp.exp(a_log.astype(F32))
    xl, bl, cl, dl = lat
    xc, bc, cc, dc = ctx_in
    h0 = jnp.zeros((xl.shape[0], SSM_HEADS, SSM_HEAD_DIM, SSM_STATE), F32)
    rev = lambda t: jnp.flip(t, axis=1)
    yc_f, hc_f = ssd_scan(xc, dc[..., 0, :], a[0], bc, cc, h0, ctx_out)
    yc_b, hc_b = ssd_scan(rev(xc), rev(dc[..., 1, :]), a[1], rev(bc), rev(cc), h0, ctx_out)
    yl_f, _ = ssd_scan(xl, dl[..., 0, :], a[0], bl, cl, hc_f, True)
    yl_b, _ = ssd_scan(rev(xl), rev(dl[..., 1, :]), a[1], rev(bl), rev(cl), hc_b, True)
    skip = d_skip[:, None]
    y_lat = yl_f + rev(yl_b) + skip * xl
    y_ctx = (yc_f + rev(yc_b) + skip * xc) if ctx_out else None
    return y_lat, y_ctx


def mla_keys_values(ckv, kr, p, rope):
    kv = rms_norm(ckv, p['g_kv']) @ p['w_kv_b']
    kv = kv.reshape(*kv.shape[:-1], MLA_HEADS, QK_NOPE + V_DIM)
    k_nope, v = kv[..., :QK_NOPE], kv[..., QK_NOPE:]
    if rope is not None:
        kr = apply_axial_rope(kr, rope[0], rope[1])
    k = jnp.concatenate([k_nope, jnp.broadcast_to(kr[..., None, :], k_nope.shape[:-1] + (QK_ROPE,))], -1)
    return k, v


def mla_queries(cq, p, rope):
    q = rms_norm(cq, p['g_q']) @ p['w_q_b']
    q = q.reshape(*q.shape[:-1], MLA_HEADS, QK_NOPE + QK_ROPE)
    if rope is not None:
        cos, sin = rope
        q = jnp.concatenate([q[..., :QK_NOPE], apply_axial_rope(q[..., QK_NOPE:], cos[:, None], sin[:, None])], -1)
    return q


def block_attention(q, k, v):
    b, lq, h, dk = q.shape
    scale = dk ** -0.5
    qb = jnp.moveaxis(q.reshape(b, lq // ATTN_BLOCK, ATTN_BLOCK, h, dk), 1, 0)

    def one(qi):
        s = jnp.einsum('bqhd,bkhd->bhqk', qi, k).astype(F32) * scale
        pr = jax.nn.softmax(s, axis=-1).astype(v.dtype)
        return jnp.einsum('bhqk,bkhd->bqhd', pr, v)

    o = lax.map(one, qb)
    return jnp.moveaxis(o, 0, 1).reshape(b, lq, h * v.shape[-1])


def token_mixers(h, hc, p, rope, ctx_out):
    w_in = p['w_in']
    proj_l = h @ w_in
    tail_l = proj_l[..., OFF_XBC:]
    if ctx_out:
        proj_c = hc @ w_in
        tail_c = proj_c[..., OFF_XBC:]
    else:
        tail_c = hc @ w_in[:, OFF_XBC:]
    xbc_l, dt_l, ckv_l, kr_l = split_tail(tail_l)
    xbc_c, dt_c, ckv_c, kr_c = split_tail(tail_c)

    gm_l = chunk_gmlp(proj_l[..., OFF_GM:OFF_Q], p)

    y_l, y_c = bidirectional_ssd(ssm_inputs(xbc_l, dt_l, p), ssm_inputs(xbc_c, dt_c, p),
                                 p['a_log'], p['d_skip'], ctx_out)
    ssm_l = gated_group_rms_norm(y_l.reshape(*y_l.shape[:2], SSM_INNER), proj_l[..., OFF_Z:OFF_XBC], p['g_ssm'])

    k_l, v_l = mla_keys_values(ckv_l, kr_l, p, rope)
    k_c, v_c = mla_keys_values(ckv_c, kr_c, p, None)
    q_l = mla_queries(proj_l[..., OFF_Q:OFF_Z], p, rope)
    att_l = block_attention(q_l, jnp.concatenate([k_c, k_l], 1), jnp.concatenate([v_c, v_l], 1))

    mix_l = jnp.concatenate([gm_l, ssm_l, att_l], -1) @ p['w_out']
    if not ctx_out:
        return mix_l, None
    gm_c = chunk_gmlp(proj_c[..., OFF_GM:OFF_Q], p)
    ssm_c = gated_group_rms_norm(y_c.reshape(*y_c.shape[:2], SSM_INNER), proj_c[..., OFF_Z:OFF_XBC], p['g_ssm'])
    att_c = block_attention(mla_queries(proj_c[..., OFF_Q:OFF_Z], p, None), k_c, v_c)
    mix_c = jnp.concatenate([gm_c, ssm_c, att_c], -1) @ p['w_out']
    return mix_l, mix_c


def routed_experts(hf, idx, wts, w_g, w_u, w_d):
    t, k = idx.shape
    e = w_g.shape[0]
    n_assign = t * k
    flat_e = idx.reshape(-1)
    flat_tok = jnp.repeat(jnp.arange(t, dtype=jnp.int32), k)
    flat_w = wts.reshape(-1)
    order = jnp.argsort(flat_e, stable=True)
    e_sorted = flat_e[order]
    counts = jnp.bincount(flat_e, length=e)
    padded = (counts + EXPERT_BLOCK - 1) // EXPERT_BLOCK * EXPERT_BLOCK
    start = jnp.cumsum(counts) - counts
    pend = jnp.cumsum(padded)
    pstart = pend - padded
    dest = pstart[e_sorted] + jnp.arange(n_assign) - start[e_sorted]
    n_blocks = (n_assign + e * (EXPERT_BLOCK - 1) + EXPERT_BLOCK - 1) // EXPERT_BLOCK
    cap = n_blocks * EXPERT_BLOCK
    slot_tok = jnp.zeros((cap,), jnp.int32).at[dest].set(flat_tok[order])
    slot_w = jnp.zeros((cap,), hf.dtype).at[dest].set(flat_w[order])
    block_e = jnp.minimum(jnp.searchsorted(pend, jnp.arange(n_blocks) * EXPERT_BLOCK, side='right'), e - 1)

    def body(out, blk):
        tok, w, ex = blk
        xb = hf[tok]
        hb = jax.nn.silu(xb @ w_g[ex]) * (xb @ w_u[ex])
        return out.at[tok].add((hb @ w_d[ex]) * w[:, None]), None

    out, _ = lax.scan(body, jnp.zeros_like(hf),
                      (slot_tok.reshape(n_blocks, EXPERT_BLOCK), slot_w.reshape(n_blocks, EXPERT_BLOCK), block_e))
    return out


def moe_ffn(hf, p):
    t = hf.shape[0]
    scores = jax.nn.sigmoid((hf @ p['w_router']).astype(F32))
    biased = scores + p['b_router'].astype(F32)
    per = N_EXPERTS // N_EXPERT_GROUPS
    grp_score = jnp.sum(lax.top_k(biased.reshape(t, N_EXPERT_GROUPS, per), 2)[0], -1)
    _, gidx = lax.top_k(grp_score, TOPK_GROUPS)
    gmask = jnp.any(gidx[..., None] == jnp.arange(N_EXPERT_GROUPS), axis=1)
    emask = jnp.repeat(gmask, per, axis=1)
    _, eidx = lax.top_k(jnp.where(emask, biased, -jnp.inf), TOP_K)
    w = jnp.take_along_axis(scores, eidx, axis=1)
    w = (w / jnp.sum(w, -1, keepdims=True) * ROUTED_SCALE).astype(hf.dtype)
    routed = routed_experts(hf, eidx, w, p['w_e_gate'], p['w_e_up'], p['w_e_down'])
    shared = (jax.nn.silu(hf @ p['w_sh_gate']) * (hf @ p['w_sh_up'])) @ p['w_sh_down']
    return routed + shared


def trunk_layer(x, ctx, mod_l, mod_c, p, rope, last):
    b, n, d = x.shape
    h = x * (1 + mod_l[:, 1, None]) + mod_l[:, 0, None]
    hc = ctx * (1 + mod_c[1]) + mod_c[0]
    mix_l, mix_c = token_mixers(h, hc, p, rope, not last)
    x = layer_norm(DN_ALPHA * x + mod_l[:, 2, None] * mix_l, p['ln1_g'], p['ln1_b'])
    tokens = (x * (1 + mod_l[:, 4, None]) + mod_l[:, 3, None]).reshape(b * n, d)
    if not last:
        ctx = layer_norm(DN_ALPHA * ctx + mod_c[2] * mix_c, p['ln1_g'], p['ln1_b'])
        tokens_c = (ctx * (1 + mod_c[4]) + mod_c[3]).reshape(-1, d)
        tokens = jnp.concatenate([tokens, tokens_c], 0)
    f = moe_ffn(tokens, p)
    x = layer_norm(DN_ALPHA * x + mod_l[:, 5, None] * f[:b * n].reshape(b, n, d), p['ln2_g'], p['ln2_b'])
    if not last:
        ctx = layer_norm(DN_ALPHA * ctx + mod_c[5] * f[b * n:].reshape(ctx.shape), p['ln2_g'], p['ln2_b'])
    return x, ctx


def setup_inputs(seed: int = 0) -> dict:
    key = jax.random.key(seed)
    ks = iter(jax.random.split(key, 48))
    nrm = lambda shape, scale: jax.random.normal(next(ks), shape, F32) * scale
    L, D = DEPTH, D_MODEL
    dt0 = jnp.exp(jax.random.uniform(next(ks), (L, 2, SSM_HEADS), F32, math.log(DT_MIN), math.log(DT_MAX)))
    a_log = jnp.log(jax.random.uniform(next(ks), (L, 2, SSM_HEADS), F32, 1.0, 16.0))
    return {
        'x': nrm((BATCH, SEQ, D), 1.0),
        'c': nrm((BATCH, D), 1.0),
        'ctx': nrm((BATCH, CTX_LEN, D), 1.0),
        'c_ctx': nrm((D,), 1.0),
        'w_mod': nrm((L, D, 6 * D), 0.5 * D ** -0.5),
        'b_mod': nrm((L, 6 * D), 0.02),
        'w_in': nrm((L, D, IN_WIDTH), D ** -0.5),
        'g_q': 1.0 + nrm((L, Q_LORA), 0.02),
        'w_q_b': nrm((L, Q_LORA, MLA_HEADS * (QK_NOPE + QK_ROPE)), Q_LORA ** -0.5),
        'g_kv': 1.0 + nrm((L, KV_LORA), 0.02),
        'w_kv_b': nrm((L, KV_LORA, MLA_HEADS * (QK_NOPE + V_DIM)), KV_LORA ** -0.5),
        'conv_w': nrm((L, SSM_CONV, XBC_WIDTH), SSM_CONV ** -0.5),
        'conv_b': nrm((L, XBC_WIDTH), 0.02),
        'a_log': a_log,
        'dt_bias': dt0 + jnp.log(-jnp.expm1(-dt0)),
        'd_skip': 1.0 + nrm((L, SSM_HEADS), 0.02),
        'g_ssm': 1.0 + nrm((L, SSM_INNER), 0.02),
        'g_v': 1.0 + nrm((L, GM_WIDTH), 0.02),
        'b_v': nrm((L, GM_WIDTH), 0.02),
        'w_sp': nrm((L, GM_HEADS, GM_CHUNK, GM_CHUNK), GM_CHUNK ** -0.5),
        'b_sp': 1.0 + nrm((L, GM_HEADS, GM_CHUNK), 0.02),
        'w_out': nrm((L, MIX_WIDTH, D), DN_BETA * MIX_WIDTH ** -0.5),
        'ln1_g': 1.0 + nrm((L, D), 0.02),
        'ln1_b': nrm((L, D), 0.02),
        'ln2_g': 1.0 + nrm((L, D), 0.02),
        'ln2_b': nrm((L, D), 0.02),
        'w_router': nrm((L, D, N_EXPERTS), D ** -0.5),
        'b_router': nrm((L, N_EXPERTS), 0.01),
        'w_e_gate': nrm((L, N_EXPERTS, D, EXPERT_FF), D ** -0.5),
        'w_e_up': nrm((L, N_EXPERTS, D, EXPERT_FF), D ** -0.5),
        'w_e_down': nrm((L, N_EXPERTS, EXPERT_FF, D), DN_BETA * EXPERT_FF ** -0.5),
        'w_sh_gate': nrm((L, D, SHARED_FF), D ** -0.5),
        'w_sh_up': nrm((L, D, SHARED_FF), D ** -0.5),
        'w_sh_down': nrm((L, SHARED_FF, D), DN_BETA * SHARED_FF ** -0.5),
    }


def reference(x, c, ctx, c_ctx, w_mod, b_mod, w_in, g_q, w_q_b, g_kv, w_kv_b, conv_w, conv_b, a_log, dt_bias,
              d_skip, g_ssm, g_v, b_v, w_sp, b_sp, w_out, ln1_g, ln1_b, ln2_g, ln2_b, w_router, b_router,
              w_e_gate, w_e_up, w_e_down, w_sh_gate, w_sh_up, w_sh_down):
    rope = axial_rope_tables(x.shape[1])
    for l in range(DEPTH):
        last = l == DEPTH - 1
        n_mod_c = 2 if last else 6
        mod_l = (jax.nn.silu(c) @ w_mod[l] + b_mod[l]).reshape(c.shape[0], 6, D_MODEL)
        mod_c = (jax.nn.silu(c_ctx) @ w_mod[l][:, :n_mod_c * D_MODEL]
                 + b_mod[l][:n_mod_c * D_MODEL]).reshape(n_mod_c, D_MODEL)
        p = dict(w_in=w_in[l], g_q=g_q[l], w_q_b=w_q_b[l], g_kv=g_kv[l], w_kv_b=w_kv_b[l],
                 conv_w=conv_w[l], conv_b=conv_b[l], a_log=a_log[l], dt_bias=dt_bias[l], d_skip=d_skip[l],
                 g_ssm=g_ssm[l], g_v=g_v[l], b_v=b_v[l], w_sp=w_sp[l], b_sp=b_sp[l], w_out=w_out[l],
                 ln1_g=ln1_g[l], ln1_b=ln1_b[l], ln2_g=ln2_g[l], ln2_b=ln2_b[l],
                 w_router=w_router[l], b_router=b_router[l], w_e_gate=w_e_gate[l], w_e_up=w_e_up[l],
                 w_e_down=w_e_down[l], w_sh_gate=w_sh_gate[l], w_sh_up=w_sh_up[l], w_sh_down=w_sh_down[l])
        x, ctx = trunk_layer(x, ctx, mod_l, mod_c, p, rope, last)
    return x
```

```cpp
#include <hip/hip_runtime.h>
#include <cstdio>
#include <cstdint>

#ifndef DBG_WHICH
#define DBG_WHICH 1
#define DBG_K 8
#define DBG_ROWS 32
#endif
#ifndef N_LAUNCH_MODE
#define N_LAUNCH_MODE 0
#endif

#define DI __device__ __forceinline__
typedef unsigned short bf16_t;
typedef short bf16x8 __attribute__((ext_vector_type(8)));
typedef short s16x4 __attribute__((ext_vector_type(4)));
typedef float f32x16 __attribute__((ext_vector_type(16)));
typedef float f32x4 __attribute__((ext_vector_type(4)));
typedef unsigned u32x4 __attribute__((ext_vector_type(4)));
typedef unsigned u32x2 __attribute__((ext_vector_type(2)));

constexpr int DM = 2048, NB = 2, SEQ = 8192, CTXL = 256, RPB = CTXL + SEQ, MR = NB * RPB;
constexpr int NCH = MR / 128;
constexpr int NP = 3840;
constexpr int PC_GM = 0, PC_Q = 1024, PC_Z = 1792, PC_XBC = 2304, PC_KV = 3328, PC_KR = 3584, PC_DT = 3648;
constexpr int IN_W = 3664;
constexpr int NEXP = 64, NE1 = 65;
constexpr float DN_ALPHA = 1.4142135623730951f;
constexpr int HROWS = 172032;

constexpr size_t al256(size_t x) { return (x + 255) / 256 * 256; }
constexpr size_t WS_BAR = 0;
constexpr size_t WS_CNT = 16384;
constexpr size_t WS_MOD = 32768;
constexpr size_t ZERO_BYTES = 32768;
constexpr size_t WS_MODP = WS_MOD + (size_t)2 * 3 * 12288 * 4;
constexpr size_t WS_RSS = WS_MODP + (size_t)4 * 2 * 3 * 12288 * 4;
constexpr size_t WS_WIN = al256(WS_RSS + (size_t)MR * 16 * 4);
constexpr size_t WS_WQB = WS_WIN + (size_t)NP * 2048 * 2;
constexpr size_t WS_WKVB = WS_WQB + (size_t)1536 * 768 * 2;
constexpr size_t WS_WOUT = WS_WKVB + (size_t)2048 * 256 * 2;
constexpr size_t WS_WGU = WS_WOUT + (size_t)2048 * 2048 * 2;
constexpr size_t WS_WDN = WS_WGU + (size_t)NE1 * 1024 * 2048 * 2;
constexpr size_t WS_WRH = WS_WDN + (size_t)NE1 * 2048 * 512 * 2;
constexpr size_t WS_WRL = WS_WRH + (size_t)64 * 2048 * 2;
constexpr size_t WS_XRES = WS_WRL + (size_t)64 * 2048 * 2;
constexpr size_t WS_HB = WS_XRES + (size_t)MR * DM * 4;
constexpr size_t WS_Y = WS_HB + (size_t)MR * DM * 2;
constexpr size_t WS_H = WS_Y + (size_t)MR * DM * 4;
constexpr size_t WS_LIST = WS_H + (size_t)HROWS * 512 * 2;
constexpr size_t WS_TSLOT = WS_LIST + (size_t)64 * MR * 8;
constexpr size_t WS_O = al256(WS_TSLOT + (size_t)MR * 8 * 8);
constexpr size_t WS_PROJ = WS_O;
constexpr size_t WS_DT = WS_PROJ + (size_t)MR * NP * 2;
constexpr size_t WS_Q = WS_DT + (size_t)MR * 16 * 4;
constexpr size_t WS_KV = WS_Q + (size_t)MR * 1536 * 2;
constexpr size_t WS_KRR = WS_KV + (size_t)MR * 2048 * 2;
constexpr size_t WS_ST = WS_KRR + (size_t)MR * 64 * 2;
constexpr size_t WS_HP = WS_ST + (size_t)NCH * 16 * 8192 * 4;
constexpr size_t WS_DEC = WS_HP + (size_t)NCH * 16 * 8192 * 2;
constexpr size_t WS_MIX = al256(WS_DEC + (size_t)NCH * 16 * 4);
constexpr size_t WS_MIXEND = WS_MIX + (size_t)MR * DM * 2;
constexpr size_t WS_OEND = WS_O + (size_t)HROWS * 2048 * 2;
constexpr size_t WS_W1 = al256(WS_OEND > WS_MIXEND ? WS_OEND : WS_MIXEND);
constexpr size_t WSTRIDE = WS_W1 - WS_WIN;
constexpr size_t WS_END = WS_W1 + (WS_XRES - WS_WIN);

constexpr int LDS_BYTES = 156 * 1024;
constexpr int SM0 = 256;

#define XB_TMO      128
#define XB_XCNT(j)  (256  + 64 * (j))
#define XB_XSUB(j)  (1280 + 64 * (j))
#define XB_XGEN(j)  (2304 + 64 * (j))
#define XB_TOP      3328
#define XB_TOPGEN   3392
#define XCD_BAR_WORDS 3456
#define XB_SPIN_CAP (1u << 18)
#define LAS __attribute__((address_space(3)))

__device__ __forceinline__ unsigned xb_ld(unsigned* p)              { return __hip_atomic_load(p, __ATOMIC_RELAXED, __HIP_MEMORY_SCOPE_AGENT); }
__device__ __forceinline__ unsigned xb_add(unsigned* p, unsigned v) { return __hip_atomic_fetch_add(p, v, __ATOMIC_RELAXED, __HIP_MEMORY_SCOPE_AGENT); }
__device__ __forceinline__ unsigned xb_xcc_id() { return (unsigned)__builtin_amdgcn_s_getreg((3 << 11) | 20) & 0xFu; }
#define XB_SPIN(cond, bar) do { unsigned _sp = 0; while (cond) { __builtin_amdgcn_s_sleep(1); \
    if ((++_sp & 255u) == 0u) { if (xb_ld(&(bar)[XB_TMO])) break; if (_sp > XB_SPIN_CAP) { atomicAdd(&(bar)[XB_TMO], 1u); break; } } } } while (0)

struct XcdBarrier { unsigned* bar; unsigned x; volatile LAS unsigned* st; };

__device__ __forceinline__ XcdBarrier xcd_barrier_post(unsigned* bar, volatile LAS unsigned* st) {
    XcdBarrier b; b.bar = bar; b.x = xb_xcc_id(); b.st = st;
    if (threadIdx.x == 0) (void)xb_add(&bar[XB_XCNT(b.x)], 1u);
    return b;
}
__device__ __forceinline__ void xcd_barrier_complete(unsigned* bar, unsigned x, unsigned& nloc, unsigned& nx) {
    const unsigned G = gridDim.x * gridDim.y * gridDim.z;
    unsigned sum, cnt, mine, sp = 0u;
    for (;;) {
        sum = 0u; cnt = 0u; mine = 0u;
#pragma unroll
        for (unsigned j = 0; j < 16; ++j) { const unsigned c = xb_ld(&bar[XB_XCNT(j)]); sum += c; cnt += (c > 0u) ? 1u : 0u; mine = (j == x) ? c : mine; }
        if (sum == G) break;
        __builtin_amdgcn_s_sleep(1);
        if ((++sp & 255u) == 0u) { if (xb_ld(&bar[XB_TMO])) break; if (sp > XB_SPIN_CAP) { atomicAdd(&bar[XB_TMO], 1u); break; } }
    }
    nloc = mine > 0u ? mine : 1u; nx = cnt > 0u ? cnt : 1u;
}
__device__ __forceinline__ void xcd_barrier(const XcdBarrier& b) {
    asm volatile("s_waitcnt vmcnt(0)" ::: "memory");
    __syncthreads();
    if (threadIdx.x == 0) {
        unsigned* bar = b.bar;
        __builtin_amdgcn_s_waitcnt(0);
        unsigned nloc = b.st[0], nx = b.st[1];
        if (nloc == 0u) { xcd_barrier_complete(bar, b.x, nloc, nx); b.st[0] = nloc; b.st[1] = nx; }
        const unsigned old = xb_add(&bar[XB_XSUB(b.x)], 1u);
        const unsigned gen = old / nloc;
        if (old + 1u == (gen + 1u) * nloc) {
            __builtin_amdgcn_fence(__ATOMIC_RELEASE, "agent");
            asm volatile("s_waitcnt vmcnt(0)" ::: "memory");
            const unsigned og = xb_add(&bar[XB_TOP], 1u);
            const unsigned tg = og / nx;
            if (og + 1u == (tg + 1u) * nx) xb_add(&bar[XB_TOPGEN], 1u);
            else XB_SPIN(xb_ld(&bar[XB_TOPGEN]) == tg, bar);
            __builtin_amdgcn_fence(__ATOMIC_ACQUIRE, "agent");
            xb_add(&bar[XB_XGEN(b.x)], 1u);
            asm volatile("s_waitcnt vmcnt(0)" ::: "memory");
        } else {
            XB_SPIN(xb_ld(&bar[XB_XGEN(b.x)]) == gen, bar);
            __builtin_amdgcn_fence(__ATOMIC_ACQUIRE, "agent");
            asm volatile("s_waitcnt vmcnt(0)" ::: "memory");
        }
    }
    __syncthreads();
}

typedef __bf16 bf16x2_t __attribute__((ext_vector_type(2)));
typedef float f32x2_t __attribute__((ext_vector_type(2)));
DI unsigned cvtpk(float lo, float hi) { f32x2_t v = {lo, hi}; bf16x2_t b = __builtin_convertvector(v, bf16x2_t); return __builtin_bit_cast(unsigned, b); }
DI unsigned pk_fp8(f32x4 v) { int w = __float_as_int(v[0]);
    w = __builtin_amdgcn_cvt_pk_fp8_f32(v[0], v[1], w, false); w = __builtin_amdgcn_cvt_pk_fp8_f32(v[2], v[3], w, true); return (unsigned)w; }
constexpr float MIXS = 16.f;
DI unsigned pk_mix(float a0, float a1, float a2, float a3) { const f32x4 v = {__builtin_amdgcn_fmed3f(a0 * MIXS, -448.f, 448.f), __builtin_amdgcn_fmed3f(a1 * MIXS, -448.f, 448.f), __builtin_amdgcn_fmed3f(a2 * MIXS, -448.f, 448.f), __builtin_amdgcn_fmed3f(a3 * MIXS, -448.f, 448.f)}; return pk_fp8(v); }
DI f32x4 unpk_fp8(unsigned w) { const f32x2_t lo = __builtin_amdgcn_cvt_pk_f32_fp8((int)w, false), hi = __builtin_amdgcn_cvt_pk_f32_fp8((int)w, true); return (f32x4){lo[0], lo[1], hi[0], hi[1]}; }
DI float bf_lo(unsigned w) { return __uint_as_float(w << 16); }
DI float bf_hi(unsigned w) { return __uint_as_float(w & 0xffff0000u); }
DI float bf2f(bf16_t b) { return __uint_as_float(((unsigned)b) << 16); }
DI bf16_t f2bf(float f) { return (bf16_t)(cvtpk(f, 0.f) & 0xffffu); }
DI float silu_f(float x) { return x * __builtin_amdgcn_rcpf(1.f + __expf(-x)); }
DI float gelu_f(float v) {
    const float av = fabsf(v), t = __builtin_amdgcn_rcpf(av * 0.2316418882f + 1.0f);
    float q = t * 0.5307027145f + (-0.7265760135f); q = q * t + 0.7107068705f; q = q * t + (-0.142248368f); q = q * t + 0.127414796f; q = q * t;
    const float e = __builtin_amdgcn_exp2f((v * v) * (-0.72134752044f));
    const float m = v * (q * e);
    return v < 0.f ? m : v - m;
}
DI int crow(int r, int hi) { return (r & 3) + 8 * (r >> 2) + 4 * hi; }
DI int tidx() { int t = threadIdx.x; asm volatile("" : "+v"(t)); return t; }
DI float wave_sum(float v) { for (int o = 32; o >= 1; o >>= 1) v += __shfl_xor(v, o); return v; }

struct Args {
    const float *x, *c, *ctx, *c_ctx, *w_mod, *b_mod, *w_in, *g_q, *w_q_b, *g_kv, *w_kv_b, *conv_w, *conv_b, *a_log, *dt_bias, *d_skip,
                *g_ssm, *g_v, *b_v, *w_sp, *b_sp, *w_out, *ln1_g, *ln1_b, *ln2_g, *ln2_b, *w_router, *b_router, *w_e_gate, *w_e_up,
                *w_e_down, *w_sh_gate, *w_sh_up, *w_sh_down;
    float* out; unsigned char* ws; int ph_lo, ph_hi;
};

template <int MI, int NI, int KS, bool SWAP>
DI void mma_lds(const unsigned char* As, int lda, const unsigned char* Bs, int ldb, f32x16 (&acc)[MI][NI], int r, int h) {
#pragma unroll
    for (int ks = 0; ks < KS; ++ks) {
        bf16x8 a[MI], b[NI];
#pragma unroll
        for (int mi = 0; mi < MI; ++mi) a[mi] = *(const bf16x8*)(As + (mi * 32 + r) * lda + (ks * 16 + h * 8) * 2);
#pragma unroll
        for (int ni = 0; ni < NI; ++ni) b[ni] = *(const bf16x8*)(Bs + (ni * 32 + r) * ldb + (ks * 16 + h * 8) * 2);
#pragma unroll
        for (int mi = 0; mi < MI; ++mi)
#pragma unroll
            for (int ni = 0; ni < NI; ++ni)
                acc[mi][ni] = SWAP ? __builtin_amdgcn_mfma_f32_32x32x16_bf16(b[ni], a[mi], acc[mi][ni], 0, 0, 0)
                                   : __builtin_amdgcn_mfma_f32_32x32x16_bf16(a[mi], b[ni], acc[mi][ni], 0, 0, 0);
    }
}

#define XSWZ(R, kb) ((((kb) ^ (((R) >> 3) & 15))) << 4)
template <int MI, int NI, int KS, bool SWAP, bool SWZA, bool SWZB>
DI void mma_lds_x(const unsigned char* As, int lda, int rowA0, const unsigned char* Bs, int ldb, int rowB0, f32x16 (&acc)[MI][NI], int r, int h) {
#pragma unroll
    for (int ks = 0; ks < KS; ++ks) {
        bf16x8 a[MI], b[NI];
#pragma unroll
        for (int mi = 0; mi < MI; ++mi) a[mi] = *(const bf16x8*)(As + (mi * 32 + r) * lda + (SWZA ? XSWZ(rowA0 + mi * 32 + r, ks * 2 + h) : (ks * 16 + h * 8) * 2));
#pragma unroll
        for (int ni = 0; ni < NI; ++ni) b[ni] = *(const bf16x8*)(Bs + (ni * 32 + r) * ldb + (SWZB ? XSWZ(rowB0 + ni * 32 + r, ks * 2 + h) : (ks * 16 + h * 8) * 2));
#pragma unroll
        for (int mi = 0; mi < MI; ++mi)
#pragma unroll
            for (int ni = 0; ni < NI; ++ni)
                acc[mi][ni] = SWAP ? __builtin_amdgcn_mfma_f32_32x32x16_bf16(b[ni], a[mi], acc[mi][ni], 0, 0, 0)
                                   : __builtin_amdgcn_mfma_f32_32x32x16_bf16(a[mi], b[ni], acc[mi][ni], 0, 0, 0);
    }
}
DI int xswz_off(int R, int s, int ld) { return R * ld + XSWZ(R, s >> 3) + (s & 7) * 2; }

constexpr int GT_LD = 144;
constexpr int GT_BYTES = (256 + 128) * GT_LD;
template <bool SWAP, class AR, class EP>
DI void gemm_tile(unsigned char* sm, const AR& arow, const bf16_t* Bt, size_t ldb, int K, const EP& ep) {
    const int tid = tidx(), wave = tid >> 6, lane = tid & 63, r = lane & 31, h = lane >> 5, wm = wave >> 1, wn = wave & 1;
    unsigned char* As = sm; unsigned char* Bs = sm + 256 * GT_LD;
    const int lr = tid >> 3, kc = (tid & 7) * 8;
    const bf16_t* ap[4]; const bf16_t* bp[2];
#pragma unroll
    for (int i = 0; i < 4; ++i) ap[i] = arow(lr + 64 * i) + kc;
#pragma unroll
    for (int i = 0; i < 2; ++i) bp[i] = Bt + (size_t)(lr + 64 * i) * ldb + kc;
    u32x4 ra[4], rb[2];
#pragma unroll
    for (int i = 0; i < 4; ++i) ra[i] = *(const u32x4*)(ap[i]);
#pragma unroll
    for (int i = 0; i < 2; ++i) rb[i] = *(const u32x4*)(bp[i]);
    f32x16 acc[2][2];
#pragma unroll
    for (int i = 0; i < 2; ++i)
#pragma unroll
        for (int j = 0; j < 2; ++j)
#pragma unroll
            for (int q = 0; q < 16; ++q) acc[i][j][q] = 0.f;
    const int nk = K >> 6;
    for (int kt = 0; kt < nk; ++kt) {
        __syncthreads();
#pragma unroll
        for (int i = 0; i < 4; ++i) *(u32x4*)(As + (lr + 64 * i) * GT_LD + kc * 2) = ra[i];
#pragma unroll
        for (int i = 0; i < 2; ++i) *(u32x4*)(Bs + (lr + 64 * i) * GT_LD + kc * 2) = rb[i];
        __syncthreads();
        if (kt + 1 < nk) {
#pragma unroll
            for (int i = 0; i < 4; ++i) ra[i] = *(const u32x4*)(ap[i] + (kt + 1) * 64);
#pragma unroll
            for (int i = 0; i < 2; ++i) rb[i] = *(const u32x4*)(bp[i] + (kt + 1) * 64);
        }
        mma_lds<2, 2, 4, SWAP>(As + wm * 64 * GT_LD, GT_LD, Bs + wn * 64 * GT_LD, GT_LD, acc, r, h);
    }
    ep(acc, wm, wn, r, h);
}


namespace g8 {
typedef int i32x4_t __attribute__((ext_vector_type(4)));
typedef int i32x8_t __attribute__((ext_vector_type(8)));
constexpr int BM = 256, BK = 64, HALF = 128, HTB = HALF * BK * 2, STAGE_BYTES = 8 * HTB;
DI int lds_byte(int r, int c) { const int st = (r >> 4) * 2 + (c >> 5), rr = r & 15, cc = c & 31, ob = rr * 64 + cc * 2; return st * 1024 + (ob ^ (((ob >> 9) & 1) << 5)); }
DI void stage_rc(int b, int& R, int& C) { const int st = b / 1024, sb = b % 1024, swz = sb ^ (((sb >> 9) & 1) << 5); R = (st >> 1) * 16 + swz / 64; C = (st & 1) * 32 + (swz % 64) / 2; }
DI int perm32(int rho) { const int n = rho >> 4, i = rho & 15; return 8 * (i >> 2) + 4 * n + (i & 3); }
struct Unit { const char* Ab; const char* Bb; int p0, p1, p2; };
template <class Epi, class Sched>
DI void gemm(unsigned char* lds_generic, const int K, const int ldb  , const Sched& S, const Epi& E) {
    LAS unsigned char* lds = (LAS unsigned char*)lds_generic;
    const int tid = tidx(), wid = __builtin_amdgcn_readfirstlane(tid >> 6), lane = tid & 63, wr = wid >> 2, wc = wid & 3, fr = lane & 15, fq = lane >> 4;
    const int nt = K / BK;
    int R0, C0, R1, C1; stage_rc(tid * 16, R0, C0); stage_rc(tid * 16 + 8192, R1, C1);
    unsigned voffB[2];
    { int Rb[2]; const int Rs[2] = {R0, R1};
#pragma unroll
      for (int i = 0; i < 2; ++i) { const int R = Rs[i], x = R & 31;
          Rb[i] = Epi::ADJ16 ? 64 * (R >> 5) + 16 * ((x >> 2) & 3) + 4 * (x >> 4) + (x & 3) : (Epi::PERM ? (R & ~31) + perm32(x) : R); }
      voffB[0] = (unsigned)(Rb[0] * ldb + C0) * 2u; voffB[1] = (unsigned)(Rb[1] * ldb + C1) * 2u; }
    const size_t hstepB = (size_t)(Epi::ADJ16 ? 8 : HALF) * ldb * 2;
    const unsigned ldsw = (unsigned)wid * 1024u;
    const int aoff = lds_byte(wr * 64 + fr, fq * 8), boff = lds_byte(wc * 32 + fr, fq * 8);
#define G8_SA(b, h) (((b) * 2 + (h)) * HTB)
#define G8_SB(b, h) ((4 + (b) * 2 + (h)) * HTB)
#define G8_STA(bufoff, U, AO, h, kb) do { _Pragma("unroll") for (int _i = 0; _i < 2; ++_i) \
        __builtin_amdgcn_global_load_lds((const unsigned*)((U).Ab + (kb) + (AO)[h][_i]), (LAS unsigned*)(lds + (bufoff) + ldsw + _i * 8192), 16, 0, 0); } while (0)
#define G8_STB(bufoff, U, h, kb) do { _Pragma("unroll") for (int _i = 0; _i < 2; ++_i) \
        __builtin_amdgcn_global_load_lds((const unsigned*)((U).Bb + (kb) + (h) * hstepB + voffB[_i]), (LAS unsigned*)(lds + (bufoff) + ldsw + _i * 8192), 16, 0, 0); } while (0)
#define G8_LD8(addr) __builtin_shufflevector(*(const LAS i32x4_t*)(addr), *(const LAS i32x4_t*)((addr) + 1024), 0, 1, 2, 3, 4, 5, 6, 7)
#define G8_LDA(dst, b, h) do { _Pragma("unroll") for (int m = 0; m < 4; ++m) dst[m] = G8_LD8(lds + G8_SA(b, h) + aoff + m * 2048); } while (0)
#define G8_LDB(dst, b, h) do { _Pragma("unroll") for (int n = 0; n < 2; ++n) dst[n] = G8_LD8(lds + G8_SB(b, h) + boff + n * 2048); } while (0)
#define G8_LO(x) __builtin_bit_cast(bf16x8, __builtin_shufflevector(x, x, 0, 1, 2, 3))
#define G8_HI(x) __builtin_bit_cast(bf16x8, __builtin_shufflevector(x, x, 4, 5, 6, 7))
#define G8_MMA(ai, bj, At, Bt) do { __builtin_amdgcn_s_setprio(1); \
        if constexpr (Epi::FP8) { _Pragma("unroll") for (int m = 0; m < 4; ++m) _Pragma("unroll") for (int n = 0; n < 2; ++n) \
            asm volatile("v_mfma_scale_f32_16x16x128_f8f6f4 %0, %1, %2, %0, %4, %3 op_sel_hi:[0,0,0]" : "+v"(acc[ai][bj][m][n]) : "v"(Bt[n]), "v"(At[m]), "v"(fp8_unit_scale), "v"(fp8_w_scale)); } \
        else { _Pragma("unroll") for (int m = 0; m < 4; ++m) _Pragma("unroll") for (int n = 0; n < 2; ++n) { \
            acc[ai][bj][m][n] = __builtin_amdgcn_mfma_f32_16x16x32_bf16(G8_LO(Bt[n]), G8_LO(At[m]), acc[ai][bj][m][n], 0, 0, 0); \
            acc[ai][bj][m][n] = __builtin_amdgcn_mfma_f32_16x16x32_bf16(G8_HI(Bt[n]), G8_HI(At[m]), acc[ai][bj][m][n], 0, 0, 0); } } \
        __builtin_amdgcn_s_setprio(0); } while (0)
#define G8_WAIT_V(n) asm volatile("s_waitcnt vmcnt(" #n ")" ::: "memory")
#define G8_WAIT_L(n) asm volatile("s_waitcnt lgkmcnt(" #n ")" ::: "memory")
#define G8_BAR __builtin_amdgcn_s_barrier()
#define G8_SCHED __builtin_amdgcn_sched_barrier(0)
    Unit cur, nxt; int ui = 0; unsigned aoC[2][2], aoN[2][2];
    if (!Sched::GATHER) { S.lane_offsets(aoC, R0, C0, R1, C1); }
    if (!S.next(0, cur, aoC, R0, C0, R1, C1)) return;
    f32x4 acc[2][2][4][2];
#pragma unroll
    for (int a = 0; a < 2; ++a)
#pragma unroll
        for (int b = 0; b < 2; ++b)
#pragma unroll
            for (int m = 0; m < 4; ++m)
#pragma unroll
                for (int n = 0; n < 2; ++n) acc[a][b][m][n] = (f32x4){0.f, 0.f, 0.f, 0.f};
    i32x8_t At[4], B0[2], B1[2];
    int fp8_unit_scale = 0x7f7f7f7f, fp8_w_scale = Epi::WSC * 0x01010101; asm volatile("" : "+v"(fp8_unit_scale), "+v"(fp8_w_scale));
    G8_STB(G8_SB(0, 0), cur, 0, 0); G8_STA(G8_SA(0, 0), cur, aoC, 0, 0); G8_STB(G8_SB(0, 1), cur, 1, 0); G8_STA(G8_SA(0, 1), cur, aoC, 1, 0);
    if (wr == 1) G8_BAR;
    G8_WAIT_V(4); G8_BAR;
    G8_STB(G8_SB(1, 0), cur, 0, 128); G8_STA(G8_SA(1, 0), cur, aoC, 0, 128); G8_STB(G8_SB(1, 1), cur, 1, 128);
    G8_WAIT_V(6); G8_BAR;
    for (;;) {
        const bool has_next = S.next(ui + 1, nxt, aoN, R0, C0, R1, C1);
        if (!has_next) { nxt = cur; if (Sched::GATHER) { aoN[0][0] = aoC[0][0]; aoN[0][1] = aoC[0][1]; aoN[1][0] = aoC[1][0]; aoN[1][1] = aoC[1][1]; } }
#pragma unroll 1
        for (int t = 0; t < nt; t += 2) {
            const bool last = (t == nt - 2);
            const size_t k1 = (size_t)(t + 1) * 128, k2 = last ? 0 : (size_t)(t + 2) * 128, k3 = k2 + 128;
            Unit U2; U2.Ab = last ? nxt.Ab : cur.Ab; U2.Bb = last ? nxt.Bb : cur.Bb; unsigned ao2[2][2];
            if (Sched::GATHER) { ao2[0][0] = last ? aoN[0][0] : aoC[0][0]; ao2[0][1] = last ? aoN[0][1] : aoC[0][1]; ao2[1][0] = last ? aoN[1][0] : aoC[1][0]; ao2[1][1] = last ? aoN[1][1] : aoC[1][1]; }
            else { ao2[0][0] = aoC[0][0]; ao2[0][1] = aoC[0][1]; ao2[1][0] = aoC[1][0]; ao2[1][1] = aoC[1][1]; }
            G8_LDB(B0, 0, 0); G8_SCHED; G8_LDA(At, 0, 0); G8_STA(G8_SA(1, 1), cur, aoC, 1, k1);
            G8_WAIT_L(8); G8_BAR; G8_WAIT_L(0); G8_MMA(0, 0, At, B0); G8_BAR; G8_SCHED;
            G8_LDB(B1, 0, 1); G8_STB(G8_SB(0, 0), U2, 0, k2);
            G8_BAR; G8_WAIT_L(0); G8_MMA(0, 1, At, B1); G8_BAR;
            G8_LDA(At, 0, 1); G8_STA(G8_SA(0, 0), U2, ao2, 0, k2);
            G8_BAR; G8_WAIT_L(0); G8_MMA(1, 0, At, B0); G8_BAR; G8_SCHED;
            G8_STB(G8_SB(0, 1), U2, 1, k2);
            G8_WAIT_V(6); G8_BAR; G8_MMA(1, 1, At, B1); G8_BAR;
            G8_LDB(B0, 1, 0); G8_SCHED; G8_LDA(At, 1, 0); G8_STA(G8_SA(0, 1), U2, ao2, 1, k2);
            G8_WAIT_L(8); G8_BAR; G8_WAIT_L(0); G8_MMA(0, 0, At, B0); G8_BAR; G8_SCHED;
            G8_LDB(B1, 1, 1); G8_STB(G8_SB(1, 0), U2, 0, k3);
            G8_BAR; G8_WAIT_L(0); G8_MMA(0, 1, At, B1); G8_BAR;
            G8_LDA(At, 1, 1); G8_STA(G8_SA(1, 0), U2, ao2, 0, k3);
            G8_BAR; G8_WAIT_L(0); G8_MMA(1, 0, At, B0); G8_BAR; G8_SCHED;
            G8_STB(G8_SB(1, 1), U2, 1, k3);
            G8_WAIT_V(6); G8_BAR; G8_MMA(1, 1, At, B1); G8_BAR;
        }
        if constexpr (Epi::FP8) {
#define G8_F8(a, b) "+v"(acc[a][b][0][0]), "+v"(acc[a][b][0][1]), "+v"(acc[a][b][1][0]), "+v"(acc[a][b][1][1]), "+v"(acc[a][b][2][0]), "+v"(acc[a][b][2][1]), "+v"(acc[a][b][3][0]), "+v"(acc[a][b][3][1])
            asm volatile("s_nop 15\n\ts_nop 15" : G8_F8(0, 0), G8_F8(0, 1)); asm volatile("" : G8_F8(1, 0), G8_F8(1, 1));
#undef G8_F8
            __builtin_amdgcn_sched_barrier(0); }
        E(acc, cur, wr, wc, fr, fq);
        if (!has_next) break;
#pragma unroll
        for (int a = 0; a < 2; ++a)
#pragma unroll
            for (int b = 0; b < 2; ++b)
#pragma unroll
                for (int m = 0; m < 4; ++m)
#pragma unroll
                    for (int n = 0; n < 2; ++n) acc[a][b][m][n] = (f32x4){0.f, 0.f, 0.f, 0.f};
        cur = nxt; ++ui;
        if (Sched::GATHER) { aoC[0][0] = aoN[0][0]; aoC[0][1] = aoN[0][1]; aoC[1][0] = aoN[1][0]; aoC[1][1] = aoN[1][1]; }
    }
    G8_WAIT_V(0);
    if (wr == 0) G8_BAR;
    G8_BAR;
#undef G8_SA
#undef G8_SB
#undef G8_STA
#undef G8_STB
#undef G8_LDA
#undef G8_LDB
#undef G8_MMA
#undef G8_LO
#undef G8_HI
#undef G8_LD8
#undef G8_WAIT_V
#undef G8_WAIT_L
#undef G8_BAR
#undef G8_SCHED
}
struct DenseSched { static constexpr bool GATHER = false; const bf16_t* A; const bf16_t* Bt; int lda, ldb, nN, total, G, c, skipctx;
    DI void lane_offsets(unsigned (&ao)[2][2], int R0, int C0, int R1, int C1) const {
        ao[0][0] = (unsigned)(R0 * lda + C0) * 2u; ao[0][1] = (unsigned)(R1 * lda + C1) * 2u; ao[1][0] = (unsigned)((R0 + 128) * lda + C0) * 2u; ao[1][1] = (unsigned)((R1 + 128) * lda + C1) * 2u; }
    DI bool next(int i, Unit& u, unsigned (&ao)[2][2], int R0, int C0, int R1, int C1) const {
        const int L = i * G + c; if (L >= total) return false;
        int wgid = L; { const int q = total / 8, r = total % 8, xcd = wgid % 8, off = wgid / 8; wgid = (xcd < r ? xcd * (q + 1) : r * (q + 1) + (xcd - r) * q) + off; }
        const int nM = total / nN, nig = 8 * nN, gid = wgid / nig, fm = gid * 8, gsz = (nM - fm) < 8 ? (nM - fm) : 8;
        int pm = fm + ((wgid % nig) % gsz); const int pn = (wgid % nig) / gsz;
        if (skipctx) pm += 1 + (pm >= 32 ? 1 : 0);
        u.Ab = (const char*)(A + (size_t)pm * 256 * lda); u.Bb = (const char*)(Bt + (size_t)pn * 256 * ldb);
        u.p0 = pm; u.p1 = pn; u.p2 = 0; return true; } };
}

struct EpiInproj8 { static constexpr int WSC = 121; static constexpr bool PERM = true, ADJ16 = false, FP8 = true; bf16_t* proj; float* dtb; float* rowss; float inv; unsigned char* q8; float* vst;
    DI void operator()(const f32x4 (&acc)[2][2][4][2], const g8::Unit& u, int wr, int wc, int fr, int fq) const {
        const int pn = __builtin_amdgcn_readfirstlane(u.p1), row0 = u.p0 * 256 + wr * 64 + fr, colb = pn * 256 + wc * 32 + 8 * fq;
        const bool isq = (pn >= 4 && pn <= 6), iskv = (pn == 13), isv = (pn == 2 || pn == 3), isg = pn < 4, isdt = pn == 14;
#pragma unroll
        for (int ai = 0; ai < 2; ++ai)
#pragma unroll
            for (int m = 0; m < 4; ++m) { const int row = row0 + ai * 128 + m * 16; float ss = 0.f, sv = 0.f;
#pragma unroll
                for (int bj = 0; bj < 2; ++bj) { const int col = colb + bj * 128; f32x4 v0 = acc[ai][bj][m][0], v1 = acc[ai][bj][m][1];
                    if (isg) {
#pragma unroll
                        for (int j = 0; j < 4; ++j) { v0[j] = gelu_f(v0[j]); v1[j] = gelu_f(v1[j]); } }
                    u32x4 w; w.x = cvtpk(v0[0], v0[1]); w.y = cvtpk(v0[2], v0[3]); w.z = cvtpk(v1[0], v1[1]); w.w = cvtpk(v1[2], v1[3]);
                    *(u32x4*)(proj + (size_t)row * NP + col) = w;
                    if (isq) { u32x2 w8; w8.x = pk_fp8(v0); w8.y = pk_fp8(v1); *(u32x2*)(q8 + (size_t)row * 768 + (col - PC_Q)) = w8; }
                    if (isdt && col >= PC_DT && col < PC_DT + 16) { *(f32x4*)(dtb + (size_t)row * 16 + (col - PC_DT)) = v0; *(f32x4*)(dtb + (size_t)row * 16 + (col - PC_DT) + 4) = v1; }
                    ss += (v0[0] * v0[0] + v0[1] * v0[1]) + (v0[2] * v0[2] + v0[3] * v0[3]) + (v1[0] * v1[0] + v1[1] * v1[1]) + (v1[2] * v1[2] + v1[3] * v1[3]);
                    sv += ((v0[0] + v0[1]) + (v0[2] + v0[3])) + ((v1[0] + v1[1]) + (v1[2] + v1[3])); }
                if (isq || iskv) { ss += __shfl_xor(ss, 16); ss += __shfl_xor(ss, 32); if (fq == 0) rowss[(size_t)row * 16 + (iskv ? 12 : (pn - 4) * 4) + wc] = ss; }
                if (isv) { ss += __shfl_xor(ss, 16); ss += __shfl_xor(ss, 32); sv += __shfl_xor(sv, 16); sv += __shfl_xor(sv, 32); if (fq == 0) { vst[(size_t)row * 16 + (pn - 2) * 4 + wc] = sv; vst[(size_t)row * 16 + 8 + (pn - 2) * 4 + wc] = ss; } }
                __builtin_amdgcn_sched_barrier(0); }
    } };


struct EpiRowScale8 { static constexpr int WSC = 121; static constexpr bool PERM = true, ADJ16 = false, FP8 = true; bf16_t* out; int ldo; const float* rss; float invK; int s0, ns;
    DI void operator()(const f32x4 (&acc)[2][2][4][2], const g8::Unit& u, int wr, int wc, int fr, int fq) const {
        const int row0 = u.p0 * 256 + wr * 64 + fr, colb = u.p1 * 256 + wc * 32 + 8 * fq;
#pragma unroll
        for (int ai = 0; ai < 2; ++ai)
#pragma unroll
            for (int m = 0; m < 4; ++m) { const int row = row0 + ai * 128 + m * 16; float ssum = 0.f;
                { const f32x4* rp = (const f32x4*)(rss + (size_t)row * 16 + s0); for (int t = 0; t < ns; t += 4) { const f32x4 pv = rp[t >> 2]; ssum += (pv[0] + pv[1]) + (pv[2] + pv[3]); } }
                const float sc = rsqrtf(ssum * invK + 1e-6f);
#pragma unroll
                for (int bj = 0; bj < 2; ++bj) { const f32x4 v0 = acc[ai][bj][m][0] * sc, v1 = acc[ai][bj][m][1] * sc;
                    u32x4 w; w.x = cvtpk(v0[0], v0[1]); w.y = cvtpk(v0[2], v0[3]); w.z = cvtpk(v1[0], v1[1]); w.w = cvtpk(v1[2], v1[3]);
                    *(u32x4*)(out + (size_t)row * ldo + colb + bj * 128) = w; } }
    } };
struct EpiKn8 { static constexpr int WSC = 127; static constexpr bool PERM = true, ADJ16 = false, FP8 = false; unsigned char* out; const float* rss;
    DI void operator()(const f32x4 (&acc)[2][2][4][2], const g8::Unit& u, int wr, int wc, int fr, int fq) const {
        const int row0 = u.p0 * 256 + wr * 64 + fr, colb = u.p1 * 256 + wc * 32 + 8 * fq;
#pragma unroll
        for (int ai = 0; ai < 2; ++ai)
#pragma unroll
            for (int m = 0; m < 4; ++m) { const int row = row0 + ai * 128 + m * 16;
                const f32x4 pv = *(const f32x4*)(rss + (size_t)row * 16 + 12); const float sc = rsqrtf(((pv[0] + pv[1]) + (pv[2] + pv[3])) * (1.f / 256.f) + 1e-6f);
#pragma unroll
                for (int bj = 0; bj < 2; ++bj) { u32x2 w; w.x = pk_fp8(acc[ai][bj][m][0] * sc); w.y = pk_fp8(acc[ai][bj][m][1] * sc);
                    *(u32x2*)(out + (size_t)row * 1024 + colb + bj * 128) = w; } }
    } };
struct EpiVt8 { static constexpr int WSC = 127; static constexpr bool PERM = true, ADJ16 = false, FP8 = false; unsigned char* vt; const float* rss;
    DI void operator()(const f32x4 (&acc)[2][2][4][2], const g8::Unit& u, int wr, int wc, int fr, int fq) const {
        const int f0 = u.p0 * 256 + wr * 64 + fr, tokb = u.p1 * 256 + wc * 32 + 8 * fq;
#pragma unroll
        for (int bj = 0; bj < 2; ++bj) { const int tok0 = tokb + bj * 128; f32x4 s0, s1;
#pragma unroll
            for (int t = 0; t < 8; ++t) { const f32x4 pv = *(const f32x4*)(rss + (size_t)(tok0 + t) * 16 + 12); const float sc = rsqrtf(((pv[0] + pv[1]) + (pv[2] + pv[3])) * (1.f / 256.f) + 1e-6f);
                if (t < 4) s0[t] = sc; else s1[t - 4] = sc; }
            const int kap = tok0 & 63; unsigned char* tb = vt + (size_t)(tok0 >> 6) * 65536 + (kap >> 5) * 16 + ((kap & 31) >> 3) * 4;
#pragma unroll
            for (int ai = 0; ai < 2; ++ai)
#pragma unroll
                for (int m = 0; m < 4; ++m) { const int f = f0 + ai * 128 + m * 16; unsigned char* p = tb + (size_t)f * 64;
                    *(unsigned*)p = pk_fp8(acc[ai][bj][m][0] * s0); *(unsigned*)(p + 32) = pk_fp8(acc[ai][bj][m][1] * s1); } }
    } };
struct EpiOut8 { static constexpr int WSC = 117; static constexpr bool PERM = true, ADJ16 = false, FP8 = true; bf16_t* M; float inv;
    DI void operator()(const f32x4 (&acc)[2][2][4][2], const g8::Unit& u, int wr, int wc, int fr, int fq) const {
        const int row0 = u.p0 * 256 + wr * 64 + fr, colb = u.p1 * 256 + wc * 32 + 8 * fq;
#pragma unroll
        for (int ai = 0; ai < 2; ++ai)
#pragma unroll
            for (int m = 0; m < 4; ++m) { const size_t ro = (size_t)(row0 + ai * 128 + m * 16) * DM;
#pragma unroll
                for (int bj = 0; bj < 2; ++bj) { const f32x4 v0 = acc[ai][bj][m][0], v1 = acc[ai][bj][m][1];
                    u32x4 w; w.x = cvtpk(v0[0], v0[1]); w.y = cvtpk(v0[2], v0[3]); w.z = cvtpk(v1[0], v1[1]); w.w = cvtpk(v1[2], v1[3]);
                    *(u32x4*)(M + ro + colb + bj * 128) = w; } }
    } };
DI int moe_unit(int i, int G, int c, int total) {
    if (G & 7) { const int L = i * G + c; return L < total ? L : -1; }
    const int x = c & 7, slot = c >> 3, ns = G >> 3, q = total >> 3, r = total & 7;
    const int start = x * q + (x < r ? x : r), len = q + (x < r ? 1 : 0), k = i * ns + slot;
    return k < len ? start + k : -1;
}
struct MoeDownSched { static constexpr bool GATHER = false; const bf16_t* H; const bf16_t* W; const int* mtoff; int total, G, c;
    DI void lane_offsets(unsigned (&ao)[2][2], int R0, int C0, int R1, int C1) const {
        ao[0][0] = (unsigned)(R0 * 256 + C0) * 2u; ao[0][1] = (unsigned)(R1 * 256 + C1) * 2u; ao[1][0] = (unsigned)((R0 + 128) * 256 + C0) * 2u; ao[1][1] = (unsigned)((R1 + 128) * 256 + C1) * 2u; }
    DI bool next(int i, g8::Unit& u, unsigned (&ao)[2][2], int R0, int C0, int R1, int C1) const {
        const int L = moe_unit(i, G, c, total); if (L < 0) return false;
        const int pn = L & 7, mtg = L >> 3; const int e = ((const unsigned char*)(mtoff + 144))[mtg];
        u.Ab = (const char*)(H + (size_t)mtg * 256 * 256); u.Bb = (const char*)(W + ((size_t)e * 2048 + pn * 256) * 256);
        u.p0 = mtg; u.p1 = pn; u.p2 = e; return true; } };
struct EpiDown8 { static constexpr int WSC = 121; static constexpr bool PERM = true, ADJ16 = true, FP8 = true; unsigned char* O; float inv;
    DI void operator()(const f32x4 (&acc)[2][2][4][2], const g8::Unit& u, int wr, int wc, int fr, int fq) const {
        const int row0 = u.p0 * 256 + wr * 64 + fr, colb = u.p1 * 256 + wc * 64 + 16 * fq;
#pragma unroll
        for (int ai = 0; ai < 2; ++ai)
#pragma unroll
            for (int m = 0; m < 4; ++m) { u32x4 w; w.x = pk_fp8(acc[ai][0][m][0]); w.y = pk_fp8(acc[ai][0][m][1]); w.z = pk_fp8(acc[ai][1][m][0]); w.w = pk_fp8(acc[ai][1][m][1]);
                *(u32x4*)(O + (size_t)(row0 + ai * 128 + m * 16) * DM + colb) = w; }
    } };
struct ListEnt { int row; float w; };
struct MoeGUSched { static constexpr bool GATHER = true; const bf16_t* tok; const bf16_t* W; const int* mtoff; const int* gcnt; const ListEnt* list; int total, G, c, l;
    DI void lane_offsets(unsigned (&ao)[2][2], int, int, int, int) const {}
    DI bool next(int i, g8::Unit& u, unsigned (&ao)[2][2], int R0, int C0, int R1, int C1) const {
        const int L = moe_unit(i, G, c, total); if (L < 0) return false;
        const int pn = L & 3, mtg = L >> 2; const int e = ((const unsigned char*)(mtoff + 144))[mtg];
        const int mt = mtg - mtoff[e], cnt = mtoff[72 + e];
        const int Rr[2] = {R0, R1}, Cc[2] = {C0, C1};
#pragma unroll
        for (int h = 0; h < 2; ++h)
#pragma unroll
            for (int q = 0; q < 2; ++q) { const int pos = mt * 256 + h * 128 + Rr[q]; const int pc = pos < cnt ? pos : 0;
                int row = list[(size_t)(e < 64 ? e : 0) * MR + pc].row;
                const int srow = l == 0 ? pc : (pc < SEQ ? CTXL + pc : RPB + CTXL + (pc - SEQ));
                row = e < 64 ? row : srow; row = pos < cnt ? row : 0;
                row = (row < 0 || row >= MR) ? 0 : row;
                ao[h][q] = (unsigned)(row * 1024 + Cc[q]) * 2u; }
        u.Ab = (const char*)tok; u.Bb = (const char*)(W + ((size_t)e * 1024 + pn * 256) * 1024);
        u.p0 = mtg; u.p1 = pn; u.p2 = e; return true; } };
struct EpiGU8 { static constexpr int WSC = 121; static constexpr bool PERM = true, ADJ16 = false, FP8 = true; unsigned char* H; float inv;
    DI void operator()(const f32x4 (&acc)[2][2][4][2], const g8::Unit& u, int wr, int wc, int fr, int fq) const {
        const int row0 = u.p0 * 256 + wr * 64 + fr, colb = u.p1 * 128 + wc * 32 + 8 * fq;
#pragma unroll
        for (int ai = 0; ai < 2; ++ai)
#pragma unroll
            for (int m = 0; m < 4; ++m) { float o[8];
#pragma unroll
                for (int n = 0; n < 2; ++n)
#pragma unroll
                    for (int j = 0; j < 4; ++j) { const float gq = acc[ai][0][m][n][j]; o[n * 4 + j] = (gq * acc[ai][1][m][n][j]) * __builtin_amdgcn_rcpf(1.f + __builtin_amdgcn_exp2f(gq)); }
                u32x2 w; w.x = pk_fp8((f32x4){o[0], o[1], o[2], o[3]}); w.y = pk_fp8((f32x4){o[4], o[5], o[6], o[7]});
                *(u32x2*)(H + (size_t)(row0 + ai * 128 + m * 16) * 512 + colb) = w; }
    } };

DI void ph_mod(const Args& a, unsigned char* sm) {
    const int tid = tidx(), wave = tid >> 6, lane = tid & 63;
    float* sv = (float*)sm;
    float* red = (float*)(sm + 8192);
    float* modp = (float*)(a.ws + WS_MODP);
    for (int u = blockIdx.x; u < 2 * 48 * 4; u += gridDim.x) {
        const int kb = u & 3, cb = (u >> 2) % 48, l = u / 192;
        __syncthreads();
        for (int i = tid; i < 3 * 512; i += 512) { const int rr = i >> 9, k = i & 511; const float c = (rr < 2) ? a.c[rr * DM + kb * 512 + k] : a.c_ctx[kb * 512 + k]; sv[i] = silu_f(c); }
        __syncthreads();
        const float* W = a.w_mod + ((size_t)l * DM + kb * 512 + wave * 64) * 12288 + cb * 256 + lane * 4;
        float acc[3][4];
#pragma unroll
        for (int i = 0; i < 3; ++i)
#pragma unroll
            for (int j = 0; j < 4; ++j) acc[i][j] = 0.f;
#pragma unroll 8
        for (int k = 0; k < 64; ++k) {
            const f32x4 w = __builtin_nontemporal_load((const f32x4*)(W + (size_t)k * 12288));
#pragma unroll
            for (int rr = 0; rr < 3; ++rr) { const float s = sv[rr * 512 + wave * 64 + k];
#pragma unroll
                for (int j = 0; j < 4; ++j) acc[rr][j] += s * w[j]; }
        }
#pragma unroll
        for (int rr = 0; rr < 3; ++rr)
#pragma unroll
            for (int j = 0; j < 4; ++j) red[(wave * 3 + rr) * 256 + lane * 4 + j] = acc[rr][j];
        __syncthreads();
        for (int i = tid; i < 768; i += 512) {
            const int rr = i >> 8, c = i & 255; float s = 0.f;
#pragma unroll
            for (int w = 0; w < 8; ++w) s += red[(w * 3 + rr) * 256 + c];
            if (kb == 0) s += a.b_mod[(size_t)l * 12288 + cb * 256 + c];
            modp[(((size_t)kb * 2 + l) * 3 + rr) * 12288 + cb * 256 + c] = s;
        }
    }
}

template <class Map>
DI void convT(unsigned char* sm, bf16_t* dst, int N, int K, const Map map, const float* ksc) {
    const int tid = tidx(); const int nkt = K >> 7; const int ntiles = (N >> 6) * nkt;
    unsigned* T = (unsigned*)sm;
    const size_t ld = (size_t)Map::LD;
    const int n4 = (tid & 15) * 4, kr = tid >> 4;
    f32x4 v[4]; bool ok = true;
    auto load_tile = [&](int t) {
        const int n0 = (t / nkt) << 6, k0 = (t % nkt) << 7;
        const float* src = map(n0 + n4); ok = src != nullptr; if (!ok) src = map(0);
        const float* p = src + (size_t)(k0 + kr) * ld;
#pragma unroll
        for (int i = 0; i < 4; ++i) v[i] = __builtin_nontemporal_load((const f32x4*)(p + (size_t)(32 * i) * ld));
        if (!ok) {
#pragma unroll
            for (int i = 0; i < 4; ++i) v[i] = (f32x4){0.f, 0.f, 0.f, 0.f}; }
        if (ksc) {
#pragma unroll
            for (int i = 0; i < 4; ++i) v[i] *= ksc[k0 + kr + 32 * i]; }
    };
    int t = blockIdx.x;
    if (t < ntiles) load_tile(t);
    for (; t < ntiles; t += gridDim.x) {
        const int n0 = (t / nkt) << 6, k0 = (t % nkt) << 7;
        __syncthreads();
#pragma unroll
        for (int i = 0; i < 4; ++i) { const int k = kr + 32 * i; u32x2 w; w.x = cvtpk(v[i][0], v[i][1]); w.y = cvtpk(v[i][2], v[i][3]);
            *(u32x2*)(T + k * 32 + ((n4 >> 1) ^ (4 * ((k >> 3) & 7)))) = w; }
        if (t + (int)gridDim.x < ntiles) load_tile(t + gridDim.x);
        __syncthreads();
#pragma unroll
        for (int i = 0; i < 2; ++i) { const int idx = tid + i * 512, nr = idx >> 4, kc = idx & 15;
            const unsigned short* Th = (const unsigned short*)T + (size_t)(kc * 8) * 64 + ((((nr >> 1) ^ (4 * (kc & 7))) << 1) | (nr & 1));
            u32x4 w; w.x = (unsigned)Th[0] | ((unsigned)Th[64] << 16); w.y = (unsigned)Th[128] | ((unsigned)Th[192] << 16); w.z = (unsigned)Th[256] | ((unsigned)Th[320] << 16); w.w = (unsigned)Th[384] | ((unsigned)Th[448] << 16);
            *(u32x4*)(dst + (size_t)(n0 + nr) * K + k0 + kc * 8) = w; }
    }
}
struct MapGU;
template <class M> DI float conv_row_scale(const M&, int) { return 1.f; }
DI float conv_row_scale(const MapGU&, int n) { return ((n >> 7) & 1) ? -0.6931471805599453f : -1.4426950408889634f; }
template <class Map, bool NULLOK = false>
DI void convT8(unsigned char* sm, unsigned char* dst, int N, int K, const Map map, float scale, const float* ksc = nullptr) {
    const int tid = tidx(); const int nkt = K >> 7; const int ntiles = (N >> 6) * nkt; const int G = (int)gridDim.x;
    unsigned* T = (unsigned*)sm;
    const size_t ld = (size_t)Map::LD;
    const int n4 = (tid & 15) * 4, kr = tid >> 4;
    f32x4 va[4], vb[4]; float sa = scale, sb = scale;
    auto load_tile = [&](int t, f32x4 (&v)[4], float& sc) {
        const int n0 = (t / nkt) << 6, k0 = (t % nkt) << 7;
        const float* src = map(n0 + n4); sc = scale;
        if (NULLOK) { if (src == nullptr) { src = map(0); sc = 0.f; } }
        const float* p = src + (size_t)(k0 + kr) * ld;
#pragma unroll
        for (int i = 0; i < 4; ++i) v[i] = __builtin_nontemporal_load((const f32x4*)(p + (size_t)(32 * i) * ld));
    };
    auto put_tile = [&](unsigned* Tt, const f32x4 (&v)[4], float sc, int t) {
        const int k0 = (t % nkt) << 7; sc *= conv_row_scale(map, (t / nkt) << 6);
#pragma unroll
        for (int i = 0; i < 4; ++i) { const int k = kr + 32 * i; const float si = ksc ? sc * ksc[k0 + k] : sc; Tt[k * 16 + ((n4 >> 2) ^ ((k >> 4) & 7))] = pk_fp8(v[i] * si); }
    };
    auto get_tile = [&](const unsigned* Tt, int t) {
        const int n0 = (t / nkt) << 6, k0 = (t % nkt) << 7;
        const int nr = tid >> 3, kc = tid & 7; const unsigned char* Tb = (const unsigned char*)Tt + (size_t)(kc * 16) * 64 + ((((nr >> 2) ^ kc) << 2) | (nr & 3));
        unsigned w[4];
#pragma unroll
        for (int q = 0; q < 4; ++q) w[q] = (unsigned)Tb[(4 * q) * 64] | ((unsigned)Tb[(4 * q + 1) * 64] << 8) | ((unsigned)Tb[(4 * q + 2) * 64] << 16) | ((unsigned)Tb[(4 * q + 3) * 64] << 24);
        *(u32x4*)(dst + (size_t)(n0 + nr) * K + k0 + kc * 16) = (u32x4){w[0], w[1], w[2], w[3]};
    };
    int t = blockIdx.x;
    if (t < ntiles) load_tile(t, va, sa);
    if (t + G < ntiles) load_tile(t + G, vb, sb);
    for (; t < ntiles; t += 2 * G) {
        const bool hasb = t + G < ntiles;
        __syncthreads();
        put_tile(T, va, sa, t); if (hasb) put_tile(T + 2048, vb, sb, t + G);
        if (t + 2 * G < ntiles) load_tile(t + 2 * G, va, sa);
        if (t + 3 * G < ntiles) load_tile(t + 3 * G, vb, sb);
        __syncthreads();
        get_tile(T, t); if (hasb) get_tile(T + 2048, t + G);
    }
}
template <int LDV> struct MapPlain { static constexpr int LD = LDV; const float* base; DI const float* operator()(int n) const { return base + n; } };
struct MapIn { static constexpr int LD = IN_W; const float* base; DI const float* operator()(int n) const { int oc = n; if (n >= 3328 && n < 3648) oc = n + 16; else if (n >= 3648 && n < 3664) oc = n - 320; return n < 3664 ? base + oc : nullptr; } };
struct MapKVB { static constexpr int LD = 2048; const float* base;
    DI const float* operator()(int n) const { const int m = n & 1023; return base + ((m >> 7) * 256 + (n >> 10) * 128 + (m & 127)); } };
struct MapGU { static constexpr int LD = 512; const float *eg, *eu, *sg, *su;
    DI const float* operator()(int n) const { const int e = n >> 10, np = n & 1023, pn = np >> 8, isup = (np >> 7) & 1, j = pn * 128 + (np & 127);
        const float* be = isup ? eu : eg; const float* bs = isup ? su : sg;
        return e < 64 ? be + (size_t)e * 2048 * 512 + j : bs + j; } };
struct MapDN { static constexpr int LD = 2048; const float *ed, *sd;
    DI const float* operator()(int n) const { const int e = n >> 11, c = n & 2047; return (e < 64 ? ed + (size_t)e * 512 * 2048 : sd) + c; } };
DI void conv_router(const Args& a, int l) {
    bf16_t* hi = (bf16_t*)(a.ws + WS_WRH + (size_t)l * WSTRIDE); bf16_t* lo = (bf16_t*)(a.ws + WS_WRL + (size_t)l * WSTRIDE);
    const float* w = a.w_router + (size_t)l * 2048 * 64;
    for (int i = blockIdx.x * 512 + tidx(); i < 2048 * 64; i += gridDim.x * 512) {
        const int k = i >> 6, n = i & 63; const float v = w[i]; const bf16_t hb = f2bf(v); const float rem = v - bf2f(hb);
        hi[n * 2048 + k] = hb; lo[n * 2048 + k] = f2bf(rem);
    }
}
DI void ph_convert_dense(const Args& a, int l, unsigned char* sm) {
    convT8<MapIn, true>(sm, (unsigned char*)(a.ws + WS_WIN + (size_t)l * WSTRIDE), NP, 2048, MapIn{a.w_in + (size_t)l * 2048 * IN_W}, 64.f);
    convT8(sm, (unsigned char*)(a.ws + WS_WQB + (size_t)l * WSTRIDE), 1536, 768, MapPlain<1536>{a.w_q_b + (size_t)l * 768 * 1536}, 64.f, a.g_q + l * 768);
    convT(sm, (bf16_t*)(a.ws + WS_WKVB + (size_t)l * WSTRIDE), 2048, 256, MapKVB{a.w_kv_b + (size_t)l * 256 * 2048}, a.g_kv + l * 256);
    convT8(sm, (unsigned char*)(a.ws + WS_WOUT + (size_t)l * WSTRIDE), 2048, 2048, MapPlain<2048>{a.w_out + (size_t)l * 2048 * 2048}, 64.f);
    conv_router(a, l);
}
DI void ph_convert_experts(const Args& a, int l, unsigned char* sm) {
    convT8(sm, (unsigned char*)(a.ws + WS_WGU + (size_t)l * WSTRIDE), NE1 * 1024, 2048, MapGU{a.w_e_gate + (size_t)l * 64 * 2048 * 512, a.w_e_up + (size_t)l * 64 * 2048 * 512, a.w_sh_gate + (size_t)l * 2048 * 512, a.w_sh_up + (size_t)l * 2048 * 512}, 64.f);
    convT8(sm, (unsigned char*)(a.ws + WS_WDN + (size_t)l * WSTRIDE), NE1 * 2048, 512, MapDN{a.w_e_down + (size_t)l * 64 * 512 * 2048, a.w_sh_down + (size_t)l * 512 * 2048}, 64.f);
}
DI void ph_convert(const Args& a, int l, unsigned char* sm) { ph_convert_dense(a, l, sm); ph_convert_experts(a, l, sm); }

DI void ph_modulate0(const Args& a) {
    const float* modp = (const float*)(a.ws + WS_MODP);
    { float* modw = (float*)(a.ws + WS_MOD);
      for (int i = blockIdx.x * 512 + tidx(); i < 2 * 3 * 12288; i += gridDim.x * 512) modw[i] = ((modp[i] + modp[73728 + i]) + modp[2 * 73728 + i]) + modp[3 * 73728 + i]; }
    unsigned char* hb8 = (unsigned char*)(a.ws + WS_HB);
    for (size_t i = (size_t)blockIdx.x * 512 + tidx(); i < (size_t)MR * 256; i += (size_t)gridDim.x * 512) {
        const int g = (int)(i >> 8), c8 = (int)(i & 255) * 8, b = g / RPB, rr = g % RPB;
        const float* src = rr < CTXL ? a.ctx + ((size_t)(b * CTXL + rr)) * DM : a.x + ((size_t)(b * SEQ + rr - CTXL)) * DM;
        const float* m = modp + (size_t)(rr < CTXL ? 2 : b) * 12288;
        const f32x4 v0 = __builtin_nontemporal_load((const f32x4*)(src + c8)), v1 = __builtin_nontemporal_load((const f32x4*)(src + c8 + 4));
#define MSUM(off) (((*(const f32x4*)(m + (off)) + *(const f32x4*)(m + 73728 + (off))) + *(const f32x4*)(m + 2 * 73728 + (off))) + *(const f32x4*)(m + 3 * 73728 + (off)))
        const f32x4 sh0 = MSUM(c8), sh1 = MSUM(c8 + 4), sc0 = MSUM(DM + c8), sc1 = MSUM(DM + c8 + 4);
#undef MSUM
        const f32x4 h0 = v0 * (1.f + sc0) + sh0, h1 = v1 * (1.f + sc1) + sh1;
        u32x2 w; w.x = pk_fp8(h0); w.y = pk_fp8(h1);
        *(u32x2*)(hb8 + (size_t)g * DM + c8) = w;
    }
}

struct ARowLin { const bf16_t* base; size_t ld; DI const bf16_t* operator()(int i) const { return base + (size_t)i * ld; } };
struct EpiInproj { bf16_t* proj; float* dtb; int row0, col0;
    DI void operator()(f32x16 (&acc)[2][2], int wm, int wn, int r, int h) const {
#pragma unroll
        for (int mi = 0; mi < 2; ++mi)
#pragma unroll
            for (int ni = 0; ni < 2; ++ni)
#pragma unroll
                for (int q = 0; q < 4; ++q) {
                    const int row = row0 + wm * 64 + mi * 32 + r, col = col0 + wn * 64 + ni * 32 + 8 * q + 4 * h;
                    float v0 = acc[mi][ni][4 * q], v1 = acc[mi][ni][4 * q + 1], v2 = acc[mi][ni][4 * q + 2], v3 = acc[mi][ni][4 * q + 3];
                    if (col < 1024) { v0 = gelu_f(v0); v1 = gelu_f(v1); v2 = gelu_f(v2); v3 = gelu_f(v3); }
                    u32x2 w; w.x = cvtpk(v0, v1); w.y = cvtpk(v2, v3);
                    *(u32x2*)(proj + (size_t)row * NP + col) = w;
                    if (col >= PC_DT && col < PC_DT + 16) *(f32x4*)(dtb + (size_t)row * 16 + (col - PC_DT)) = (f32x4){v0, v1, v2, v3};
                }
    } };
DI void ph_inproj(const Args& a, int l, unsigned char* sm) {
    g8::DenseSched S{(const bf16_t*)(a.ws + WS_HB), (const bf16_t*)(a.ws + WS_WIN + (size_t)l * WSTRIDE), 1024, 1024, NP / 256, (MR / 256) * (NP / 256), (int)gridDim.x, (int)blockIdx.x, 0};
    EpiInproj8 E{(bf16_t*)(a.ws + WS_PROJ), (float*)(a.ws + WS_DT), (float*)(a.ws + WS_RSS), 1.f / 64.f, (unsigned char*)(a.ws + WS_KV) + (size_t)MR * 2048, (float*)(a.ws + WS_KV + (size_t)MR * 2816)};
    __syncthreads();
    g8::gemm(sm, 1024, 1024, S, E);
}

DI void conv8(const bf16_t* proj, int g, int seg_lo, int seg_hi, int c0, const float* cw, const float* cb, float (&o)[8]) {
    const f32x4 b0 = *(const f32x4*)(cb + c0), b1 = *(const f32x4*)(cb + c0 + 4);
    float acc[8] = {b0[0], b0[1], b0[2], b0[3], b1[0], b1[1], b1[2], b1[3]};
    u32x4 raw[5]; f32x4 w0[5], w1[5];
#pragma unroll
    for (int j = 0; j < 5; ++j) {
        const int gg = g + j - 2; const bool in = gg >= seg_lo && gg < seg_hi; const int gc = in ? gg : g; const float mk = in ? 1.f : 0.f;
        raw[j] = *(const u32x4*)(proj + (size_t)gc * NP + PC_XBC + c0);
        w0[j] = *(const f32x4*)(cw + j * 1024 + c0) * mk; w1[j] = *(const f32x4*)(cw + j * 1024 + c0 + 4) * mk;
    }
#pragma unroll
    for (int j = 0; j < 5; ++j) {
        acc[0] += w0[j][0] * bf_lo(raw[j].x); acc[1] += w0[j][1] * bf_hi(raw[j].x); acc[2] += w0[j][2] * bf_lo(raw[j].y); acc[3] += w0[j][3] * bf_hi(raw[j].y);
        acc[4] += w1[j][0] * bf_lo(raw[j].z); acc[5] += w1[j][1] * bf_hi(raw[j].z); acc[6] += w1[j][2] * bf_lo(raw[j].w); acc[7] += w1[j][3] * bf_hi(raw[j].w);
    }
#pragma unroll
    for (int i = 0; i < 8; ++i) o[i] = silu_f(acc[i]);
}
DI void chunk_seg(int ck, int& g0, int& seg_lo, int& seg_hi) {
    const int b = ck / 66, cc = ck % 66; g0 = ck * 128;
    if (cc < 2) { seg_lo = b * RPB; seg_hi = seg_lo + CTXL; } else { seg_lo = b * RPB + CTXL; seg_hi = (b + 1) * RPB; }
}
DI void dt_scan_wave(const float* dtbuf, int g0, int col, float bias, float aneg, int dir, float* dts, float* acs, int lane) {
    float x0 = dtbuf[(size_t)(g0 + lane) * 16 + col] + bias, x1 = dtbuf[(size_t)(g0 + lane + 64) * 16 + col] + bias;
    const float d0 = x0 > 20.f ? x0 : log1pf(__expf(x0)), d1 = x1 > 20.f ? x1 : log1pf(__expf(x1));
    dts[lane] = d0; dts[lane + 64] = d1;
    float v0 = d0 * aneg, v1 = d1 * aneg;
    if (dir == 0) {
#pragma unroll
        for (int o = 1; o < 64; o <<= 1) { const float t0 = __shfl_up(v0, o), t1 = __shfl_up(v1, o); if (lane >= o) { v0 += t0; v1 += t1; } }
        const float tot = __shfl(v0, 63); v1 += tot;
    } else {
#pragma unroll
        for (int o = 1; o < 64; o <<= 1) { const float t0 = __shfl_down(v0, o), t1 = __shfl_down(v1, o); if (lane + o < 64) { v0 += t0; v1 += t1; } }
        const float tot = __shfl(v1, 0); v0 += tot;
    }
    acs[lane] = v0; acs[lane + 64] = v1;
}

DI void gmlp_unit(const Args& a, int l, int ck, int hh, unsigned char* sm) {
    const int tid = tidx(), wave = tid >> 6, lane = tid & 63, r = lane & 31, h = lane >> 5, wm = wave >> 1, wn = wave & 1;
    const bf16_t* proj = (const bf16_t*)(a.ws + WS_PROJ); unsigned char* mix = (unsigned char*)(a.ws + WS_MIX);
    unsigned char* Asp = sm;
    unsigned char* VT = sm + 128 * 272;
    const int g0 = ck * 128;
    __syncthreads();
    { const float* gv = a.g_v + l * 512 + hh * 128; const float* bv = a.b_v + l * 512 + hh * 128; const float* vst = (const float*)(a.ws + WS_KV + (size_t)MR * 2816);
      const int sr_ = tid >> 2, dq = (tid & 3) * 32;
      const f32x4 s0 = *(const f32x4*)(vst + (size_t)(g0 + sr_) * 16), s1 = *(const f32x4*)(vst + (size_t)(g0 + sr_) * 16 + 4), q0 = *(const f32x4*)(vst + (size_t)(g0 + sr_) * 16 + 8), q1 = *(const f32x4*)(vst + (size_t)(g0 + sr_) * 16 + 12);
      const float mu = (((s0[0] + s0[1]) + (s0[2] + s0[3])) + ((s1[0] + s1[1]) + (s1[2] + s1[3]))) * (1.f / 512.f);
      const float var = (((q0[0] + q0[1]) + (q0[2] + q0[3])) + ((q1[0] + q1[1]) + (q1[2] + q1[3]))) * (1.f / 512.f) - mu * mu;
      const float rstd = rsqrtf(fmaxf(var, 0.f) + 1e-5f);
      const bf16_t* vrow = proj + (size_t)(g0 + sr_) * NP + PC_GM + 512 + hh * 128 + dq;
#pragma unroll
      for (int i = 0; i < 4; ++i) { const u32x4 raw = *(const u32x4*)(vrow + i * 8); const unsigned w4[4] = {raw.x, raw.y, raw.z, raw.w};
          const f32x4 ga = *(const f32x4*)(gv + dq + i * 8), gb = *(const f32x4*)(gv + dq + i * 8 + 4), ba = *(const f32x4*)(bv + dq + i * 8), bb = *(const f32x4*)(bv + dq + i * 8 + 4);
#pragma unroll
          for (int j = 0; j < 8; ++j) { const float vv = (j & 1) ? bf_hi(w4[j >> 1]) : bf_lo(w4[j >> 1]); const float gj = j < 4 ? ga[j] : gb[j - 4], bj = j < 4 ? ba[j] : bb[j - 4];
              *(bf16_t*)(VT + xswz_off(dq + i * 8 + j, sr_, 272)) = f2bf((vv - mu) * rstd * gj + bj); } } }
    const float* wsp = a.w_sp + ((size_t)l * 4 + hh) * 128 * 128;
#pragma unroll
    for (int i = 0; i < 8; ++i) { const int idx = tid + i * 512, t = idx >> 5, s4 = (idx & 31) * 4; const f32x4 w = *(const f32x4*)(wsp + t * 128 + s4);
        u32x2 p; p.x = cvtpk(w[0], w[1]); p.y = cvtpk(w[2], w[3]); *(u32x2*)(Asp + t * 272 + s4 * 2) = p; }
    __syncthreads();
    f32x16 acc[1][2];
#pragma unroll
    for (int j = 0; j < 2; ++j)
#pragma unroll
        for (int q = 0; q < 16; ++q) acc[0][j][q] = 0.f;
    mma_lds_x<1, 2, 8, true, false, true>(Asp + wm * 32 * 272, 272, 0, VT + wn * 64 * 272, 272, wn * 64, acc, r, h);
    const int t = wm * 32 + r; const float bsp = a.b_sp[((size_t)l * 4 + hh) * 128 + t];
#pragma unroll
    for (int ni = 0; ni < 2; ++ni)
#pragma unroll
        for (int q = 0; q < 4; ++q) {
            const int d = wn * 64 + ni * 32 + 8 * q + 4 * h;
            const u32x2 uu = *(const u32x2*)(proj + (size_t)(g0 + t) * NP + PC_GM + hh * 128 + d);
            const float o0 = bf_lo(uu.x) * (acc[0][ni][4 * q] + bsp), o1 = bf_hi(uu.x) * (acc[0][ni][4 * q + 1] + bsp), o2 = bf_lo(uu.y) * (acc[0][ni][4 * q + 2] + bsp), o3 = bf_hi(uu.y) * (acc[0][ni][4 * q + 3] + bsp);
            *(unsigned*)(mix + (size_t)(g0 + t) * DM + hh * 128 + d) = pk_mix(o0, o1, o2, o3);
        }
}
DI void ssd_state_unit(const Args& a, int l, int ck, int hh, unsigned char* sm) {
    const int tid = tidx(), wave = tid >> 6, lane = tid & 63, r = lane & 31, h = lane >> 5, wm = wave >> 1, wn = wave & 1;
    const bf16_t* proj = (const bf16_t*)(a.ws + WS_PROJ); const float* dtbuf = (const float*)(a.ws + WS_DT);
    unsigned char* XT2 = sm;
    unsigned char* BT = sm + 128 * 272;
    float* sc = (float*)(sm + 2 * 128 * 272);
    int g0, seg_lo, seg_hi; chunk_seg(ck, g0, seg_lo, seg_hi);
    __syncthreads();
    if (wave < 2) { const int dir = wave; dt_scan_wave(dtbuf, g0, dir * 8 + hh, a.dt_bias[(l * 2 + dir) * 8 + hh], -__expf(a.a_log[(l * 2 + dir) * 8 + hh]), dir, sc + dir * 128, sc + 256 + dir * 128, lane); }
    __syncthreads();
    const float* cw = a.conv_w + (size_t)l * 5 * 1024; const float* cb = a.conv_b + (size_t)l * 1024;
    const float af_last = sc[256 + 127], ab_first = sc[256 + 128 + 0];
#pragma unroll 1
    for (int i = 0; i < 2; ++i) {
        const int idx = tid + i * 512, lrow = idx >> 3, c0 = (idx & 7) * 8; float o[8];
        conv8(proj, g0 + lrow, seg_lo, seg_hi, hh * 64 + c0, cw, cb, o);
        const float wf = sc[lrow] * __expf(af_last - sc[256 + lrow]), wb = sc[128 + lrow] * __expf(ab_first - sc[256 + 128 + lrow]);
#pragma unroll
        for (int j = 0; j < 8; ++j) { *(bf16_t*)(XT2 + (c0 + j) * 272 + lrow * 2) = f2bf(o[j] * wf); *(bf16_t*)(XT2 + (64 + c0 + j) * 272 + lrow * 2) = f2bf(o[j] * wb); }
    }
#pragma unroll 1
    for (int i = 0; i < 4; ++i) {
        const int idx = tid + i * 512, lrow = idx >> 4, c0 = (idx & 15) * 8; float o[8];
        conv8(proj, g0 + lrow, seg_lo, seg_hi, 512 + (hh >> 2) * 128 + c0, cw, cb, o);
#pragma unroll
        for (int j = 0; j < 8; ++j) *(bf16_t*)(BT + (c0 + j) * 272 + lrow * 2) = f2bf(o[j]);
    }
    __syncthreads();
    f32x16 acc[1][2];
#pragma unroll
    for (int j = 0; j < 2; ++j)
#pragma unroll
        for (int q = 0; q < 16; ++q) acc[0][j][q] = 0.f;
    mma_lds<1, 2, 8, true>(XT2 + wm * 32 * 272, 272, BT + wn * 64 * 272, 272, acc, r, h);
    const int m = wm * 32 + r, dir = m >> 6, p = m & 63;
    float* st = (float*)(a.ws + WS_ST) + ((size_t)(ck * 8 + hh) * 2 + dir) * 8192 + p * 128;
#pragma unroll
    for (int ni = 0; ni < 2; ++ni)
#pragma unroll
        for (int q = 0; q < 4; ++q) { const int n = wn * 64 + ni * 32 + 8 * q + 4 * h;
            *(f32x4*)(st + n) = (f32x4){acc[0][ni][4 * q], acc[0][ni][4 * q + 1], acc[0][ni][4 * q + 2], acc[0][ni][4 * q + 3]}; }
    if (tid < 2) ((float*)(a.ws + WS_DEC))[(ck * 8 + hh) * 2 + tid] = __expf(tid == 0 ? af_last : ab_first);
}
struct EpiRowScale { bf16_t* out; size_t ldo; int row0, col0; const float* rs;
    DI void operator()(f32x16 (&acc)[2][2], int wm, int wn, int r, int h) const {
#pragma unroll
        for (int mi = 0; mi < 2; ++mi) { const int rl = wm * 64 + mi * 32 + r; const float s = rs[rl];
#pragma unroll
            for (int ni = 0; ni < 2; ++ni)
#pragma unroll
                for (int q = 0; q < 4; ++q) { const int col = col0 + wn * 64 + ni * 32 + 8 * q + 4 * h;
                    u32x2 w; w.x = cvtpk(acc[mi][ni][4 * q] * s, acc[mi][ni][4 * q + 1] * s); w.y = cvtpk(acc[mi][ni][4 * q + 2] * s, acc[mi][ni][4 * q + 3] * s);
                    *(u32x2*)(out + (size_t)(row0 + rl) * ldo + col) = w; } }
    } };
DI void rms_gemm_tile(unsigned char* sm, const bf16_t* A  , int K, const bf16_t* Bt, bf16_t* out, size_t ldo, int row0, int col0) {
    const int tid = tidx(); float* rs = (float*)(sm + GT_BYTES);
    __syncthreads();
    { const int row = tid >> 1, half = tid & 1; const bf16_t* p = A + (size_t)row * NP + half * (K >> 1); float ss = 0.f;
      for (int k = 0; k < (K >> 1); k += 8) { const u32x4 w = *(const u32x4*)(p + k);
          ss += bf_lo(w.x) * bf_lo(w.x) + bf_hi(w.x) * bf_hi(w.x) + bf_lo(w.y) * bf_lo(w.y) + bf_hi(w.y) * bf_hi(w.y) + bf_lo(w.z) * bf_lo(w.z) + bf_hi(w.z) * bf_hi(w.z) + bf_lo(w.w) * bf_lo(w.w) + bf_hi(w.w) * bf_hi(w.w); }
      ss += __shfl_xor(ss, 1);
      if (half == 0) rs[row] = rsqrtf(ss / (float)K + 1e-6f); }
    gemm_tile<true>(sm, ARowLin{A, NP}, Bt, (size_t)K, K, EpiRowScale{out, ldo, row0, col0, rs});
}
DI void krope_rows(const Args& a) {
    const bf16_t* proj = (const bf16_t*)(a.ws + WS_PROJ); unsigned char* krr = (unsigned char*)(a.ws + WS_KRR);
    for (int i = blockIdx.x * 512 + tidx(); i < MR * 32; i += gridDim.x * 512) {
        const int g = i >> 5, pr = i & 31, axis = pr >> 4, ii = pr & 15, rr = g % RPB;
        const float x1 = bf2f(proj[(size_t)g * NP + PC_KR + axis * 32 + ii]), x2 = bf2f(proj[(size_t)g * NP + PC_KR + axis * 32 + 16 + ii]);
        float o1 = x1, o2 = x2;
        if (rr >= CTXL) { const int t = rr - CTXL; const float pos = (float)(axis ? (t & 63) : (t >> 6)); const float ang = pos * exp2f(-(float)ii * 0.83048202372184059f);
            const float c = __cosf(ang), s = __sinf(ang); o1 = x1 * c - x2 * s; o2 = x2 * c + x1 * s; }
        const unsigned pk = (unsigned)__builtin_amdgcn_cvt_pk_fp8_f32(o1, o2, 0, false);
        krr[(size_t)g * 64 + axis * 32 + ii] = (unsigned char)pk; krr[(size_t)g * 64 + axis * 32 + 16 + ii] = (unsigned char)(pk >> 8);
    }
}
DI void ph_mixers1(const Args& a, int l, unsigned char* sm) {
    const bf16_t* proj = (const bf16_t*)(a.ws + WS_PROJ);
    { const float* rss = (const float*)(a.ws + WS_RSS);
      g8::DenseSched Sq{(const bf16_t*)((const unsigned char*)(a.ws + WS_KV) + (size_t)MR * 2048), (const bf16_t*)(a.ws + WS_WQB + (size_t)l * WSTRIDE), 384, 384, 6, (l == 0 ? 66 : 64) * 6, (int)gridDim.x, (int)blockIdx.x, l};
      __syncthreads();
      g8::gemm(sm, 384, 384, Sq, EpiRowScale8{(bf16_t*)(a.ws + WS_Q), 1536, rss, 1.f / 768.f, 0, 12});
      g8::DenseSched Sk{proj + PC_KV, (const bf16_t*)(a.ws + WS_WKVB + (size_t)l * WSTRIDE), NP, 256, 4, 66 * 4, (int)gridDim.x, (int)((blockIdx.x + 116) % gridDim.x), 0};
      __syncthreads();
      g8::gemm(sm, 256, 256, Sk, EpiKn8{(unsigned char*)(a.ws + WS_KV), rss});
      g8::DenseSched Sv{(const bf16_t*)(a.ws + WS_WKVB + (size_t)l * WSTRIDE) + 1024 * 256, proj + PC_KV, 256, NP, 66, 4 * 66, (int)gridDim.x, (int)((blockIdx.x + 100) % gridDim.x), 0};
      __syncthreads();
      g8::gemm(sm, 256, NP, Sv, EpiVt8{(unsigned char*)(a.ws + WS_KV) + (size_t)MR * 1024, rss}); }
    const int nss = NCH * 8, ngm = NCH * 4, total = nss + ngm;
    for (int u0 = blockIdx.x; u0 < total; u0 += gridDim.x) {
        const int u = total - 1 - u0;
        if (u < nss) ssd_state_unit(a, l, u >> 3, u & 7, sm);
        else { const int v = u - nss; gmlp_unit(a, l, v >> 2, v & 3, sm); }
    }
    krope_rows(a);
}

DI void ssd_scan(const Args& a) {
    const float* ST = (const float*)(a.ws + WS_ST); const float* DEC = (const float*)(a.ws + WS_DEC); bf16_t* HP = (bf16_t*)(a.ws + WS_HP);
    for (int idx = blockIdx.x * 512 + tidx(); idx < NB * 8 * 2 * 8192; idx += gridDim.x * 512) {
        const int pn = idx & 8191, dir = (idx >> 13) & 1, hh = (idx >> 14) & 7, b = idx >> 17;
        float carry = 0.f;
#pragma unroll 6
        for (int s = 0; s < 66; ++s) {
            const int cc = dir == 0 ? s : (s < 2 ? 1 - s : 67 - s);
            const size_t base = (size_t)((b * 66 + cc) * 8 + hh) * 2 + dir;
            HP[base * 8192 + pn] = f2bf(carry);
            carry = carry * DEC[base] + __builtin_nontemporal_load(ST + base * 8192 + pn);
        }
    }
}

constexpr float ATT_SCALE = 0.07216878364870322f;
constexpr float ATT_THR = 0.5f, ATT_PEXP = 8.f;
constexpr int AF_KLD = 208, AF_VLD = 80, AF_KB = 64 * AF_KLD, AF_VB = 128 * AF_VLD, AF_K = 0, AF_V = 2 * AF_KB;
#define SBAR() __builtin_amdgcn_sched_barrier(0)
using g8::i32x4_t; using g8::i32x8_t;
#define AF_LD32(p) __builtin_shufflevector(*(const i32x4_t*)(p), *(const i32x4_t*)((p) + 16), 0, 1, 2, 3, 4, 5, 6, 7)
DI f32x16 mfma8(i32x8_t a, i32x8_t b, f32x16 c, int sc) { return __builtin_amdgcn_mfma_scale_f32_32x32x64_f8f6f4(a, b, c, 0, 0, 0, sc, 0, sc); }
DI void partialSM(f32x16& p0, f32x16& p1, float& m_reg, float& mn, float& alpha) {
    constexpr float C = ATT_SCALE * 1.4426950408889634f;
    float pmax = p0[0];
#pragma unroll
    for (int r = 1; r < 16; ++r) pmax = fmaxf(pmax, p0[r]);
#pragma unroll
    for (int r = 0; r < 16; ++r) pmax = fmaxf(pmax, p1[r]);
    { auto rr = __builtin_amdgcn_permlane32_swap(__float_as_uint(pmax), __float_as_uint(pmax), false, false);
      pmax = fmaxf(__uint_as_float(rr[0]), __uint_as_float(rr[1])); }
    if (__builtin_expect(__all(pmax - m_reg <= ATT_THR / ATT_SCALE), 1)) { mn = m_reg; alpha = 1.f; }
    else { mn = fmaxf(m_reg, pmax); alpha = __builtin_amdgcn_exp2f((m_reg - mn) * C); m_reg = mn; }
    const float mnC = ATT_PEXP - mn * C;
#pragma unroll
    for (int r = 0; r < 16; ++r) p0[r] = fmaf(p0[r], C, mnC);
#pragma unroll
    for (int r = 0; r < 16; ++r) p1[r] = fmaf(p1[r], C, mnC);
#pragma unroll
    for (int r = 0; r < 16; ++r) p0[r] = __builtin_amdgcn_exp2f(p0[r]);
}
DI void finishSM(f32x16& p0, f32x16& p1, float alpha, float& l_reg, i32x8_t& P) {
#pragma unroll
    for (int r = 0; r < 16; ++r) p1[r] = __builtin_amdgcn_exp2f(p1[r]);
    float ps = 0;
#pragma unroll
    for (int r = 0; r < 16; ++r) ps += p0[r];
#pragma unroll
    for (int r = 0; r < 16; ++r) ps += p1[r];
    asm volatile("" : "+v"(ps));
    l_reg = l_reg * alpha + ps;
#pragma unroll
    for (int w = 0; w < 4; ++w) { P[w] = (int)pk_fp8((f32x4){p0[4 * w], p0[4 * w + 1], p0[4 * w + 2], p0[4 * w + 3]}); P[4 + w] = (int)pk_fp8((f32x4){p1[4 * w], p1[4 * w + 1], p1[4 * w + 2], p1[4 * w + 3]}); }
}
DI void qkt(f32x16& p0, f32x16& p1, const unsigned char* K, const i32x8_t (&qf)[3], int r32, int hi, int sc1) {
    const unsigned char* k0 = K + r32 * AF_KLD + hi * 32; const unsigned char* k1 = k0 + 32 * AF_KLD;
#pragma unroll
    for (int r = 0; r < 16; ++r) { p0[r] = 0.f; p1[r] = 0.f; }
#pragma unroll
    for (int blk = 0; blk < 3; ++blk) { const i32x8_t a0 = AF_LD32(k0 + blk * 64), a1 = AF_LD32(k1 + blk * 64);
        p0 = mfma8(a0, qf[blk], p0, sc1); p1 = mfma8(a1, qf[blk], p1, sc1); }
}
DI void pv_d0(f32x16* o, const unsigned char* V, const i32x8_t P, int r32, int hi, int sc1) {
    const unsigned char* vb = V + r32 * AF_VLD + hi * 32;
#pragma unroll
    for (int d = 0; d < 4; ++d) { const i32x8_t av = AF_LD32(vb + d * 32 * AF_VLD); o[d] = mfma8(av, P, o[d], sc1); }
}
DI unsigned q8pack(unsigned w0, unsigned w1) { return pk_fp8((f32x4){bf_lo(w0), bf_hi(w0), bf_lo(w1), bf_hi(w1)}); }
DI void attn_unit(const Args& a, int qrow0, int krow0, int seq, int hh, int rope_t0, unsigned char* lds) {
    const bf16_t* Qg = (const bf16_t*)(a.ws + WS_Q); const unsigned char* KNg = (const unsigned char*)(a.ws + WS_KV); const unsigned char* VTg = KNg + (size_t)MR * 1024; const unsigned char* KRg = (const unsigned char*)(a.ws + WS_KRR);
    unsigned char* Og = (unsigned char*)(a.ws + WS_MIX);
    int tid_o = tidx();
    const int tid = tid_o, wid = tid >> 6, lane = tid & 63, r32 = lane & 31, hi = lane >> 5;
    int sc1 = 0x7f7f7f7f; asm volatile("" : "+s"(sc1));
    float m_reg = -1e30f, l_reg = 0; f32x16 o[4];
#pragma unroll
    for (int d = 0; d < 4; ++d)
#pragma unroll
        for (int r = 0; r < 16; ++r) o[d][r] = 0.f;
    i32x8_t qf[3];
    { const bf16_t* Qw = Qg + (size_t)(qrow0 + wid * 32 + r32) * 1536 + hh * 192 + hi * 32;
#pragma unroll
      for (int blk = 0; blk < 2; ++blk)
#pragma unroll
          for (int i = 0; i < 4; ++i) { const u32x4 w = *(const u32x4*)(Qw + blk * 64 + i * 8); qf[blk][2 * i] = (int)q8pack(w.x, w.y); qf[blk][2 * i + 1] = (int)q8pack(w.z, w.w); }
      const u32x4 xa = *(const u32x4*)(Qw + 128), xb = *(const u32x4*)(Qw + 136), ya = *(const u32x4*)(Qw + 144), yb = *(const u32x4*)(Qw + 152);
      const unsigned x1w[8] = {xa.x, xa.y, xa.z, xa.w, xb.x, xb.y, xb.z, xb.w}, x2w[8] = {ya.x, ya.y, ya.z, ya.w, yb.x, yb.y, yb.z, yb.w};
      const int t = rope_t0 + wid * 32 + r32; const float pos = rope_t0 >= 0 ? (float)(hi ? (t & 63) : (t >> 6)) : 0.f;
#pragma unroll
      for (int i = 0; i < 4; ++i) { f32x4 y1, y2;
#pragma unroll
          for (int j = 0; j < 4; ++j) { const int f = 4 * i + j; const unsigned w1 = x1w[f >> 1], w2 = x2w[f >> 1];
              const float u1 = (f & 1) ? bf_hi(w1) : bf_lo(w1), u2 = (f & 1) ? bf_hi(w2) : bf_lo(w2);
              const float ang = pos * exp2f(-(float)f * 0.83048202372184059f); const float c = __cosf(ang), sn = __sinf(ang);
              y1[j] = u1 * c - u2 * sn; y2[j] = u2 * c + u1 * sn; }
          qf[2][i] = (int)pk_fp8(y1); qf[2][4 + i] = (int)pk_fp8(y2); } }
    const int skey = tid >> 3, spart = tid & 7;
    const unsigned char* Kp = KNg + (size_t)krow0 * 1024 + hh * 128; const unsigned char* Krp = KRg + (size_t)krow0 * 64; const unsigned char* Vp = VTg + ((size_t)((krow0 >> 6) * 8 + hh) * 128) * 64;
    const unsigned koff = (unsigned)(skey * 1024 + spart * 16), kroff = (unsigned)(skey * 64 + spart * 8), voff = (unsigned)(tid * 16);
    unsigned char* kw = lds + AF_K + skey * AF_KLD + spart * 16; unsigned char* krw = lds + AF_K + skey * AF_KLD + 128 + spart * 8; unsigned char* vw = lds + AF_V + (tid >> 2) * AF_VLD + (tid & 3) * 16;
    u32x4 ks, vs; u32x2 kr;
#define SLOAD(k0) do { ks = *(const u32x4*)(Kp + (size_t)(k0) * 1024 + koff); kr = *(const u32x2*)(Krp + (size_t)(k0) * 64 + kroff); vs = *(const u32x4*)(Vp + (size_t)((k0) >> 6) * 65536 + voff); } while (0)
#define SWRITE(b) do { *(u32x4*)(kw + (b) * AF_KB) = ks; *(u32x2*)(krw + (b) * AF_KB) = kr; *(u32x4*)(vw + (b) * AF_VB) = vs; } while (0)
#define SWAIT() asm volatile("s_waitcnt vmcnt(0)" ::: "memory")
#define RESC(al) do { if (__any((al) < 1.f)) { _Pragma("unroll") for (int d = 0; d < 4; ++d) _Pragma("unroll") for (int r = 0; r < 16; ++r) o[d][r] *= (al); } } while (0)
    const unsigned char* K0 = lds + AF_K; const unsigned char* K1 = K0 + AF_KB; const unsigned char* V0 = lds + AF_V; const unsigned char* V1 = V0 + AF_VB;
    f32x16 pA0, pA1, pB0, pB1; float mnA, mnB, alA, alB; i32x8_t P; const int NT = seq / 64;
    __syncthreads();
    SLOAD(0); SWAIT(); SWRITE(0); __syncthreads();
    qkt(pA0, pA1, K0, qf, r32, hi, sc1); partialSM(pA0, pA1, m_reg, mnA, alA);
    SLOAD(64);
    SWAIT(); SWRITE(1); if (NT > 2) SLOAD(128); __syncthreads();
#pragma unroll 1
    for (int j = 1; j + 1 < NT; j += 2) {
        SBAR(); qkt(pB0, pB1, K1, qf, r32, hi, sc1);
        finishSM(pA0, pA1, alA, l_reg, P); SBAR();
        pv_d0(o, V0, P, r32, hi, sc1); partialSM(pB0, pB1, m_reg, mnB, alB);
        __syncthreads(); SWAIT(); SWRITE(0); SLOAD((j + 2) * 64);
        RESC(alB); __syncthreads();
        SBAR(); qkt(pA0, pA1, K0, qf, r32, hi, sc1);
        finishSM(pB0, pB1, alB, l_reg, P); SBAR();
        pv_d0(o, V1, P, r32, hi, sc1); partialSM(pA0, pA1, m_reg, mnA, alA);
        __syncthreads(); SWAIT(); SWRITE(1); if (j + 3 < NT) SLOAD((j + 3) * 64);
        RESC(alA); __syncthreads();
    }
    SBAR(); qkt(pB0, pB1, K1, qf, r32, hi, sc1);
    finishSM(pA0, pA1, alA, l_reg, P); SBAR();
    pv_d0(o, V0, P, r32, hi, sc1); partialSM(pB0, pB1, m_reg, mnB, alB);
    RESC(alB);
    finishSM(pB0, pB1, alB, l_reg, P); SBAR();
    pv_d0(o, V1, P, r32, hi, sc1);
    { auto rr = __builtin_amdgcn_permlane32_swap(__float_as_uint(l_reg), __float_as_uint(l_reg), false, false);
      l_reg = __uint_as_float(rr[0]) + __uint_as_float(rr[1]); }
    const float rl = __builtin_amdgcn_rcpf(l_reg) * MIXS;
    int obase = (qrow0 + wid * 32 + r32) * DM + 1024 + hh * 128 + 4 * hi;
    asm volatile("" : "+v"(obase));
    unsigned char* Ow = Og + obase;
#pragma unroll
    for (int d = 0; d < 4; ++d)
#pragma unroll
        for (int g = 0; g < 4; ++g) *(unsigned*)(Ow + d * 32 + 8 * g) = pk_fp8((f32x4){o[d][4 * g] * rl, o[d][4 * g + 1] * rl, o[d][4 * g + 2] * rl, o[d][4 * g + 3] * rl});
#undef SLOAD
#undef SWRITE
#undef SWAIT
#undef RESC
}
DI void ph_attn(const Args& a, int l, unsigned char* sm) {
    ssd_scan(a);
    const bool early = (((int)blockIdx.x >> 3) & 1) == 0;
    if (l == 0 && early) { ph_convert_experts(a, 0, sm); ph_convert(a, 1, sm); __syncthreads(); }
    const int nlat = NB * 8 * 32, total = nlat + (l == 0 ? NB * 8 : 0);
    for (int u = blockIdx.x; u < total; u += gridDim.x) {
        if (u < nlat) { const int b = u >> 8, w = u & 255, hh = w & 7, qb = w >> 3;
            attn_unit(a, b * RPB + CTXL + qb * 256, b * RPB, RPB, hh, qb * 256, sm); }
        else { const int v = u - nlat, b = v >> 3, hh = v & 7;
            attn_unit(a, b * RPB, b * RPB, CTXL, hh, -1, sm); }
    }
    if (l == 0 && !early) { __syncthreads(); ph_convert_experts(a, 0, sm); ph_convert(a, 1, sm); }
}

DI void ssd_out_unit(const Args& a, int l, int ck, int gg, unsigned char* sm) {
    const int tid = tidx(), wave = tid >> 6, lane = tid & 63, r = lane & 31, h = lane >> 5, wm = wave >> 1, wn = wave & 1;
    const bf16_t* proj = (const bf16_t*)(a.ws + WS_PROJ); const float* dtbuf = (const float*)(a.ws + WS_DT); const bf16_t* HP = (const bf16_t*)(a.ws + WS_HP);
    unsigned char* mix = (unsigned char*)(a.ws + WS_MIX);
    unsigned char* Cc = sm;
    unsigned char* BM = sm + 34816;
    unsigned char* XT = sm + 69632;
    unsigned char* Hf = sm + 87040;
    unsigned char* Hb = sm + 104448;
    float* sc = (float*)(sm + 121856);
    float* ssq = (float*)(sm + 121856 + 8192);
    int g0, seg_lo, seg_hi; chunk_seg(ck, g0, seg_lo, seg_hi);
    const float* cw = a.conv_w + (size_t)l * 5 * 1024; const float* cb = a.conv_b + (size_t)l * 1024;
    __syncthreads();
    { const int hl = wave >> 1, dir = wave & 1, hh = gg * 4 + hl;
      dt_scan_wave(dtbuf, g0, dir * 8 + hh, a.dt_bias[(l * 2 + dir) * 8 + hh], -__expf(a.a_log[(l * 2 + dir) * 8 + hh]), dir, sc + wave * 128, sc + 1024 + wave * 128, lane); }
#pragma unroll 1
    for (int i = 0; i < 8; ++i) {
        const int idx = tid + i * 512, isB = idx >> 11, rem = idx & 2047, lrow = rem >> 4, c0 = (rem & 15) * 8; float o[8];
        conv8(proj, g0 + lrow, seg_lo, seg_hi, (isB ? 512 : 768) + gg * 128 + c0, cw, cb, o);
        u32x4 w; w.x = cvtpk(o[0], o[1]); w.y = cvtpk(o[2], o[3]); w.z = cvtpk(o[4], o[5]); w.w = cvtpk(o[6], o[7]);
        *(u32x4*)((isB ? BM : Cc) + lrow * 272 + c0 * 2) = w;
    }
    __syncthreads();
    f32x16 G[1][2];
#pragma unroll
    for (int j = 0; j < 2; ++j)
#pragma unroll
        for (int q = 0; q < 16; ++q) G[0][j][q] = 0.f;
    mma_lds<1, 2, 8, true>(Cc + wm * 32 * 272, 272, BM + wn * 64 * 272, 272, G, r, h);
    const int lrow = wm * 32 + r;
    u32x2 yp0[4], yp1[4], yp2[4], yp3[4]; float ssl = 0.f;
#pragma unroll
    for (int q = 0; q < 4; ++q) { yp0[q] = (u32x2){0u, 0u}; yp1[q] = yp0[q]; yp2[q] = yp0[q]; yp3[q] = yp0[q]; }
#pragma unroll 1
    for (int hl = 0; hl < 4; ++hl) {
        const int hh = gg * 4 + hl;
        const float* dtf = sc + (hl * 2) * 128; const float* dtb = sc + (hl * 2 + 1) * 128; const float* acf = sc + 1024 + (hl * 2) * 128; const float* acb = sc + 1024 + (hl * 2 + 1) * 128;
        __syncthreads();
#pragma unroll 1
        for (int i = 0; i < 2; ++i) { const int idx = tid + i * 512, lr2 = idx >> 3, c0 = (idx & 7) * 8; float o[8];
            conv8(proj, g0 + lr2, seg_lo, seg_hi, hh * 64 + c0, cw, cb, o);
#pragma unroll
            for (int j = 0; j < 8; ++j) *(bf16_t*)(XT + (c0 + j) * 272 + lr2 * 2) = f2bf(o[j]); }
        { const bf16_t* hp = HP + ((size_t)(ck * 8 + hh) * 2) * 8192;
#pragma unroll
          for (int i = 0; i < 4; ++i) { const int idx = tid + i * 512, dir = idx >> 10, rem = idx & 1023, p = rem >> 4, n8 = (rem & 15) * 8;
              *(u32x4*)((dir ? Hb : Hf) + p * 272 + n8 * 2) = *(const u32x4*)(hp + (size_t)dir * 8192 + p * 128 + n8); } }
        { const float afl = acf[lrow], abl = acb[lrow];
#pragma unroll
          for (int ni = 0; ni < 2; ++ni)
#pragma unroll
              for (int q = 0; q < 4; ++q) { float mv[4];
#pragma unroll
                  for (int j = 0; j < 4; ++j) { const int s = wn * 64 + ni * 32 + 8 * q + 4 * h + j;
                      const float wf = (s <= lrow) ? __expf(afl - acf[s]) * dtf[s] : 0.f, wb = (s >= lrow) ? __expf(abl - acb[s]) * dtb[s] : 0.f;
                      mv[j] = G[0][ni][4 * q + j] * (wf + wb); }
                  u32x2 w; w.x = cvtpk(mv[0], mv[1]); w.y = cvtpk(mv[2], mv[3]);
                  *(u32x2*)(BM + lrow * 272 + (wn * 64 + ni * 32 + 8 * q + 4 * h) * 2) = w; } }
        __syncthreads();
        f32x16 a1[1][1], aF[1][1], aB[1][1];
#pragma unroll
        for (int q = 0; q < 16; ++q) { a1[0][0][q] = 0.f; aF[0][0][q] = 0.f; aB[0][0][q] = 0.f; }
        mma_lds<1, 1, 8, true>(BM + wm * 32 * 272, 272, XT + wn * 32 * 272, 272, a1, r, h);
        mma_lds<1, 1, 8, true>(Cc + wm * 32 * 272, 272, Hf + wn * 32 * 272, 272, aF, r, h);
        mma_lds<1, 1, 8, true>(Cc + wm * 32 * 272, 272, Hb + wn * 32 * 272, 272, aB, r, h);
        const float ef = __expf(acf[lrow]), eb = __expf(acb[lrow]), dsk = a.d_skip[l * 8 + hh];
#pragma unroll
        for (int q = 0; q < 4; ++q) {
            const int p0 = wn * 32 + 8 * q + 4 * h;
            const u32x2 zz = *(const u32x2*)(proj + (size_t)(g0 + lrow) * NP + PC_Z + hh * 64 + p0);
            const float zv[4] = {bf_lo(zz.x), bf_hi(zz.x), bf_lo(zz.y), bf_hi(zz.y)};
            float vv[4];
#pragma unroll
            for (int j = 0; j < 4; ++j) {
                const float xv = bf2f(*(const bf16_t*)(XT + (p0 + j) * 272 + lrow * 2));
                const float y = a1[0][0][4 * q + j] + ef * aF[0][0][4 * q + j] + eb * aB[0][0][4 * q + j] + dsk * xv;
                vv[j] = y * silu_f(zv[j]); ssl += vv[j] * vv[j];
            }
            u32x2 w; w.x = cvtpk(vv[0], vv[1]); w.y = cvtpk(vv[2], vv[3]);
            if (hl == 0) yp0[q] = w; else if (hl == 1) yp1[q] = w; else if (hl == 2) yp2[q] = w; else yp3[q] = w;
        }
    }
    ssq[lrow * 4 + wn * 2 + h] = ssl;
    __syncthreads();
    const float rstd = rsqrtf((ssq[lrow * 4] + ssq[lrow * 4 + 1] + ssq[lrow * 4 + 2] + ssq[lrow * 4 + 3]) * (1.f / 256.f) + 1e-6f);
#pragma unroll
    for (int hl = 0; hl < 4; ++hl)
#pragma unroll
        for (int q = 0; q < 4; ++q) {
            const int ch = gg * 256 + hl * 64 + wn * 32 + 8 * q + 4 * h;
            const f32x4 gs = *(const f32x4*)(a.g_ssm + l * 512 + ch);
            const u32x2 yv = hl == 0 ? yp0[q] : hl == 1 ? yp1[q] : hl == 2 ? yp2[q] : yp3[q];
            *(unsigned*)(mix + (size_t)(g0 + lrow) * DM + 512 + ch) = pk_mix(bf_lo(yv.x) * rstd * gs[0], bf_hi(yv.x) * rstd * gs[1], bf_lo(yv.y) * rstd * gs[2], bf_hi(yv.y) * rstd * gs[3]);
        }
}
DI void ph_ssd_out(const Args& a, int l, unsigned char* sm) {
    if (l == 0) { for (int u = blockIdx.x; u < NCH * 2; u += gridDim.x) ssd_out_unit(a, l, u >> 1, u & 1, sm); }
    else { for (int u = blockIdx.x; u < 256; u += gridDim.x) { const int lc = u >> 1; ssd_out_unit(a, l, (lc >> 6) * 66 + 2 + (lc & 63), u & 1, sm); } }
}

struct EpiOut { float* Y; const float* xres; const float* gate;     int row0, col0;
    DI void operator()(f32x16 (&acc)[2][2], int wm, int wn, int r, int h) const {
#pragma unroll
        for (int mi = 0; mi < 2; ++mi)
#pragma unroll
            for (int ni = 0; ni < 2; ++ni)
#pragma unroll
                for (int q = 0; q < 4; ++q) { const int row = row0 + wm * 64 + mi * 32 + r, col = col0 + wn * 64 + ni * 32 + 8 * q + 4 * h;
                    const f32x4 xr = *(const f32x4*)(xres + (size_t)row * DM + col), gt = *(const f32x4*)(gate + col);
                    f32x4 o; o[0] = DN_ALPHA * xr[0] + gt[0] * acc[mi][ni][4 * q]; o[1] = DN_ALPHA * xr[1] + gt[1] * acc[mi][ni][4 * q + 1];
                    o[2] = DN_ALPHA * xr[2] + gt[2] * acc[mi][ni][4 * q + 2]; o[3] = DN_ALPHA * xr[3] + gt[3] * acc[mi][ni][4 * q + 3];
                    *(f32x4*)(Y + (size_t)row * DM + col) = o; }
    } };
DI void ph_outproj(const Args& a, int l, unsigned char* sm) {
    g8::DenseSched S{(const bf16_t*)(a.ws + WS_MIX), (const bf16_t*)(a.ws + WS_WOUT + (size_t)l * WSTRIDE), 1024, 1024, 8, (l == 0 ? 66 : 64) * 8, (int)gridDim.x, (int)blockIdx.x, l};
    __syncthreads();
    g8::gemm(sm, 1024, 1024, S, EpiOut8{(bf16_t*)(a.ws + WS_Y), 1.f / (64.f * MIXS)});
}

DI void ph_ln1_router(const Args& a, int l, unsigned char* sm) {
    const int tid = tidx(), wave = tid >> 6, lane = tid & 63;
    bf16_t* Y = (bf16_t*)(a.ws + WS_XRES); const bf16_t* MO = (const bf16_t*)(a.ws + WS_Y); unsigned char* tok8 = (unsigned char*)(a.ws + WS_HB); const float* mod = (const float*)(a.ws + WS_MOD);
    const bf16_t* wrh = (const bf16_t*)(a.ws + WS_WRH + (size_t)l * WSTRIDE); const bf16_t* wrl = (const bf16_t*)(a.ws + WS_WRL + (size_t)l * WSTRIDE);
    int* gcnt = (int*)(a.ws + WS_CNT) + l * 64; ListEnt* list = (ListEnt*)(a.ws + WS_LIST); ListEnt* tslot = (ListEnt*)(a.ws + WS_TSLOT);
    constexpr int TLD = 2052;
    float* tokf = (float*)sm;
    float* part = (float*)(sm + 16 * TLD * 4);
    int* lcnt = (int*)(sm + 16 * TLD * 4 + 8192);
    int* lbase = lcnt + 64;
    int* ent0 = lbase + 64;
    const float* g1 = a.ln1_g + l * DM; const float* b1 = a.ln1_b + l * DM; const float* brt = a.b_router + l * 64;
    const int nunits = l == 0 ? MR / 16 : NB * SEQ / 16;
    __syncthreads();
    if (tid < 64) lcnt[tid] = 0;
    int nu = 0;
    for (int u = blockIdx.x; u < nunits && nu < 5; u += gridDim.x, ++nu) {
        const int g0 = l == 0 ? u * 16 : (u < 512 ? CTXL + u * 16 : RPB + CTXL + (u - 512) * 16);
        int* ent = ent0 + nu * 512;
        __syncthreads();
        if (tid < 128) { ent[tid * 4] = g0 + (tid >> 3); ent[tid * 4 + 1] = 0; ent[tid * 4 + 2] = 0; ent[tid * 4 + 3] = 0; }
        { const int rlA = wave * 2, gA = g0 + rlA, gB = gA + 1, bq = gA / RPB, rq = gA % RPB;
          const float* m = mod + ((size_t)l * 3 + (rq < CTXL ? 2 : bq)) * 12288;
          bf16_t* yA = Y + (size_t)gA * DM; bf16_t* yB = Y + (size_t)gB * DM; f32x4 vA[8], vB[8]; float sA = 0.f, sB = 0.f;
          const float* xinA = rq < CTXL ? a.ctx + ((size_t)(bq * CTXL + rq)) * DM : a.x + ((size_t)(bq * SEQ + rq - CTXL)) * DM; const float* xinB = xinA + DM;
#pragma unroll
          for (int j = 0; j < 8; ++j) { const int c = j * 256 + lane * 4; const f32x4 gt = *(const f32x4*)(m + 2 * DM + c);
              const u32x2 mA = __builtin_nontemporal_load((const u32x2*)(MO + (size_t)gA * DM + c)), mB = __builtin_nontemporal_load((const u32x2*)(MO + (size_t)gB * DM + c));
              f32x4 rA, rB;
              if (l == 0) { rA = __builtin_nontemporal_load((const f32x4*)(xinA + c)); rB = __builtin_nontemporal_load((const f32x4*)(xinB + c)); }
              else { const u32x2 wA = __builtin_nontemporal_load((const u32x2*)(yA + c)), wB = __builtin_nontemporal_load((const u32x2*)(yB + c)); rA = (f32x4){bf_lo(wA.x), bf_hi(wA.x), bf_lo(wA.y), bf_hi(wA.y)}; rB = (f32x4){bf_lo(wB.x), bf_hi(wB.x), bf_lo(wB.y), bf_hi(wB.y)}; }
              vA[j] = DN_ALPHA * rA + gt * (f32x4){bf_lo(mA.x), bf_hi(mA.x), bf_lo(mA.y), bf_hi(mA.y)};
              vB[j] = DN_ALPHA * rB + gt * (f32x4){bf_lo(mB.x), bf_hi(mB.x), bf_lo(mB.y), bf_hi(mB.y)}; }
#pragma unroll
          for (int j = 0; j < 8; ++j) { sA += (vA[j][0] + vA[j][1]) + (vA[j][2] + vA[j][3]); sB += (vB[j][0] + vB[j][1]) + (vB[j][2] + vB[j][3]); }
#pragma unroll
          for (int o = 32; o >= 1; o >>= 1) { sA += __shfl_xor(sA, o); sB += __shfl_xor(sB, o); }
          const float muA = sA * (1.f / 2048.f), muB = sB * (1.f / 2048.f); float qA = 0.f, qB = 0.f;
#pragma unroll
          for (int j = 0; j < 8; ++j) { const f32x4 dA = vA[j] - muA, dB = vB[j] - muB; qA += (dA[0] * dA[0] + dA[1] * dA[1]) + (dA[2] * dA[2] + dA[3] * dA[3]); qB += (dB[0] * dB[0] + dB[1] * dB[1]) + (dB[2] * dB[2] + dB[3] * dB[3]); }
#pragma unroll
          for (int o = 32; o >= 1; o >>= 1) { qA += __shfl_xor(qA, o); qB += __shfl_xor(qB, o); }
          const float rsA = rsqrtf(qA * (1.f / 2048.f) + 1e-5f), rsB = rsqrtf(qB * (1.f / 2048.f) + 1e-5f);
#pragma unroll
          for (int j = 0; j < 8; ++j) { const int c = j * 256 + lane * 4;
              const f32x4 gg = *(const f32x4*)(g1 + c), bb = *(const f32x4*)(b1 + c), sc = 1.f + *(const f32x4*)(m + 4 * DM + c), sh = *(const f32x4*)(m + 3 * DM + c);
              const f32x4 xA = (vA[j] - muA) * rsA * gg + bb, xB = (vB[j] - muB) * rsB * gg + bb;
              { u32x2 wA, wB; wA.x = cvtpk(xA[0], xA[1]); wA.y = cvtpk(xA[2], xA[3]); wB.x = cvtpk(xB[0], xB[1]); wB.y = cvtpk(xB[2], xB[3]); *(u32x2*)(yA + c) = wA; *(u32x2*)(yB + c) = wB; }
              const f32x4 tA = xA * sc + sh, tB = xB * sc + sh;
              *(unsigned*)(tok8 + (size_t)gA * DM + c) = pk_fp8(tA); *(unsigned*)(tok8 + (size_t)gB * DM + c) = pk_fp8(tB);
              *(f32x4*)(tokf + rlA * TLD + c) = tA; *(f32x4*)(tokf + (rlA + 1) * TLD + c) = tB; }
        }
        __syncthreads();
        { const int nb = wave & 3, kh = wave >> 2, rw = lane & 15, kq = lane >> 4;
          f32x4 acc = {0.f, 0.f, 0.f, 0.f};
          const float* ap = tokf + rw * TLD + kh * 1024 + kq * 8;
          const bf16_t* bh = wrh + (size_t)(nb * 16 + rw) * 2048 + kh * 1024 + kq * 8; const bf16_t* bl = wrl + (size_t)(nb * 16 + rw) * 2048 + kh * 1024 + kq * 8;
#pragma unroll 8
          for (int ks = 0; ks < 32; ++ks) {
              const f32x4 x0 = *(const f32x4*)(ap + ks * 32), x1 = *(const f32x4*)(ap + ks * 32 + 4);
              u32x4 hw; hw.x = cvtpk(x0[0], x0[1]); hw.y = cvtpk(x0[2], x0[3]); hw.z = cvtpk(x1[0], x1[1]); hw.w = cvtpk(x1[2], x1[3]);
              u32x4 lw; lw.x = cvtpk(x0[0] - bf_lo(hw.x), x0[1] - bf_hi(hw.x)); lw.y = cvtpk(x0[2] - bf_lo(hw.y), x0[3] - bf_hi(hw.y));
              lw.z = cvtpk(x1[0] - bf_lo(hw.z), x1[1] - bf_hi(hw.z)); lw.w = cvtpk(x1[2] - bf_lo(hw.w), x1[3] - bf_hi(hw.w));
              const bf16x8 ahi = *reinterpret_cast<bf16x8*>(&hw), alo = *reinterpret_cast<bf16x8*>(&lw);
              const bf16x8 bhi = *(const bf16x8*)(bh + ks * 32), blo = *(const bf16x8*)(bl + ks * 32);
              acc = __builtin_amdgcn_mfma_f32_16x16x32_bf16(ahi, bhi, acc, 0, 0, 0);
              acc = __builtin_amdgcn_mfma_f32_16x16x32_bf16(ahi, blo, acc, 0, 0, 0);
              acc = __builtin_amdgcn_mfma_f32_16x16x32_bf16(alo, bhi, acc, 0, 0, 0);
          }
#pragma unroll
          for (int j = 0; j < 4; ++j) part[(kh * 16 + kq * 4 + j) * 64 + nb * 16 + rw] = acc[j]; }
        __syncthreads();
#pragma unroll 1
        for (int rr2 = 0; rr2 < 2; ++rr2) {
            const int rl = wave * 2 + rr2, g = g0 + rl;
            const float logit = part[rl * 64 + lane] + part[(16 + rl) * 64 + lane];
            float score = 1.f / (1.f + __expf(-logit)); if (!(score >= 0.f && score <= 1.f)) score = 0.5f;
            const float bsd = score + brt[lane];
            int rk = 0;
#pragma unroll
            for (int j = 0; j < 8; ++j) { const int src = (lane & ~7) + j; const float o = __shfl(bsd, src); rk += (o > bsd || (o == bsd && src < lane)) ? 1 : 0; }
            float gs = rk < 2 ? bsd : 0.f; gs += __shfl_xor(gs, 1); gs += __shfl_xor(gs, 2); gs += __shfl_xor(gs, 4);
            int grk = 0; const int mygrp = lane >> 3;
#pragma unroll
            for (int j = 0; j < 8; ++j) { const float o = __shfl(gs, j * 8); grk += (o > gs || (o == gs && j < mygrp)) ? 1 : 0; }
            const bool elig = grk < 4; const float val = elig ? bsd : -INFINITY;
            int erk = 0;
#pragma unroll
            for (int j = 0; j < 64; ++j) { const float o = __int_as_float(__builtin_amdgcn_readlane(__float_as_int(val), j)); erk += (o > val || (o == val && j < lane)) ? 1 : 0; }
            const bool sel = elig && erk < 8;
            const float wsum = wave_sum(sel ? score : 0.f); const float wgt = score / wsum * 2.5f;
            if (sel) { const int lp = atomicAdd(&lcnt[lane], 1); int* e = ent + (rl * 8 + erk) * 4; e[0] = g; e[1] = lane; e[2] = __float_as_int(wgt); e[3] = lp; }
        }
    }
    __syncthreads();
    if (tid < 64) { const int c = lcnt[tid]; lbase[tid] = c ? atomicAdd(&gcnt[tid], c) : 0; }
    __syncthreads();
    for (int i = tid; i < nu * 128; i += 512) { const int* e = ent0 + i * 4; int pos = lbase[e[1] & 63] + e[3]; pos = pos < 0 ? 0 : (pos >= MR ? MR - 1 : pos);
        ListEnt le; le.row = e[0]; le.w = __int_as_float(e[2]); list[(size_t)e[1] * MR + pos] = le;
        ListEnt ts; ts.row = e[1] * 32768 + pos; ts.w = le.w; tslot[(size_t)e[0] * 8 + (i & 7)] = ts; }
}

DI void moe_offsets(const Args& a, int l, int* mtoff  ) {
    const int tid = tidx();
    if (tid < 64) { const int* gcnt = (const int*)(a.ws + WS_CNT) + l * 64;
        const int c = gcnt[tid], t = (c + 255) >> 8; int incl = t;
#pragma unroll
        for (int o = 1; o < 64; o <<= 1) { const int v = __shfl_up(incl, o); if (tid >= o) incl += v; }
        mtoff[tid] = incl - t; mtoff[72 + tid] = c;
        if (tid == 63) { const int cs = l == 0 ? MR : NB * SEQ; mtoff[64] = incl; mtoff[72 + 64] = cs; mtoff[NE1] = incl + ((cs + 255) >> 8); } }
    __syncthreads();
    if (tid < NE1) { unsigned char* etab = (unsigned char*)(mtoff + 144); const int hi = mtoff[tid + 1] < 1024 ? mtoff[tid + 1] : 1024; for (int m = mtoff[tid]; m < hi; ++m) etab[m] = (unsigned char)tid; }
    __syncthreads();
}
DI int moe_find(const int* mtoff, int mtg) { int e = 0;
#pragma unroll 1
    for (int j = 1; j < NE1; ++j) e = (mtoff[j] <= mtg) ? j : e;
    return e; }
struct ARowGather { const bf16_t* base; const int* rt; DI const bf16_t* operator()(int i) const { return base + (size_t)rt[i] * DM; } };
struct EpiGU { bf16_t* H; int slot0, col0;
    DI void operator()(f32x16 (&acc)[2][2], int wm, int wn, int r, int h) const {
#pragma unroll
        for (int mi = 0; mi < 2; ++mi)
#pragma unroll
            for (int q = 0; q < 4; ++q) { const int row = slot0 + wm * 64 + mi * 32 + r, col = col0 + wn * 32 + 8 * q + 4 * h; float o[4];
#pragma unroll
                for (int j = 0; j < 4; ++j) o[j] = silu_f(acc[mi][0][4 * q + j]) * acc[mi][1][4 * q + j];
                u32x2 w; w.x = cvtpk(o[0], o[1]); w.y = cvtpk(o[2], o[3]); *(u32x2*)(H + (size_t)row * 512 + col) = w; }
    } };
DI void ph_gateup(const Args& a, int l, unsigned char* sm) {
    int* mtoff = (int*)(sm + g8::STAGE_BYTES);
    __syncthreads(); moe_offsets(a, l, mtoff);
    MoeGUSched S{(const bf16_t*)(a.ws + WS_HB), (const bf16_t*)(a.ws + WS_WGU + (size_t)l * WSTRIDE), mtoff, (const int*)(a.ws + WS_CNT) + l * 64, (const ListEnt*)(a.ws + WS_LIST), mtoff[NE1] * 4, (int)gridDim.x, (int)blockIdx.x, l};
    g8::gemm(sm, 1024, 1024, S, EpiGU8{(unsigned char*)(a.ws + WS_H), 1.f / 64.f});
}
DI void ph_down(const Args& a, int l, unsigned char* sm) {
    int* mtoff = (int*)(sm + g8::STAGE_BYTES);
    __syncthreads(); moe_offsets(a, l, mtoff);
    MoeDownSched S{(const bf16_t*)(a.ws + WS_H), (const bf16_t*)(a.ws + WS_WDN + (size_t)l * WSTRIDE), mtoff, mtoff[NE1] * 8, (int)gridDim.x, (int)blockIdx.x};
    g8::gemm(sm, 256, 256, S, EpiDown8{(unsigned char*)(a.ws + WS_O), 1.f / 64.f});
}

DI void ph_ln2(const Args& a, int l, unsigned char* sm) {
    const int tid = tidx(), wave = tid >> 6, lane = tid & 63;
    int* mtoff = (int*)sm;
    __syncthreads(); moe_offsets(a, l, mtoff);
    const bf16_t* X1 = (const bf16_t*)(a.ws + WS_XRES); const unsigned char* O8 = (const unsigned char*)(a.ws + WS_O); const ListEnt* tslot = (const ListEnt*)(a.ws + WS_TSLOT);
    const float* mod = (const float*)(a.ws + WS_MOD); bf16_t* xres = (bf16_t*)(a.ws + WS_XRES); unsigned char* hb8 = (unsigned char*)(a.ws + WS_HB);
    const float* g2 = a.ln2_g + l * DM; const float* b2 = a.ln2_b + l * DM;
    const int nrows = l == 0 ? MR : NB * SEQ;
    for (int gi = blockIdx.x * 8 + wave; gi < nrows; gi += gridDim.x * 8) {
        const int g = l == 0 ? gi : (gi < SEQ ? CTXL + gi : RPB + CTXL + (gi - SEQ));
        const int b = g / RPB, rr = g % RPB;
        const float* m = mod + ((size_t)l * 3 + (rr < CTXL ? 2 : b)) * 12288;
#define LN2_C(j) ((((j) >> 2) << 10) + lane * 16 + (((j) & 3) << 2))
        const ListEnt mine = tslot[(size_t)g * 8 + (lane & 7)];
        f32x4 f[8];
        { const unsigned char* orow = O8 + ((size_t)mtoff[64] * 256 + gi) * DM + lane * 16;
          const u32x4 w0 = __builtin_nontemporal_load((const u32x4*)orow), w1 = __builtin_nontemporal_load((const u32x4*)(orow + 1024));
          f[0] = unpk_fp8(w0.x); f[1] = unpk_fp8(w0.y); f[2] = unpk_fp8(w0.z); f[3] = unpk_fp8(w0.w); f[4] = unpk_fp8(w1.x); f[5] = unpk_fp8(w1.y); f[6] = unpk_fp8(w1.z); f[7] = unpk_fp8(w1.w); }
#pragma unroll 4
        for (int k = 0; k < 8; ++k) {
            const int code = __builtin_amdgcn_readlane(mine.row, k); const float wk = __int_as_float(__builtin_amdgcn_readlane(__float_as_int(mine.w), k));
            int r_ = mtoff[(code >> 15) & 63] * 256 + (code & 32767); r_ = r_ >= HROWS ? HROWS - 1 : r_;
            const unsigned char* orow = O8 + (size_t)r_ * DM + lane * 16;
            const u32x4 w0 = __builtin_nontemporal_load((const u32x4*)orow), w1 = __builtin_nontemporal_load((const u32x4*)(orow + 1024));
            f[0] += wk * unpk_fp8(w0.x); f[1] += wk * unpk_fp8(w0.y); f[2] += wk * unpk_fp8(w0.z); f[3] += wk * unpk_fp8(w0.w);
            f[4] += wk * unpk_fp8(w1.x); f[5] += wk * unpk_fp8(w1.y); f[6] += wk * unpk_fp8(w1.z); f[7] += wk * unpk_fp8(w1.w);
        }
        float s = 0.f;
#pragma unroll
        for (int j = 0; j < 8; ++j) { const int c = LN2_C(j);
            const u32x2 xw = __builtin_nontemporal_load((const u32x2*)(X1 + (size_t)g * DM + c));
            f[j] = DN_ALPHA * (f32x4){bf_lo(xw.x), bf_hi(xw.x), bf_lo(xw.y), bf_hi(xw.y)} + *(const f32x4*)(m + 5 * DM + c) * f[j]; s += (f[j][0] + f[j][1]) + (f[j][2] + f[j][3]); }
        const float mu = wave_sum(s) * (1.f / 2048.f); float q = 0.f;
#pragma unroll
        for (int j = 0; j < 8; ++j) { const f32x4 d = f[j] - mu; q += (d[0] * d[0] + d[1] * d[1]) + (d[2] * d[2] + d[3] * d[3]); }
        const float rstd = rsqrtf(wave_sum(q) * (1.f / 2048.f) + 1e-5f);
        const float* mn = mod + ((size_t)3 + (rr < CTXL ? 2 : b)) * 12288;
        float* orow = a.out + ((size_t)b * SEQ + (rr - CTXL)) * DM;
#pragma unroll
        for (int j = 0; j < 8; ++j) { const int c = LN2_C(j);
            const f32x4 y = (f[j] - mu) * rstd * *(const f32x4*)(g2 + c) + *(const f32x4*)(b2 + c);
            if (l == 0) {
                { u32x2 yw; yw.x = cvtpk(y[0], y[1]); yw.y = cvtpk(y[2], y[3]); *(u32x2*)(xres + (size_t)g * DM + c) = yw; }
                const f32x4 t = y * (1.f + *(const f32x4*)(mn + DM + c)) + *(const f32x4*)(mn + c);
                *(unsigned*)(hb8 + (size_t)g * DM + c) = pk_fp8(t);
            } else *(f32x4*)(orow + c) = y;
        }
    }
}
#undef LN2_C

constexpr int NPH = 21;
__global__ void __launch_bounds__(512, 2) fwd(Args a) {
    extern __shared__ __attribute__((aligned(16))) unsigned char lds[];
    if (threadIdx.x == 0) *(uint4*)lds = make_uint4(0u, 0u, 0u, 0u);
    __syncthreads();
    XcdBarrier bar; bar.bar = (unsigned*)(a.ws + WS_BAR); bar.x = 0; bar.st = nullptr;
    const bool multi = (a.ph_hi - a.ph_lo) > 1;
    if (multi) bar = xcd_barrier_post((unsigned*)(a.ws + WS_BAR), (volatile LAS unsigned*)lds);
    unsigned char* sm = lds + SM0;
    const int lo = a.ph_lo, hi = a.ph_hi;
#ifndef PH_ENABLE
#define PH_ENABLE 0xFFFF
#endif
#define EN(t) (((PH_ENABLE) >> (t)) & 1)
#ifndef REPMASK
#define REPMASK 0
#endif
#define RP(t) (((REPMASK) >> (t)) & 1)
#define IN(k) (lo <= (k) && (k) < hi)
#if defined(__HIP_DEVICE_COMPILE__)
#define ASSUME_GLOBAL(p) __builtin_assume(!__builtin_amdgcn_is_shared((const __attribute__((address_space(0))) void*)(p)) && !__builtin_amdgcn_is_private((const __attribute__((address_space(0))) void*)(p)))
#else
#define ASSUME_GLOBAL(p) ((void)0)
#endif
#define GAS __attribute__((address_space(1)))
#define CAS __attribute__((address_space(4)))
#define GP(f) b.f = (decltype(b.f))(GAS void*)(void*)b.f
#if !defined(__HIP_DEVICE_COMPILE__)
#define LA(b) Args b = a
#else
#define LA(b) Args b; { const CAS Args* kp_ = (const CAS Args*)__builtin_amdgcn_kernarg_segment_ptr(); asm volatile("" : "+s"(kp_)); b = *kp_; \
    GP(x); GP(c); GP(ctx); GP(c_ctx); GP(w_mod); GP(b_mod); GP(w_in); GP(g_q); GP(w_q_b); GP(g_kv); GP(w_kv_b); GP(conv_w); GP(conv_b); GP(a_log); GP(dt_bias); GP(d_skip); GP(g_ssm); GP(g_v); GP(b_v); \
    GP(w_sp); GP(b_sp); GP(w_out); GP(ln1_g); GP(ln1_b); GP(ln2_g); GP(ln2_b); GP(w_router); GP(b_router); GP(w_e_gate); GP(w_e_up); GP(w_e_down); GP(w_sh_gate); GP(w_sh_up); GP(w_sh_down); GP(out); GP(ws); }
#endif
#define SEAM(k) do { if (IN(k) && IN((k) + 1)) xcd_barrier(bar); } while (0)
    if (IN(0)) { if (EN(0)) { LA(b); ph_mod(b, sm); } if (EN(1)) { LA(b); ph_convert_dense(b, 0, sm); } }
    SEAM(0);
#pragma unroll 1
    for (int l = 0; l < 2; ++l) {
        const int pb = 1 + 10 * l;
        if (l == 0) { if (IN(pb + 0) && EN(2)) { LA(b); ph_modulate0(b); } SEAM(pb + 0); }
        if (IN(pb + 1) && EN(3)) { LA(b); ph_inproj(b, l, sm); if (RP(3)) { __syncthreads(); ph_inproj(b, l, sm); } }
        SEAM(pb + 1);
        if (IN(pb + 2) && EN(4)) { LA(b); ph_mixers1(b, l, sm); if (RP(4)) { __syncthreads(); ph_mixers1(b, l, sm); } }
        SEAM(pb + 2);
        if (IN(pb + 3) && EN(5)) { LA(b); ph_attn(b, l, sm); if (RP(5)) { __syncthreads(); ph_attn(b, l, sm); } }
        SEAM(pb + 3);
        if (IN(pb + 4) && EN(6)) { LA(b); ph_ssd_out(b, l, sm); if (RP(6)) { __syncthreads(); ph_ssd_out(b, l, sm); } }
        SEAM(pb + 4);
        if (IN(pb + 5) && EN(7)) { LA(b); ph_outproj(b, l, sm); if (RP(7)) { __syncthreads(); ph_outproj(b, l, sm); } }
        SEAM(pb + 5);
        if (IN(pb + 6) && EN(8)) { LA(b); ph_ln1_router(b, l, sm); }
        SEAM(pb + 6);
        if (IN(pb + 7) && EN(9)) { LA(b); ph_gateup(b, l, sm); if (RP(9)) { __syncthreads(); ph_gateup(b, l, sm); } }
        SEAM(pb + 7);
        if (IN(pb + 8) && EN(10)) { LA(b); ph_down(b, l, sm); if (RP(10)) { __syncthreads(); ph_down(b, l, sm); } }
        SEAM(pb + 8);
        if (IN(pb + 9) && EN(11)) { LA(b); ph_ln2(b, l, sm); if (RP(11)) { __syncthreads(); ph_ln2(b, l, sm); } }
        SEAM(pb + 9);
    }
#undef IN
#undef SEAM
}


#ifdef DBG_NANCHK
__global__ void chk_kernel(const void* p, size_t n, int is_bf16, unsigned* flags, int idx) {
    bool bad = false;
    for (size_t i = (size_t)blockIdx.x * blockDim.x + threadIdx.x; i < n; i += (size_t)gridDim.x * blockDim.x) {
        float v = is_bf16 ? __uint_as_float(((unsigned)((const unsigned short*)p)[i]) << 16) : ((const float*)p)[i];
        if (!(fabsf(v) < 1e30f)) bad = true;
    }
    if (bad) atomicOr(&flags[idx], 1u);
}
__global__ void chk_rows(const unsigned short* p, int rows, int cols, unsigned* res) {
    for (int r = blockIdx.x; r < rows; r += gridDim.x) { bool bad = false;
        for (int c = threadIdx.x; c < cols; c += blockDim.x) { const float v = __uint_as_float(((unsigned)p[(size_t)r * cols + c]) << 16); if (!(fabsf(v) < 1e30f)) bad = true; }
        if (__syncthreads_or(bad ? 1 : 0)) { if (threadIdx.x == 0) { atomicMin(&res[0], (unsigned)r); atomicAdd(&res[1], 1u); } } }
}
__global__ void chk_final2(float* out, size_t n, const unsigned* res, const int* gcnt) {
    int tot = 0; for (int e = 0; e < 64; ++e) tot += (gcnt[e] + 255) >> 8;
    float V = DBG_WHICH == 0 ? (float)res[0] : DBG_WHICH == 1 ? (float)res[1] : (float)tot * 256.f;
    for (size_t i = (size_t)blockIdx.x * blockDim.x + threadIdx.x; i < n; i += (size_t)gridDim.x * blockDim.x) out[i] = (i == 0) ? V : 0.f;
}
__global__ void chk_final(float* out, size_t n, const unsigned* flags) {
    int first = 90;
    for (int i = 89; i >= 0; --i) if (flags[i]) first = i;
    const float V = 100.f * (1.f + (float)first);
    for (size_t i = (size_t)blockIdx.x * blockDim.x + threadIdx.x; i < n; i += (size_t)gridDim.x * blockDim.x) out[i] = (i == 0) ? V : 0.f;
}
#endif
extern "C" void kernel_launch(void* const* d_in, const int* in_sizes, int n_in, void* d_out, int out_size, void* d_ws, size_t ws_size, hipStream_t stream) {
    static int grid = 0;
    if (grid == 0) {
        if (n_in != 34 || out_size != NB * SEQ * DM || ws_size < WS_END) { fprintf(stderr, "kernel_launch: unexpected shapes (n_in %d, out %d, ws %zu, need %zu)\n", n_in, out_size, ws_size, (size_t)WS_END); grid = -1; return; }
        int dev = 0, cus = 0, per_cu = 0;
        if (hipGetDevice(&dev) != hipSuccess || hipDeviceGetAttribute(&cus, hipDeviceAttributeMultiprocessorCount, dev) != hipSuccess) { grid = -1; return; }
        if (hipFuncSetAttribute((const void*)fwd, hipFuncAttributeMaxDynamicSharedMemorySize, LDS_BYTES) != hipSuccess) { fprintf(stderr, "kernel_launch: hipFuncSetAttribute failed\n"); grid = -1; return; }
        if (hipOccupancyMaxActiveBlocksPerMultiprocessor(&per_cu, (const void*)fwd, 512, LDS_BYTES) != hipSuccess || per_cu < 1) fprintf(stderr, "kernel_launch: occupancy query says %d\n", per_cu);
        (void)hipGetLastError();
        grid = cus;
    }
    if (grid < 0) return;
    (void)hipMemsetAsync(d_ws, 0, ZERO_BYTES, stream);
    Args a{};
    const float** pp = (const float**)&a;
    for (int i = 0; i < 34; ++i) pp[i] = (const float*)d_in[i];
    a.out = (float*)d_out; a.ws = (unsigned char*)d_ws;
#if N_LAUNCH_MODE == 1
#ifdef DBG_NANCHK
    unsigned* flags = (unsigned*)((unsigned char*)d_ws + WS_CNT + 4096);
    unsigned char* W = (unsigned char*)d_ws;
#define CHK(off, n, isb) hipLaunchKernelGGL(chk_kernel, dim3(1024), dim3(256), 0, stream, (const void*)(W + (off)), (size_t)(n), isb, flags, p)
#endif
    for (int p = 0; p < NPH; ++p) { a.ph_lo = p; a.ph_hi = p + 1; hipLaunchKernelGGL(fwd, dim3(grid), dim3(512), LDS_BYTES, stream, a);
#ifdef DBG_NANCHK
        const int k = p == 0 ? -1 : (p - 1) % 10, l = p == 0 ? 0 : (p - 1) / 10, o = 20 * l;
#undef CHK
#define CHK(off, n, isb, idx) hipLaunchKernelGGL(chk_kernel, dim3(1024), dim3(256), 0, stream, (const void*)(W + (off)), (size_t)(n), isb, flags, idx)
        if (p == 0) CHK(WS_MOD, 2 * 3 * 12288, 0, 1);
        if (p == 0) { CHK(WS_WGU, (size_t)NE1 * 1024 * 2048, 1, 2); CHK(WS_WDN, (size_t)NE1 * 2048 * 512, 1, 3); }
        if (k == 1) { CHK(WS_PROJ, (size_t)MR * NP, 1, o + 4); CHK(WS_DT, (size_t)MR * 16, 0, o + 5); }
        if (k == 2) { CHK(WS_Q, (size_t)MR * 1536, 1, o + 6); CHK(WS_KV, (size_t)MR * 2048, 1, o + 7); CHK(WS_KRR, (size_t)MR * 64, 1, o + 8); CHK(WS_ST, (size_t)NCH * 16 * 8192, 0, o + 9); CHK(WS_DEC, (size_t)NCH * 16, 0, o + 10); }
        if (k == 3) { CHK(WS_HP, (size_t)NCH * 16 * 8192, 1, o + 11); }
        if (k == 4 && l == 0) { CHK(WS_MIX, (size_t)MR * DM, 1, o + 12); }
        if (k == 5) { CHK(WS_Y, (size_t)MR * DM, 0, o + 13); }
        if (k == 6) { CHK(WS_Y, (size_t)MR * DM, 0, o + 14); CHK(WS_HB, (size_t)MR * DM, 1, o + 15); }
        if (k == 7) { CHK(WS_H, (size_t)150000 * 512, 1, o + 16); }
        if (k == DBG_K && l == 0) { hipMemsetAsync(flags + 100, 0x7f, 4, stream); hipLaunchKernelGGL(chk_rows, dim3(2048), dim3(256), 0, stream, (const unsigned short*)(W + WS_O), DBG_ROWS, 2048, flags + 100);
            hipLaunchKernelGGL(chk_final2, dim3(1024), dim3(256), 0, stream, (float*)d_out, (size_t)out_size, (const unsigned*)(flags + 100), (const int*)(W + WS_CNT)); break; }
        if (k == 9 && l == 0) { CHK(WS_XRES, (size_t)MR * DM, 0, o + 18); CHK(WS_HB, (size_t)MR * DM, 1, o + 19); }
#endif
    }
#if 0
    hipLaunchKernelGGL(chk_final, dim3(1024), dim3(256), 0, stream, (float*)d_out, (size_t)out_size, (const unsigned*)flags);
#endif
#else
    a.ph_lo = 0; a.ph_hi = NPH; hipLaunchKernelGGL(fwd, dim3(grid), dim3(512), LDS_BYTES, stream, a);
#endif
    const hipError_t le = hipPeekAtLastError();
    if (le != hipSuccess) fprintf(stderr, "kernel_launch: launch failed: %s\n", hipGetErrorName(le));
}
```

```cpp
#include <hip/hip_runtime.h>
#include <cstdio>
#include <cstdint>

#ifndef DBG_WHICH
#define DBG_WHICH 1
#define DBG_K 8
#define DBG_ROWS 32
#endif
#ifndef N_LAUNCH_MODE
#define N_LAUNCH_MODE 0
#endif

#define DI __device__ __forceinline__
typedef unsigned short bf16_t;
typedef short bf16x8 __attribute__((ext_vector_type(8)));
typedef short s16x4 __attribute__((ext_vector_type(4)));
typedef float f32x16 __attribute__((ext_vector_type(16)));
typedef float f32x4 __attribute__((ext_vector_type(4)));
typedef unsigned u32x4 __attribute__((ext_vector_type(4)));
typedef unsigned u32x2 __attribute__((ext_vector_type(2)));

constexpr int DM = 2048, NB = 2, SEQ = 8192, CTXL = 256, RPB = CTXL + SEQ, MR = NB * RPB;
constexpr int NCH = MR / 128;
constexpr int NP = 3840;
constexpr int PC_GM = 0, PC_Q = 1024, PC_Z = 1792, PC_XBC = 2304, PC_KV = 3328, PC_KR = 3584, PC_DT = 3648;
constexpr int IN_W = 3664;
constexpr int NEXP = 64, NE1 = 65;
constexpr float DN_ALPHA = 1.4142135623730951f;
constexpr int HROWS = 172032;

constexpr size_t al256(size_t x) { return (x + 255) / 256 * 256; }
constexpr size_t WS_BAR = 0;
constexpr size_t WS_CNT = 16384;
constexpr size_t WS_MOD = 32768;
constexpr size_t ZERO_BYTES = 32768;
constexpr size_t WS_MODP = WS_MOD + (size_t)2 * 3 * 12288 * 4;
constexpr size_t WS_RSS = WS_MODP + (size_t)4 * 2 * 3 * 12288 * 4;
constexpr size_t WS_WIN = al256(WS_RSS + (size_t)MR * 16 * 4);
constexpr size_t WS_WQB = WS_WIN + (size_t)NP * 2048 * 2;
constexpr size_t WS_WKVB = WS_WQB + (size_t)1536 * 768 * 2;
constexpr size_t WS_WOUT = WS_WKVB + (size_t)2048 * 256 * 2;
constexpr size_t WS_WGU = WS_WOUT + (size_t)2048 * 2048 * 2;
constexpr size_t WS_WDN = WS_WGU + (size_t)NE1 * 1024 * 2048 * 2;
constexpr size_t WS_WRH = WS_WDN + (size_t)NE1 * 2048 * 512 * 2;
constexpr size_t WS_WRL = WS_WRH + (size_t)64 * 2048 * 2;
constexpr size_t WS_XRES = WS_WRL + (size_t)64 * 2048 * 2;
constexpr size_t WS_HB = WS_XRES + (size_t)MR * DM * 4;
constexpr size_t WS_Y = WS_HB + (size_t)MR * DM * 2;
constexpr size_t WS_H = WS_Y + (size_t)MR * DM * 4;
constexpr size_t WS_LIST = WS_H + (size_t)HROWS * 512 * 2;
constexpr size_t WS_TSLOT = WS_LIST + (size_t)64 * MR * 8;
constexpr size_t WS_O = al256(WS_TSLOT + (size_t)MR * 8 * 8);
constexpr size_t WS_PROJ = WS_O;
constexpr size_t WS_DT = WS_PROJ + (size_t)MR * NP * 2;
constexpr size_t WS_Q = WS_DT + (size_t)MR * 16 * 4;
constexpr size_t WS_KV = WS_Q + (size_t)MR * 1536 * 2;
constexpr size_t WS_KRR = WS_KV + (size_t)MR * 2048 * 2;
constexpr size_t WS_ST = WS_KRR + (size_t)MR * 64 * 2;
constexpr size_t WS_HP = WS_ST + (size_t)NCH * 16 * 8192 * 4;
constexpr size_t WS_DEC = WS_HP + (size_t)NCH * 16 * 8192 * 2;
constexpr size_t WS_MIX = al256(WS_DEC + (size_t)NCH * 16 * 4);
constexpr size_t WS_MIXEND = WS_MIX + (size_t)MR * DM * 2;
constexpr size_t WS_OEND = WS_O + (size_t)HROWS * 2048 * 2;
constexpr size_t WS_W1 = al256(WS_OEND > WS_MIXEND ? WS_OEND : WS_MIXEND);
constexpr size_t WSTRIDE = WS_W1 - WS_WIN;
constexpr size_t WS_END = WS_W1 + (WS_XRES - WS_WIN);

constexpr int LDS_BYTES = 156 * 1024;
constexpr int SM0 = 256;

#define XB_TMO      128
#define XB_XCNT(j)  (256  + 64 * (j))
#define XB_XSUB(j)  (1280 + 64 * (j))
#define XB_XGEN(j)  (2304 + 64 * (j))
#define XB_TOP      3328
#define XB_TOPGEN   3392
#define XCD_BAR_WORDS 3456
#define XB_SPIN_CAP (1u << 18)
#define LAS __attribute__((address_space(3)))

__device__ __forceinline__ unsigned xb_ld(unsigned* p)              { return __hip_atomic_load(p, __ATOMIC_RELAXED, __HIP_MEMORY_SCOPE_AGENT); }
__device__ __forceinline__ unsigned xb_add(unsigned* p, unsigned v) { return __hip_atomic_fetch_add(p, v, __ATOMIC_RELAXED, __HIP_MEMORY_SCOPE_AGENT); }
__device__ __forceinline__ unsigned xb_xcc_id() { return (unsigned)__builtin_amdgcn_s_getreg((3 << 11) | 20) & 0xFu; }
#define XB_SPIN(cond, bar) do { unsigned _sp = 0; while (cond) { __builtin_amdgcn_s_sleep(1); \
    if ((++_sp & 255u) == 0u) { if (xb_ld(&(bar)[XB_TMO])) break; if (_sp > XB_SPIN_CAP) { atomicAdd(&(bar)[XB_TMO], 1u); break; } } } } while (0)

struct XcdBarrier { unsigned* bar; unsigned x; volatile LAS unsigned* st; };

__device__ __forceinline__ XcdBarrier xcd_barrier_post(unsigned* bar, volatile LAS unsigned* st) {
    XcdBarrier b; b.bar = bar; b.x = xb_xcc_id(); b.st = st;
    if (threadIdx.x == 0) (void)xb_add(&bar[XB_XCNT(b.x)], 1u);
    return b;
}
__device__ __forceinline__ void xcd_barrier_complete(unsigned* bar, unsigned x, unsigned& nloc, unsigned& nx) {
    const unsigned G = gridDim.x * gridDim.y * gridDim.z;
    unsigned sum, cnt, mine, sp = 0u;
    for (;;) {
        sum = 0u; cnt = 0u; mine = 0u;
#pragma unroll
        for (unsigned j = 0; j < 16; ++j) { const unsigned c = xb_ld(&bar[XB_XCNT(j)]); sum += c; cnt += (c > 0u) ? 1u : 0u; mine = (j == x) ? c : mine; }
        if (sum == G) break;
        __builtin_amdgcn_s_sleep(1);
        if ((++sp & 255u) == 0u) { if (xb_ld(&bar[XB_TMO])) break; if (sp > XB_SPIN_CAP) { atomicAdd(&bar[XB_TMO], 1u); break; } }
    }
    nloc = mine > 0u ? mine : 1u; nx = cnt > 0u ? cnt : 1u;
}
__device__ __forceinline__ void xcd_barrier(const XcdBarrier& b) {
    asm volatile("s_waitcnt vmcnt(0)" ::: "memory");
    __syncthreads();
    if (threadIdx.x == 0) {
        unsigned* bar = b.bar;
        __builtin_amdgcn_s_waitcnt(0);
        unsigned nloc = b.st[0], nx = b.st[1];
        if (nloc == 0u) { xcd_barrier_complete(bar, b.x, nloc, nx); b.st[0] = nloc; b.st[1] = nx; }
        const unsigned old = xb_add(&bar[XB_XSUB(b.x)], 1u);
        const unsigned gen = old / nloc;
        if (old + 1u == (gen + 1u) * nloc) {
            __builtin_amdgcn_fence(__ATOMIC_RELEASE, "agent");
            asm volatile("s_waitcnt vmcnt(0)" ::: "memory");
            const unsigned og = xb_add(&bar[XB_TOP], 1u);
            const unsigned tg = og / nx;
            if (og + 1u == (tg + 1u) * nx) xb_add(&bar[XB_TOPGEN], 1u);
            else XB_SPIN(xb_ld(&bar[XB_TOPGEN]) == tg, bar);
            __builtin_amdgcn_fence(__ATOMIC_ACQUIRE, "agent");
            xb_add(&bar[XB_XGEN(b.x)], 1u);
            asm volatile("s_waitcnt vmcnt(0)" ::: "memory");
        } else {
            XB_SPIN(xb_ld(&bar[XB_XGEN(b.x)]) == gen, bar);
            __builtin_amdgcn_fence(__ATOMIC_ACQUIRE, "agent");
            asm volatile("s_waitcnt vmcnt(0)" ::: "memory");
        }
    }
    __syncthreads();
}

typedef __bf16 bf16x2_t __attribute__((ext_vector_type(2)));
typedef float f32x2_t __attribute__((ext_vector_type(2)));
DI unsigned cvtpk(float lo, float hi) { f32x2_t v = {lo, hi}; bf16x2_t b = __builtin_convertvector(v, bf16x2_t); return __builtin_bit_cast(unsigned, b); }
DI unsigned pk_fp8(f32x4 v) { int w = __float_as_int(v[0]);
    w = __builtin_amdgcn_cvt_pk_fp8_f32(v[0], v[1], w, false); w = __builtin_amdgcn_cvt_pk_fp8_f32(v[2], v[3], w, true); return (unsigned)w; }
constexpr float MIXS = 16.f;
DI unsigned pk_mix(float a0, float a1, float a2, float a3) { const f32x4 v = {__builtin_amdgcn_fmed3f(a0 * MIXS, -448.f, 448.f), __builtin_amdgcn_fmed3f(a1 * MIXS, -448.f, 448.f), __builtin_amdgcn_fmed3f(a2 * MIXS, -448.f, 448.f), __builtin_amdgcn_fmed3f(a3 * MIXS, -448.f, 448.f)}; return pk_fp8(v); }
DI f32x4 unpk_fp8(unsigned w) { const f32x2_t lo = __builtin_amdgcn_cvt_pk_f32_fp8((int)w, false), hi = __builtin_amdgcn_cvt_pk_f32_fp8((int)w, true); return (f32x4){lo[0], lo[1], hi[0], hi[1]}; }
DI float bf_lo(unsigned w) { return __uint_as_float(w << 16); }
DI float bf_hi(unsigned w) { return __uint_as_float(w & 0xffff0000u); }
DI float bf2f(bf16_t b) { return __uint_as_float(((unsigned)b) << 16); }
DI bf16_t f2bf(float f) { return (bf16_t)(cvtpk(f, 0.f) & 0xffffu); }
DI float silu_f(float x) { return x * __builtin_amdgcn_rcpf(1.f + __expf(-x)); }
DI float gelu_f(float v) {
    const float av = fabsf(v), t = __builtin_amdgcn_rcpf(av * 0.2316418882f + 1.0f);
    float q = t * 0.5307027145f + (-0.7265760135f); q = q * t + 0.7107068705f; q = q * t + (-0.142248368f); q = q * t + 0.127414796f; q = q * t;
    const float e = __builtin_amdgcn_exp2f((v * v) * (-0.72134752044f));
    const float m = v * (q * e);
    return v < 0.f ? m : v - m;
}
DI int crow(int r, int hi) { return (r & 3) + 8 * (r >> 2) + 4 * hi; }
DI int tidx() { int t = threadIdx.x; asm volatile("" : "+v"(t)); return t; }
DI float wave_sum(float v) { for (int o = 32; o >= 1; o >>= 1) v += __shfl_xor(v, o); return v; }

struct Args {
    const float *x, *c, *ctx, *c_ctx, *w_mod, *b_mod, *w_in, *g_q, *w_q_b, *g_kv, *w_kv_b, *conv_w, *conv_b, *a_log, *dt_bias, *d_skip,
                *g_ssm, *g_v, *b_v, *w_sp, *b_sp, *w_out, *ln1_g, *ln1_b, *ln2_g, *ln2_b, *w_router, *b_router, *w_e_gate, *w_e_up,
                *w_e_down, *w_sh_gate, *w_sh_up, *w_sh_down;
    float* out; unsigned char* ws; int ph_lo, ph_hi;
};

template <int MI, int NI, int KS, bool SWAP>
DI void mma_lds(const unsigned char* As, int lda, const unsigned char* Bs, int ldb, f32x16 (&acc)[MI][NI], int r, int h) {
#pragma unroll
    for (int ks = 0; ks < KS; ++ks) {
        bf16x8 a[MI], b[NI];
#pragma unroll
        for (int mi = 0; mi < MI; ++mi) a[mi] = *(const bf16x8*)(As + (mi * 32 + r) * lda + (ks * 16 + h * 8) * 2);
#pragma unroll
        for (int ni = 0; ni < NI; ++ni) b[ni] = *(const bf16x8*)(Bs + (ni * 32 + r) * ldb + (ks * 16 + h * 8) * 2);
#pragma unroll
        for (int mi = 0; mi < MI; ++mi)
#pragma unroll
            for (int ni = 0; ni < NI; ++ni)
                acc[mi][ni] = SWAP ? __builtin_amdgcn_mfma_f32_32x32x16_bf16(b[ni], a[mi], acc[mi][ni], 0, 0, 0)
                                   : __builtin_amdgcn_mfma_f32_32x32x16_bf16(a[mi], b[ni], acc[mi][ni], 0, 0, 0);
    }
}

#define XSWZ(R, kb) ((((kb) ^ (((R) >> 3) & 15))) << 4)
template <int MI, int NI, int KS, bool SWAP, bool SWZA, bool SWZB>
DI void mma_lds_x(const unsigned char* As, int lda, int rowA0, const unsigned char* Bs, int ldb, int rowB0, f32x16 (&acc)[MI][NI], int r, int h) {
#pragma unroll
    for (int ks = 0; ks < KS; ++ks) {
        bf16x8 a[MI], b[NI];
#pragma unroll
        for (int mi = 0; mi < MI; ++mi) a[mi] = *(const bf16x8*)(As + (mi * 32 + r) * lda + (SWZA ? XSWZ(rowA0 + mi * 32 + r, ks * 2 + h) : (ks * 16 + h * 8) * 2));
#pragma unroll
        for (int ni = 0; ni < NI; ++ni) b[ni] = *(const bf16x8*)(Bs + (ni * 32 + r) * ldb + (SWZB ? XSWZ(rowB0 + ni * 32 + r, ks * 2 + h) : (ks * 16 + h * 8) * 2));
#pragma unroll
        for (int mi = 0; mi < MI; ++mi)
#pragma unroll
            for (int ni = 0; ni < NI; ++ni)
                acc[mi][ni] = SWAP ? __builtin_amdgcn_mfma_f32_32x32x16_bf16(b[ni], a[mi], acc[mi][ni], 0, 0, 0)
                                   : __builtin_amdgcn_mfma_f32_32x32x16_bf16(a[mi], b[ni], acc[mi][ni], 0, 0, 0);
    }
}
DI int xswz_off(int R, int s, int ld) { return R * ld + XSWZ(R, s >> 3) + (s & 7) * 2; }

constexpr int GT_LD = 144;
constexpr int GT_BYTES = (256 + 128) * GT_LD;
template <bool SWAP, class AR, class EP>
DI void gemm_tile(unsigned char* sm, const AR& arow, const bf16_t* Bt, size_t ldb, int K, const EP& ep) {
    const int tid = tidx(), wave = tid >> 6, lane = tid & 63, r = lane & 31, h = lane >> 5, wm = wave >> 1, wn = wave & 1;
    unsigned char* As = sm; unsigned char* Bs = sm + 256 * GT_LD;
    const int lr = tid >> 3, kc = (tid & 7) * 8;
    const bf16_t* ap[4]; const bf16_t* bp[2];
#pragma unroll
    for (int i = 0; i < 4; ++i) ap[i] = arow(lr + 64 * i) + kc;
#pragma unroll
    for (int i = 0; i < 2; ++i) bp[i] = Bt + (size_t)(lr + 64 * i) * ldb + kc;
    u32x4 ra[4], rb[2];
#pragma unroll
    for (int i = 0; i < 4; ++i) ra[i] = *(const u32x4*)(ap[i]);
#pragma unroll
    for (int i = 0; i < 2; ++i) rb[i] = *(const u32x4*)(bp[i]);
    f32x16 acc[2][2];
#pragma unroll
    for (int i = 0; i < 2; ++i)
#pragma unroll
        for (int j = 0; j < 2; ++j)
#pragma unroll
            for (int q = 0; q < 16; ++q) acc[i][j][q] = 0.f;
    const int nk = K >> 6;
    for (int kt = 0; kt < nk; ++kt) {
        __syncthreads();
#pragma unroll
        for (int i = 0; i < 4; ++i) *(u32x4*)(As + (lr + 64 * i) * GT_LD + kc * 2) = ra[i];
#pragma unroll
        for (int i = 0; i < 2; ++i) *(u32x4*)(Bs + (lr + 64 * i) * GT_LD + kc * 2) = rb[i];
        __syncthreads();
        if (kt + 1 < nk) {
#pragma unroll
            for (int i = 0; i < 4; ++i) ra[i] = *(const u32x4*)(ap[i] + (kt + 1) * 64);
#pragma unroll
            for (int i = 0; i < 2; ++i) rb[i] = *(const u32x4*)(bp[i] + (kt + 1) * 64);
        }
        mma_lds<2, 2, 4, SWAP>(As + wm * 64 * GT_LD, GT_LD, Bs + wn * 64 * GT_LD, GT_LD, acc, r, h);
    }
    ep(acc, wm, wn, r, h);
}


namespace g8 {
typedef int i32x4_t __attribute__((ext_vector_type(4)));
typedef int i32x8_t __attribute__((ext_vector_type(8)));
constexpr int BM = 256, BK = 64, HALF = 128, HTB = HALF * BK * 2, STAGE_BYTES = 8 * HTB;
DI int lds_byte(int r, int c) { const int st = (r >> 4) * 2 + (c >> 5), rr = r & 15, cc = c & 31, ob = rr * 64 + cc * 2; return st * 1024 + (ob ^ (((ob >> 9) & 1) << 5)); }
DI void stage_rc(int b, int& R, int& C) { const int st = b / 1024, sb = b % 1024, swz = sb ^ (((sb >> 9) & 1) << 5); R = (st >> 1) * 16 + swz / 64; C = (st & 1) * 32 + (swz % 64) / 2; }
DI int perm32(int rho) { const int n = rho >> 4, i = rho & 15; return 8 * (i >> 2) + 4 * n + (i & 3); }
struct Unit { const char* Ab; const char* Bb; int p0, p1, p2; };
template <class Epi, class Sched>
DI void gemm(unsigned char* lds_generic, const int K, const int ldb  , const Sched& S, const Epi& E) {
    LAS unsigned char* lds = (LAS unsigned char*)lds_generic;
    const int tid = tidx(), wid = __builtin_amdgcn_readfirstlane(tid >> 6), lane = tid & 63, wr = wid >> 2, wc = wid & 3, fr = lane & 15, fq = lane >> 4;
    const int nt = K / BK;
    int R0, C0, R1, C1; stage_rc(tid * 16, R0, C0); stage_rc(tid * 16 + 8192, R1, C1);
    unsigned voffB[2];
    { int Rb[2]; const int Rs[2] = {R0, R1};
#pragma unroll
      for (int i = 0; i < 2; ++i) { const int R = Rs[i], x = R & 31;
          Rb[i] = Epi::ADJ16 ? 64 * (R >> 5) + 16 * ((x >> 2) & 3) + 4 * (x >> 4) + (x & 3) : (Epi::PERM ? (R & ~31) + perm32(x) : R); }
      voffB[0] = (unsigned)(Rb[0] * ldb + C0) * 2u; voffB[1] = (unsigned)(Rb[1] * ldb + C1) * 2u; }
    const size_t hstepB = (size_t)(Epi::ADJ16 ? 8 : HALF) * ldb * 2;
    const unsigned ldsw = (unsigned)wid * 1024u;
    const int aoff = lds_byte(wr * 64 + fr, fq * 8), boff = lds_byte(wc * 32 + fr, fq * 8);
#define G8_SA(b, h) (((b) * 2 + (h)) * HTB)
#define G8_SB(b, h) ((4 + (b) * 2 + (h)) * HTB)
#define G8_STA(bufoff, U, AO, h, kb) do { _Pragma("unroll") for (int _i = 0; _i < 2; ++_i) \
        __builtin_amdgcn_global_load_lds((const unsigned*)((U).Ab + (kb) + (AO)[h][_i]), (LAS unsigned*)(lds + (bufoff) + ldsw + _i * 8192), 16, 0, 0); } while (0)
#define G8_STB(bufoff, U, h, kb) do { _Pragma("unroll") for (int _i = 0; _i < 2; ++_i) \
        __builtin_amdgcn_global_load_lds((const unsigned*)((U).Bb + (kb) + (h) * hstepB + voffB[_i]), (LAS unsigned*)(lds + (bufoff) + ldsw + _i * 8192), 16, 0, 0); } while (0)
#define G8_LD8(addr) __builtin_shufflevector(*(const LAS i32x4_t*)(addr), *(const LAS i32x4_t*)((addr) + 1024), 0, 1, 2, 3, 4, 5, 6, 7)
#define G8_LDA(dst, b, h) do { _Pragma("unroll") for (int m = 0; m < 4; ++m) dst[m] = G8_LD8(lds + G8_SA(b, h) + aoff + m * 2048); } while (0)
#define G8_LDB(dst, b, h) do { _Pragma("unroll") for (int n = 0; n < 2; ++n) dst[n] = G8_LD8(lds + G8_SB(b, h) + boff + n * 2048); } while (0)
#define G8_LO(x) __builtin_bit_cast(bf16x8, __builtin_shufflevector(x, x, 0, 1, 2, 3))
#define G8_HI(x) __builtin_bit_cast(bf16x8, __builtin_shufflevector(x, x, 4, 5, 6, 7))
#define G8_MMA(ai, bj, At, Bt) do { __builtin_amdgcn_s_setprio(1); \
        if constexpr (Epi::FP8) { _Pragma("unroll") for (int m = 0; m < 4; ++m) _Pragma("unroll") for (int n = 0; n < 2; ++n) \
            asm volatile("v_mfma_scale_f32_16x16x128_f8f6f4 %0, %1, %2, %0, %4, %3 op_sel_hi:[0,0,0]" : "+v"(acc[ai][bj][m][n]) : "v"(Bt[n]), "v"(At[m]), "v"(fp8_unit_scale), "v"(fp8_w_scale)); } \
        else { _Pragma("unroll") for (int m = 0; m < 4; ++m) _Pragma("unroll") for (int n = 0; n < 2; ++n) { \
            acc[ai][bj][m][n] = __builtin_amdgcn_mfma_f32_16x16x32_bf16(G8_LO(Bt[n]), G8_LO(At[m]), acc[ai][bj][m][n], 0, 0, 0); \
            acc[ai][bj][m][n] = __builtin_amdgcn_mfma_f32_16x16x32_bf16(G8_HI(Bt[n]), G8_HI(At[m]), acc[ai][bj][m][n], 0, 0, 0); } } \
        __builtin_amdgcn_s_setprio(0); } while (0)
#define G8_WAIT_V(n) asm volatile("s_waitcnt vmcnt(" #n ")" ::: "memory")
#define G8_WAIT_L(n) asm volatile("s_waitcnt lgkmcnt(" #n ")" ::: "memory")
#define G8_BAR __builtin_amdgcn_s_barrier()
#define G8_SCHED __builtin_amdgcn_sched_barrier(0)
    Unit cur, nxt; int ui = 0; unsigned aoC[2][2], aoN[2][2];
    if (!Sched::GATHER) { S.lane_offsets(aoC, R0, C0, R1, C1); }
    if (!S.next(0, cur, aoC, R0, C0, R1, C1)) return;
    f32x4 acc[2][2][4][2];
#pragma unroll
    for (int a = 0; a < 2; ++a)
#pragma unroll
        for (int b = 0; b < 2; ++b)
#pragma unroll
            for (int m = 0; m < 4; ++m)
#pragma unroll
                for (int n = 0; n < 2; ++n) acc[a][b][m][n] = (f32x4){0.f, 0.f, 0.f, 0.f};
    i32x8_t At[4], B0[2], B1[2];
    int fp8_unit_scale = 0x7f7f7f7f, fp8_w_scale = Epi::WSC * 0x01010101; asm volatile("" : "+v"(fp8_unit_scale), "+v"(fp8_w_scale));
    G8_STB(G8_SB(0, 0), cur, 0, 0); G8_STA(G8_SA(0, 0), cur, aoC, 0, 0); G8_STB(G8_SB(0, 1), cur, 1, 0); G8_STA(G8_SA(0, 1), cur, aoC, 1, 0);
    if (wr == 1) G8_BAR;
    G8_WAIT_V(4); G8_BAR;
    G8_STB(G8_SB(1, 0), cur, 0, 128); G8_STA(G8_SA(1, 0), cur, aoC, 0, 128); G8_STB(G8_SB(1, 1), cur, 1, 128);
    G8_WAIT_V(6); G8_BAR;
    for (;;) {
        const bool has_next = S.next(ui + 1, nxt, aoN, R0, C0, R1, C1);
        if (!has_next) { nxt = cur; if (Sched::GATHER) { aoN[0][0] = aoC[0][0]; aoN[0][1] = aoC[0][1]; aoN[1][0] = aoC[1][0]; aoN[1][1] = aoC[1][1]; } }
#pragma unroll 1
        for (int t = 0; t < nt; t += 2) {
            const bool last = (t == nt - 2);
            const size_t k1 = (size_t)(t + 1) * 128, k2 = last ? 0 : (size_t)(t + 2) * 128, k3 = k2 + 128;
            Unit U2; U2.Ab = last ? nxt.Ab : cur.Ab; U2.Bb = last ? nxt.Bb : cur.Bb; unsigned ao2[2][2];
            if (Sched::GATHER) { ao2[0][0] = last ? aoN[0][0] : aoC[0][0]; ao2[0][1] = last ? aoN[0][1] : aoC[0][1]; ao2[1][0] = last ? aoN[1][0] : aoC[1][0]; ao2[1][1] = last ? aoN[1][1] : aoC[1][1]; }
            else { ao2[0][0] = aoC[0][0]; ao2[0][1] = aoC[0][1]; ao2[1][0] = aoC[1][0]; ao2[1][1] = aoC[1][1]; }
            G8_LDB(B0, 0, 0); G8_SCHED; G8_LDA(At, 0, 0); G8_STA(G8_SA(1, 1), cur, aoC, 1, k1);
            G8_WAIT_L(8); G8_BAR; G8_WAIT_L(0); G8_MMA(0, 0, At, B0); G8_BAR; G8_SCHED;
            G8_LDB(B1, 0, 1); G8_STB(G8_SB(0, 0), U2, 0, k2);
            G8_BAR; G8_WAIT_L(0); G8_MMA(0, 1, At, B1); G8_BAR;
            G8_LDA(At, 0, 1); G8_STA(G8_SA(0, 0), U2, ao2, 0, k2);
            G8_BAR; G8_WAIT_L(0); G8_MMA(1, 0, At, B0); G8_BAR; G8_SCHED;
            G8_STB(G8_SB(0, 1), U2, 1, k2);
            G8_WAIT_V(6); G8_BAR; G8_MMA(1, 1, At, B1); G8_BAR;
            G8_LDB(B0, 1, 0); G8_SCHED; G8_LDA(At, 1, 0); G8_STA(G8_SA(0, 1), U2, ao2, 1, k2);
            G8_WAIT_L(8); G8_BAR; G8_WAIT_L(0); G8_MMA(0, 0, At, B0); G8_BAR; G8_SCHED;
            G8_LDB(B1, 1, 1); G8_STB(G8_SB(1, 0), U2, 0, k3);
            G8_BAR; G8_WAIT_L(0); G8_MMA(0, 1, At, B1); G8_BAR;
            G8_LDA(At, 1, 1); G8_STA(G8_SA(1, 0), U2, ao2, 0, k3);
            G8_BAR; G8_WAIT_L(0); G8_MMA(1, 0, At, B0); G8_BAR; G8_SCHED;
            G8_STB(G8_SB(1, 1), U2, 1, k3);
            G8_WAIT_V(6); G8_BAR; G8_MMA(1, 1, At, B1); G8_BAR;
        }
        if constexpr (Epi::FP8) {
#define G8_F8(a, b) "+v"(acc[a][b][0][0]), "+v"(acc[a][b][0][1]), "+v"(acc[a][b][1][0]), "+v"(acc[a][b][1][1]), "+v"(acc[a][b][2][0]), "+v"(acc[a][b][2][1]), "+v"(acc[a][b][3][0]), "+v"(acc[a][b][3][1])
            asm volatile("s_nop 15\n\ts_nop 15" : G8_F8(0, 0), G8_F8(0, 1)); asm volatile("" : G8_F8(1, 0), G8_F8(1, 1));
#undef G8_F8
            __builtin_amdgcn_sched_barrier(0); }
        E(acc, cur, wr, wc, fr, fq);
        if (!has_next) break;
#pragma unroll
        for (int a = 0; a < 2; ++a)
#pragma unroll
            for (int b = 0; b < 2; ++b)
#pragma unroll
                for (int m = 0; m < 4; ++m)
#pragma unroll
                    for (int n = 0; n < 2; ++n) acc[a][b][m][n] = (f32x4){0.f, 0.f, 0.f, 0.f};
        cur = nxt; ++ui;
        if (Sched::GATHER) { aoC[0][0] = aoN[0][0]; aoC[0][1] = aoN[0][1]; aoC[1][0] = aoN[1][0]; aoC[1][1] = aoN[1][1]; }
    }
    G8_WAIT_V(0);
    if (wr == 0) G8_BAR;
    G8_BAR;
#undef G8_SA
#undef G8_SB
#undef G8_STA
#undef G8_STB
#undef G8_LDA
#undef G8_LDB
#undef G8_MMA
#undef G8_LO
#undef G8_HI
#undef G8_LD8
#undef G8_WAIT_V
#undef G8_WAIT_L
#undef G8_BAR
#undef G8_SCHED
}
struct DenseSched { static constexpr bool GATHER = false; const bf16_t* A; const bf16_t* Bt; int lda, ldb, nN, total, G, c, skipctx;
    DI void lane_offsets(unsigned (&ao)[2][2], int R0, int C0, int R1, int C1) const {
        ao[0][0] = (unsigned)(R0 * lda + C0) * 2u; ao[0][1] = (unsigned)(R1 * lda + C1) * 2u; ao[1][0] = (unsigned)((R0 + 128) * lda + C0) * 2u; ao[1][1] = (unsigned)((R1 + 128) * lda + C1) * 2u; }
    DI bool next(int i, Unit& u, unsigned (&ao)[2][2], int R0, int C0, int R1, int C1) const {
        const int L = i * G + c; if (L >= total) return false;
        int wgid = L; { const int q = total / 8, r = total % 8, xcd = wgid % 8, off = wgid / 8; wgid = (xcd < r ? xcd * (q + 1) : r * (q + 1) + (xcd - r) * q) + off; }
        const int nM = total / nN, nig = 8 * nN, gid = wgid / nig, fm = gid * 8, gsz = (nM - fm) < 8 ? (nM - fm) : 8;
        int pm = fm + ((wgid % nig) % gsz); const int pn = (wgid % nig) / gsz;
        if (skipctx) pm += 1 + (pm >= 32 ? 1 : 0);
        u.Ab = (const char*)(A + (size_t)pm * 256 * lda); u.Bb = (const char*)(Bt + (size_t)pn * 256 * ldb);
        u.p0 = pm; u.p1 = pn; u.p2 = 0; return true; } };
}

struct EpiInproj8 { static constexpr int WSC = 121; static constexpr bool PERM = true, ADJ16 = false, FP8 = true; bf16_t* proj; float* dtb; float* rowss; float inv; unsigned char* q8; float* vst; unsigned char* kv8;
    DI void operator()(const f32x4 (&acc)[2][2][4][2], const g8::Unit& u, int wr, int wc, int fr, int fq) const {
        const int pn = __builtin_amdgcn_readfirstlane(u.p1), row0 = u.p0 * 256 + wr * 64 + fr, colb = pn * 256 + wc * 32 + 8 * fq;
        const bool isq = (pn >= 4 && pn <= 6), iskv = (pn == 13), isv = (pn == 2 || pn == 3), isg = pn < 4, isdt = pn == 14;
#pragma unroll
        for (int ai = 0; ai < 2; ++ai)
#pragma unroll
            for (int m = 0; m < 4; ++m) { const int row = row0 + ai * 128 + m * 16; float ss = 0.f, sv = 0.f;
#pragma unroll
                for (int bj = 0; bj < 2; ++bj) { const int col = colb + bj * 128; f32x4 v0 = acc[ai][bj][m][0], v1 = acc[ai][bj][m][1];
                    if (isg) {
#pragma unroll
                        for (int j = 0; j < 4; ++j) { v0[j] = gelu_f(v0[j]); v1[j] = gelu_f(v1[j]); } }
                    u32x4 w; w.x = cvtpk(v0[0], v0[1]); w.y = cvtpk(v0[2], v0[3]); w.z = cvtpk(v1[0], v1[1]); w.w = cvtpk(v1[2], v1[3]);
                    *(u32x4*)(proj + (size_t)row * NP + col) = w;
                    if (isq) { u32x2 w8; w8.x = pk_fp8(v0); w8.y = pk_fp8(v1); *(u32x2*)(q8 + (size_t)row * 768 + (col - PC_Q)) = w8; }
                    if (iskv) { u32x2 w8; w8.x = pk_fp8(v0); w8.y = pk_fp8(v1); *(u32x2*)(kv8 + (size_t)row * 256 + (col - PC_KV)) = w8; }
                    if (isdt && col >= PC_DT && col < PC_DT + 16) { *(f32x4*)(dtb + (size_t)row * 16 + (col - PC_DT)) = v0; *(f32x4*)(dtb + (size_t)row * 16 + (col - PC_DT) + 4) = v1; }
                    ss += (v0[0] * v0[0] + v0[1] * v0[1]) + (v0[2] * v0[2] + v0[3] * v0[3]) + (v1[0] * v1[0] + v1[1] * v1[1]) + (v1[2] * v1[2] + v1[3] * v1[3]);
                    sv += ((v0[0] + v0[1]) + (v0[2] + v0[3])) + ((v1[0] + v1[1]) + (v1[2] + v1[3])); }
                if (isq || iskv) { ss += __shfl_xor(ss, 16); ss += __shfl_xor(ss, 32); if (fq == 0) rowss[(size_t)row * 16 + (iskv ? 12 : (pn - 4) * 4) + wc] = ss; }
                if (isv) { ss += __shfl_xor(ss, 16); ss += __shfl_xor(ss, 32); sv += __shfl_xor(sv, 16); sv += __shfl_xor(sv, 32); if (fq == 0) { vst[(size_t)row * 16 + (pn - 2) * 4 + wc] = sv; vst[(size_t)row * 16 + 8 + (pn - 2) * 4 + wc] = ss; } }
                __builtin_amdgcn_sched_barrier(0); }
    } };


struct EpiRowScale8 { static constexpr int WSC = 121; static constexpr bool PERM = true, ADJ16 = false, FP8 = true; bf16_t* out; int ldo; const float* rss; float invK; int s0, ns;
    DI void operator()(const f32x4 (&acc)[2][2][4][2], const g8::Unit& u, int wr, int wc, int fr, int fq) const {
        const int row0 = u.p0 * 256 + wr * 64 + fr, colb = u.p1 * 256 + wc * 32 + 8 * fq;
#pragma unroll
        for (int ai = 0; ai < 2; ++ai)
#pragma unroll
            for (int m = 0; m < 4; ++m) { const int row = row0 + ai * 128 + m * 16; float ssum = 0.f;
                { const f32x4* rp = (const f32x4*)(rss + (size_t)row * 16 + s0); for (int t = 0; t < ns; t += 4) { const f32x4 pv = rp[t >> 2]; ssum += (pv[0] + pv[1]) + (pv[2] + pv[3]); } }
                const float sc = rsqrtf(ssum * invK + 1e-6f);
#pragma unroll
                for (int bj = 0; bj < 2; ++bj) { const f32x4 v0 = acc[ai][bj][m][0] * sc, v1 = acc[ai][bj][m][1] * sc;
                    u32x4 w; w.x = cvtpk(v0[0], v0[1]); w.y = cvtpk(v0[2], v0[3]); w.z = cvtpk(v1[0], v1[1]); w.w = cvtpk(v1[2], v1[3]);
                    *(u32x4*)(out + (size_t)row * ldo + colb + bj * 128) = w; } }
    } };
struct EpiKn8 { static constexpr int WSC = 121; static constexpr bool PERM = true, ADJ16 = false, FP8 = true; unsigned char* out; const float* rss;
    DI void operator()(const f32x4 (&acc)[2][2][4][2], const g8::Unit& u, int wr, int wc, int fr, int fq) const {
        const int row0 = u.p0 * 256 + wr * 64 + fr, colb = u.p1 * 256 + wc * 32 + 8 * fq;
#pragma unroll
        for (int ai = 0; ai < 2; ++ai)
#pragma unroll
            for (int m = 0; m < 4; ++m) { const int row = row0 + ai * 128 + m * 16;
                const f32x4 pv = *(const f32x4*)(rss + (size_t)row * 16 + 12); const float sc = rsqrtf(((pv[0] + pv[1]) + (pv[2] + pv[3])) * (1.f / 256.f) + 1e-6f);
#pragma unroll
                for (int bj = 0; bj < 2; ++bj) { u32x2 w; w.x = pk_fp8(acc[ai][bj][m][0] * sc); w.y = pk_fp8(acc[ai][bj][m][1] * sc);
                    *(u32x2*)(out + (size_t)row * 1024 + colb + bj * 128) = w; } }
    } };
struct EpiVt8 { static constexpr int WSC = 121; static constexpr bool PERM = true, ADJ16 = false, FP8 = true; unsigned char* vt; const float* rss;
    DI void operator()(const f32x4 (&acc)[2][2][4][2], const g8::Unit& u, int wr, int wc, int fr, int fq) const {
        const int f0 = u.p0 * 256 + wr * 64 + fr, tokb = u.p1 * 256 + wc * 32 + 8 * fq;
#pragma unroll
        for (int bj = 0; bj < 2; ++bj) { const int tok0 = tokb + bj * 128; f32x4 s0, s1;
#pragma unroll
            for (int t = 0; t < 8; ++t) { const f32x4 pv = *(const f32x4*)(rss + (size_t)(tok0 + t) * 16 + 12); const float sc = rsqrtf(((pv[0] + pv[1]) + (pv[2] + pv[3])) * (1.f / 256.f) + 1e-6f);
                if (t < 4) s0[t] = sc; else s1[t - 4] = sc; }
            const int kap = tok0 & 63; unsigned char* tb = vt + (size_t)(tok0 >> 6) * 65536 + (kap >> 5) * 16 + ((kap & 31) >> 3) * 4;
#pragma unroll
            for (int ai = 0; ai < 2; ++ai)
#pragma unroll
                for (int m = 0; m < 4; ++m) { const int f = f0 + ai * 128 + m * 16; unsigned char* p = tb + (size_t)f * 64;
                    *(unsigned*)p = pk_fp8(acc[ai][bj][m][0] * s0); *(unsigned*)(p + 32) = pk_fp8(acc[ai][bj][m][1] * s1); } }
    } };
struct EpiOut8 { static constexpr int WSC = 117; static constexpr bool PERM = true, ADJ16 = false, FP8 = true; bf16_t* M; float inv;
    DI void operator()(const f32x4 (&acc)[2][2][4][2], const g8::Unit& u, int wr, int wc, int fr, int fq) const {
        const int row0 = u.p0 * 256 + wr * 64 + fr, colb = u.p1 * 256 + wc * 32 + 8 * fq;
#pragma unroll
        for (int ai = 0; ai < 2; ++ai)
#pragma unroll
            for (int m = 0; m < 4; ++m) { const size_t ro = (size_t)(row0 + ai * 128 + m * 16) * DM;
#pragma unroll
                for (int bj = 0; bj < 2; ++bj) { const f32x4 v0 = acc[ai][bj][m][0], v1 = acc[ai][bj][m][1];
                    u32x4 w; w.x = cvtpk(v0[0], v0[1]); w.y = cvtpk(v0[2], v0[3]); w.z = cvtpk(v1[0], v1[1]); w.w = cvtpk(v1[2], v1[3]);
                    *(u32x4*)(M + ro + colb + bj * 128) = w; } }
    } };
DI int moe_unit(int i, int G, int c, int total) {
    if (G & 7) { const int L = i * G + c; return L < total ? L : -1; }
    const int x = c & 7, slot = c >> 3, ns = G >> 3, q = total >> 3, r = total & 7;
    const int start = x * q + (x < r ? x : r), len = q + (x < r ? 1 : 0), k = i * ns + slot;
    return k < len ? start + k : -1;
}
struct MoeDownSched { static constexpr bool GATHER = false; const bf16_t* H; const bf16_t* W; const int* mtoff; int total, G, c;
    DI void lane_offsets(unsigned (&ao)[2][2], int R0, int C0, int R1, int C1) const {
        ao[0][0] = (unsigned)(R0 * 256 + C0) * 2u; ao[0][1] = (unsigned)(R1 * 256 + C1) * 2u; ao[1][0] = (unsigned)((R0 + 128) * 256 + C0) * 2u; ao[1][1] = (unsigned)((R1 + 128) * 256 + C1) * 2u; }
    DI bool next(int i, g8::Unit& u, unsigned (&ao)[2][2], int R0, int C0, int R1, int C1) const {
        const int L = moe_unit(i, G, c, total); if (L < 0) return false;
        const int pn = L & 7, mtg = L >> 3; const int e = ((const unsigned char*)(mtoff + 144))[mtg];
        u.Ab = (const char*)(H + (size_t)mtg * 256 * 256); u.Bb = (const char*)(W + ((size_t)e * 2048 + pn * 256) * 256);
        u.p0 = mtg; u.p1 = pn; u.p2 = e; return true; } };
struct EpiDown8 { static constexpr int WSC = 121; static constexpr bool PERM = true, ADJ16 = true, FP8 = true; unsigned char* O; float inv;
    DI void operator()(const f32x4 (&acc)[2][2][4][2], const g8::Unit& u, int wr, int wc, int fr, int fq) const {
        const int row0 = u.p0 * 256 + wr * 64 + fr, colb = u.p1 * 256 + wc * 64 + 16 * fq;
#pragma unroll
        for (int ai = 0; ai < 2; ++ai)
#pragma unroll
            for (int m = 0; m < 4; ++m) { u32x4 w; w.x = pk_fp8(acc[ai][0][m][0]); w.y = pk_fp8(acc[ai][0][m][1]); w.z = pk_fp8(acc[ai][1][m][0]); w.w = pk_fp8(acc[ai][1][m][1]);
                *(u32x4*)(O + (size_t)(row0 + ai * 128 + m * 16) * DM + colb) = w; }
    } };
struct ListEnt { int row; float w; };
struct MoeGUSched { static constexpr bool GATHER = true; const bf16_t* tok; const bf16_t* W; const int* mtoff; const int* gcnt; const ListEnt* list; int total, G, c, l;
    DI void lane_offsets(unsigned (&ao)[2][2], int, int, int, int) const {}
    DI bool next(int i, g8::Unit& u, unsigned (&ao)[2][2], int R0, int C0, int R1, int C1) const {
        const int L = moe_unit(i, G, c, total); if (L < 0) return false;
        const int pn = L & 3, mtg = L >> 2; const int e = ((const unsigned char*)(mtoff + 144))[mtg];
        const int mt = mtg - mtoff[e], cnt = mtoff[72 + e];
        const int Rr[2] = {R0, R1}, Cc[2] = {C0, C1};
#pragma unroll
        for (int h = 0; h < 2; ++h)
#pragma unroll
            for (int q = 0; q < 2; ++q) { const int pos = mt * 256 + h * 128 + Rr[q]; const int pc = pos < cnt ? pos : 0;
                int row = list[(size_t)(e < 64 ? e : 0) * MR + pc].row;
                const int srow = l == 0 ? pc : (pc < SEQ ? CTXL + pc : RPB + CTXL + (pc - SEQ));
                row = e < 64 ? row : srow; row = pos < cnt ? row : 0;
                row = (row < 0 || row >= MR) ? 0 : row;
                ao[h][q] = (unsigned)(row * 1024 + Cc[q]) * 2u; }
        u.Ab = (const char*)tok; u.Bb = (const char*)(W + ((size_t)e * 1024 + pn * 256) * 1024);
        u.p0 = mtg; u.p1 = pn; u.p2 = e; return true; } };
struct EpiGU8 { static constexpr int WSC = 121; static constexpr bool PERM = true, ADJ16 = false, FP8 = true; unsigned char* H; float inv;
    DI void operator()(const f32x4 (&acc)[2][2][4][2], const g8::Unit& u, int wr, int wc, int fr, int fq) const {
        const int row0 = u.p0 * 256 + wr * 64 + fr, colb = u.p1 * 128 + wc * 32 + 8 * fq;
#pragma unroll
        for (int ai = 0; ai < 2; ++ai)
#pragma unroll
            for (int m = 0; m < 4; ++m) { float o[8];
#pragma unroll
                for (int n = 0; n < 2; ++n)
#pragma unroll
                    for (int j = 0; j < 4; ++j) o[n * 4 + j] = silu_f(acc[ai][0][m][n][j]) * acc[ai][1][m][n][j];
                u32x2 w; w.x = pk_fp8((f32x4){o[0], o[1], o[2], o[3]}); w.y = pk_fp8((f32x4){o[4], o[5], o[6], o[7]});
                *(u32x2*)(H + (size_t)(row0 + ai * 128 + m * 16) * 512 + colb) = w; }
    } };

DI void ph_mod(const Args& a, unsigned char* sm) {
    const int tid = tidx(), wave = tid >> 6, lane = tid & 63;
    float* sv = (float*)sm;
    float* red = (float*)(sm + 8192);
    float* modp = (float*)(a.ws + WS_MODP);
    for (int u = blockIdx.x; u < 2 * 48 * 4; u += gridDim.x) {
        const int kb = u & 3, cb = (u >> 2) % 48, l = u / 192;
        __syncthreads();
        for (int i = tid; i < 3 * 512; i += 512) { const int rr = i >> 9, k = i & 511; const float c = (rr < 2) ? a.c[rr * DM + kb * 512 + k] : a.c_ctx[kb * 512 + k]; sv[i] = silu_f(c); }
        __syncthreads();
        const float* W = a.w_mod + ((size_t)l * DM + kb * 512 + wave * 64) * 12288 + cb * 256 + lane * 4;
        float acc[3][4];
#pragma unroll
        for (int i = 0; i < 3; ++i)
#pragma unroll
            for (int j = 0; j < 4; ++j) acc[i][j] = 0.f;
#pragma unroll 8
        for (int k = 0; k < 64; ++k) {
            const f32x4 w = __builtin_nontemporal_load((const f32x4*)(W + (size_t)k * 12288));
#pragma unroll
            for (int rr = 0; rr < 3; ++rr) { const float s = sv[rr * 512 + wave * 64 + k];
#pragma unroll
                for (int j = 0; j < 4; ++j) acc[rr][j] += s * w[j]; }
        }
#pragma unroll
        for (int rr = 0; rr < 3; ++rr)
#pragma unroll
            for (int j = 0; j < 4; ++j) red[(wave * 3 + rr) * 256 + lane * 4 + j] = acc[rr][j];
        __syncthreads();
        for (int i = tid; i < 768; i += 512) {
            const int rr = i >> 8, c = i & 255; float s = 0.f;
#pragma unroll
            for (int w = 0; w < 8; ++w) s += red[(w * 3 + rr) * 256 + c];
            if (kb == 0) s += a.b_mod[(size_t)l * 12288 + cb * 256 + c];
            modp[(((size_t)kb * 2 + l) * 3 + rr) * 12288 + cb * 256 + c] = s;
        }
    }
}

template <class Map>
DI void convT(unsigned char* sm, bf16_t* dst, int N, int K, const Map map, const float* ksc) {
    const int tid = tidx(); const int nkt = K >> 7; const int ntiles = (N >> 6) * nkt;
    unsigned* T = (unsigned*)sm;
    const size_t ld = (size_t)Map::LD;
    const int n4 = (tid & 15) * 4, kr = tid >> 4;
    f32x4 v[4]; bool ok = true;
    auto load_tile = [&](int t) {
        const int n0 = (t / nkt) << 6, k0 = (t % nkt) << 7;
        const float* src = map(n0 + n4); ok = src != nullptr; if (!ok) src = map(0);
        const float* p = src + (size_t)(k0 + kr) * ld;
#pragma unroll
        for (int i = 0; i < 4; ++i) v[i] = __builtin_nontemporal_load((const f32x4*)(p + (size_t)(32 * i) * ld));
        if (!ok) {
#pragma unroll
            for (int i = 0; i < 4; ++i) v[i] = (f32x4){0.f, 0.f, 0.f, 0.f}; }
        if (ksc) {
#pragma unroll
            for (int i = 0; i < 4; ++i) v[i] *= ksc[k0 + kr + 32 * i]; }
    };
    int t = blockIdx.x;
    if (t < ntiles) load_tile(t);
    for (; t < ntiles; t += gridDim.x) {
        const int n0 = (t / nkt) << 6, k0 = (t % nkt) << 7;
        __syncthreads();
#pragma unroll
        for (int i = 0; i < 4; ++i) { const int k = kr + 32 * i; u32x2 w; w.x = cvtpk(v[i][0], v[i][1]); w.y = cvtpk(v[i][2], v[i][3]);
            *(u32x2*)(T + k * 32 + ((n4 >> 1) ^ (4 * ((k >> 3) & 7)))) = w; }
        if (t + (int)gridDim.x < ntiles) load_tile(t + gridDim.x);
        __syncthreads();
#pragma unroll
        for (int i = 0; i < 2; ++i) { const int idx = tid + i * 512, nr = idx >> 4, kc = idx & 15;
            const unsigned short* Th = (const unsigned short*)T + (size_t)(kc * 8) * 64 + ((((nr >> 1) ^ (4 * (kc & 7))) << 1) | (nr & 1));
            u32x4 w; w.x = (unsigned)Th[0] | ((unsigned)Th[64] << 16); w.y = (unsigned)Th[128] | ((unsigned)Th[192] << 16); w.z = (unsigned)Th[256] | ((unsigned)Th[320] << 16); w.w = (unsigned)Th[384] | ((unsigned)Th[448] << 16);
            *(u32x4*)(dst + (size_t)(n0 + nr) * K + k0 + kc * 8) = w; }
    }
}
template <class Map, bool NULLOK = false>
DI void convT8(unsigned char* sm, unsigned char* dst, int N, int K, const Map map, float scale, const float* ksc = nullptr) {
    const int tid = tidx(); const int nkt = K >> 7; const int ntiles = (N >> 6) * nkt; const int G = (int)gridDim.x;
    unsigned* T = (unsigned*)sm;
    const size_t ld = (size_t)Map::LD;
    const int n4 = (tid & 15) * 4, kr = tid >> 4;
    f32x4 va[4], vb[4]; float sa = scale, sb = scale;
    auto load_tile = [&](int t, f32x4 (&v)[4], float& sc) {
        const int n0 = (t / nkt) << 6, k0 = (t % nkt) << 7;
        const float* src = map(n0 + n4); sc = scale;
        if (NULLOK) { if (src == nullptr) { src = map(0); sc = 0.f; } }
        const float* p = src + (size_t)(k0 + kr) * ld;
#pragma unroll
        for (int i = 0; i < 4; ++i) v[i] = __builtin_nontemporal_load((const f32x4*)(p + (size_t)(32 * i) * ld));
    };
    auto put_tile = [&](unsigned* Tt, const f32x4 (&v)[4], float sc, int t) {
        const int k0 = (t % nkt) << 7;
#pragma unroll
        for (int i = 0; i < 4; ++i) { const int k = kr + 32 * i; const float si = ksc ? sc * ksc[k0 + k] : sc; Tt[k * 16 + ((n4 >> 2) ^ ((k >> 4) & 7))] = pk_fp8(v[i] * si); }
    };
    auto get_tile = [&](const unsigned* Tt, int t) {
        const int n0 = (t / nkt) << 6, k0 = (t % nkt) << 7;
        const int nr = tid >> 3, kc = tid & 7; const unsigned char* Tb = (const unsigned char*)Tt + (size_t)(kc * 16) * 64 + ((((nr >> 2) ^ kc) << 2) | (nr & 3));
        unsigned w[4];
#pragma unroll
        for (int q = 0; q < 4; ++q) w[q] = (unsigned)Tb[(4 * q) * 64] | ((unsigned)Tb[(4 * q + 1) * 64] << 8) | ((unsigned)Tb[(4 * q + 2) * 64] << 16) | ((unsigned)Tb[(4 * q + 3) * 64] << 24);
        *(u32x4*)(dst + (size_t)(n0 + nr) * K + k0 + kc * 16) = (u32x4){w[0], w[1], w[2], w[3]};
    };
    int t = blockIdx.x;
    if (t < ntiles) load_tile(t, va, sa);
    if (t + G < ntiles) load_tile(t + G, vb, sb);
    for (; t < ntiles; t += 2 * G) {
        const bool hasb = t + G < ntiles;
        __syncthreads();
        put_tile(T, va, sa, t); if (hasb) put_tile(T + 2048, vb, sb, t + G);
        if (t + 2 * G < ntiles) load_tile(t + 2 * G, va, sa);
        if (t + 3 * G < ntiles) load_tile(t + 3 * G, vb, sb);
        __syncthreads();
        get_tile(T, t); if (hasb) get_tile(T + 2048, t + G);
    }
}
template <int LDV> struct MapPlain { static constexpr int LD = LDV; const float* base; DI const float* operator()(int n) const { return base + n; } };
struct MapIn { static constexpr int LD = IN_W; const float* base; DI const float* operator()(int n) const { int oc = n; if (n >= 3328 && n < 3648) oc = n + 16; else if (n >= 3648 && n < 3664) oc = n - 320; return n < 3664 ? base + oc : nullptr; } };
struct MapKVB { static constexpr int LD = 2048; const float* base;
    DI const float* operator()(int n) const { const int m = n & 1023; return base + ((m >> 7) * 256 + (n >> 10) * 128 + (m & 127)); } };
struct MapGU { static constexpr int LD = 512; const float *eg, *eu, *sg, *su;
    DI const float* operator()(int n) const { const int e = n >> 10, np = n & 1023, pn = np >> 8, isup = (np >> 7) & 1, j = pn * 128 + (np & 127);
        const float* be = isup ? eu : eg; const float* bs = isup ? su : sg;
        return e < 64 ? be + (size_t)e * 2048 * 512 + j : bs + j; } };
struct MapDN { static constexpr int LD = 2048; const float *ed, *sd;
    DI const float* operator()(int n) const { const int e = n >> 11, c = n & 2047; return (e < 64 ? ed + (size_t)e * 512 * 2048 : sd) + c; } };
DI void conv_router(const Args& a, int l) {
    bf16_t* hi = (bf16_t*)(a.ws + WS_WRH + (size_t)l * WSTRIDE); bf16_t* lo = (bf16_t*)(a.ws + WS_WRL + (size_t)l * WSTRIDE);
    const float* w = a.w_router + (size_t)l * 2048 * 64;
    for (int i = blockIdx.x * 512 + tidx(); i < 2048 * 64; i += gridDim.x * 512) {
        const int k = i >> 6, n = i & 63; const float v = w[i]; const bf16_t hb = f2bf(v); const float rem = v - bf2f(hb);
        hi[n * 2048 + k] = hb; lo[n * 2048 + k] = f2bf(rem);
    }
}
DI void ph_convert_dense(const Args& a, int l, unsigned char* sm) {
    convT8<MapIn, true>(sm, (unsigned char*)(a.ws + WS_WIN + (size_t)l * WSTRIDE), NP, 2048, MapIn{a.w_in + (size_t)l * 2048 * IN_W}, 64.f);
    convT8(sm, (unsigned char*)(a.ws + WS_WQB + (size_t)l * WSTRIDE), 1536, 768, MapPlain<1536>{a.w_q_b + (size_t)l * 768 * 1536}, 64.f, a.g_q + l * 768);
    convT8(sm, (unsigned char*)(a.ws + WS_WKVB + (size_t)l * WSTRIDE), 2048, 256, MapKVB{a.w_kv_b + (size_t)l * 256 * 2048}, 64.f, a.g_kv + l * 256);
    convT8(sm, (unsigned char*)(a.ws + WS_WOUT + (size_t)l * WSTRIDE), 2048, 2048, MapPlain<2048>{a.w_out + (size_t)l * 2048 * 2048}, 64.f);
    conv_router(a, l);
}
DI void ph_convert_experts(const Args& a, int l, unsigned char* sm) {
    convT8(sm, (unsigned char*)(a.ws + WS_WGU + (size_t)l * WSTRIDE), NE1 * 1024, 2048, MapGU{a.w_e_gate + (size_t)l * 64 * 2048 * 512, a.w_e_up + (size_t)l * 64 * 2048 * 512, a.w_sh_gate + (size_t)l * 2048 * 512, a.w_sh_up + (size_t)l * 2048 * 512}, 64.f);
    convT8(sm, (unsigned char*)(a.ws + WS_WDN + (size_t)l * WSTRIDE), NE1 * 2048, 512, MapDN{a.w_e_down + (size_t)l * 64 * 512 * 2048, a.w_sh_down + (size_t)l * 512 * 2048}, 64.f);
}
DI void ph_convert(const Args& a, int l, unsigned char* sm) { ph_convert_dense(a, l, sm); ph_convert_experts(a, l, sm); }

DI void ph_modulate0(const Args& a) {
    const float* modp = (const float*)(a.ws + WS_MODP);
    { float* modw = (float*)(a.ws + WS_MOD);
      for (int i = blockIdx.x * 512 + tidx(); i < 2 * 3 * 12288; i += gridDim.x * 512) modw[i] = ((modp[i] + modp[73728 + i]) + modp[2 * 73728 + i]) + modp[3 * 73728 + i]; }
    unsigned char* hb8 = (unsigned char*)(a.ws + WS_HB);
    for (size_t i = (size_t)blockIdx.x * 512 + tidx(); i < (size_t)MR * 256; i += (size_t)gridDim.x * 512) {
        const int g = (int)(i >> 8), c8 = (int)(i & 255) * 8, b = g / RPB, rr = g % RPB;
        const float* src = rr < CTXL ? a.ctx + ((size_t)(b * CTXL + rr)) * DM : a.x + ((size_t)(b * SEQ + rr - CTXL)) * DM;
        const float* m = modp + (size_t)(rr < CTXL ? 2 : b) * 12288;
        const f32x4 v0 = __builtin_nontemporal_load((const f32x4*)(src + c8)), v1 = __builtin_nontemporal_load((const f32x4*)(src + c8 + 4));
#define MSUM(off) (((*(const f32x4*)(m + (off)) + *(const f32x4*)(m + 73728 + (off))) + *(const f32x4*)(m + 2 * 73728 + (off))) + *(const f32x4*)(m + 3 * 73728 + (off)))
        const f32x4 sh0 = MSUM(c8), sh1 = MSUM(c8 + 4), sc0 = MSUM(DM + c8), sc1 = MSUM(DM + c8 + 4);
#undef MSUM
        const f32x4 h0 = v0 * (1.f + sc0) + sh0, h1 = v1 * (1.f + sc1) + sh1;
        u32x2 w; w.x = pk_fp8(h0); w.y = pk_fp8(h1);
        *(u32x2*)(hb8 + (size_t)g * DM + c8) = w;
    }
}

struct ARowLin { const bf16_t* base; size_t ld; DI const bf16_t* operator()(int i) const { return base + (size_t)i * ld; } };
struct EpiInproj { bf16_t* proj; float* dtb; int row0, col0;
    DI void operator()(f32x16 (&acc)[2][2], int wm, int wn, int r, int h) const {
#pragma unroll
        for (int mi = 0; mi < 2; ++mi)
#pragma unroll
            for (int ni = 0; ni < 2; ++ni)
#pragma unroll
                for (int q = 0; q < 4; ++q) {
                    const int row = row0 + wm * 64 + mi * 32 + r, col = col0 + wn * 64 + ni * 32 + 8 * q + 4 * h;
                    float v0 = acc[mi][ni][4 * q], v1 = acc[mi][ni][4 * q + 1], v2 = acc[mi][ni][4 * q + 2], v3 = acc[mi][ni][4 * q + 3];
                    if (col < 1024) { v0 = gelu_f(v0); v1 = gelu_f(v1); v2 = gelu_f(v2); v3 = gelu_f(v3); }
                    u32x2 w; w.x = cvtpk(v0, v1); w.y = cvtpk(v2, v3);
                    *(u32x2*)(proj + (size_t)row * NP + col) = w;
                    if (col >= PC_DT && col < PC_DT + 16) *(f32x4*)(dtb + (size_t)row * 16 + (col - PC_DT)) = (f32x4){v0, v1, v2, v3};
                }
    } };
DI void ph_inproj(const Args& a, int l, unsigned char* sm) {
    g8::DenseSched S{(const bf16_t*)(a.ws + WS_HB), (const bf16_t*)(a.ws + WS_WIN + (size_t)l * WSTRIDE), 1024, 1024, NP / 256, (MR / 256) * (NP / 256), (int)gridDim.x, (int)blockIdx.x, 0};
    EpiInproj8 E{(bf16_t*)(a.ws + WS_PROJ), (float*)(a.ws + WS_DT), (float*)(a.ws + WS_RSS), 1.f / 64.f, (unsigned char*)(a.ws + WS_KV) + (size_t)MR * 2048, (float*)(a.ws + WS_KV + (size_t)MR * 2816), (unsigned char*)(a.ws + WS_KV) + (size_t)MR * 2880};
    __syncthreads();
    g8::gemm(sm, 1024, 1024, S, E);
}

DI void conv8(const bf16_t* proj, int g, int seg_lo, int seg_hi, int c0, const float* cw, const float* cb, float (&o)[8]) {
    const f32x4 b0 = *(const f32x4*)(cb + c0), b1 = *(const f32x4*)(cb + c0 + 4);
    float acc[8] = {b0[0], b0[1], b0[2], b0[3], b1[0], b1[1], b1[2], b1[3]};
    u32x4 raw[5]; f32x4 w0[5], w1[5];
#pragma unroll
    for (int j = 0; j < 5; ++j) {
        const int gg = g + j - 2; const bool in = gg >= seg_lo && gg < seg_hi; const int gc = in ? gg : g; const float mk = in ? 1.f : 0.f;
        raw[j] = *(const u32x4*)(proj + (size_t)gc * NP + PC_XBC + c0);
        w0[j] = *(const f32x4*)(cw + j * 1024 + c0) * mk; w1[j] = *(const f32x4*)(cw + j * 1024 + c0 + 4) * mk;
    }
#pragma unroll
    for (int j = 0; j < 5; ++j) {
        acc[0] += w0[j][0] * bf_lo(raw[j].x); acc[1] += w0[j][1] * bf_hi(raw[j].x); acc[2] += w0[j][2] * bf_lo(raw[j].y); acc[3] += w0[j][3] * bf_hi(raw[j].y);
        acc[4] += w1[j][0] * bf_lo(raw[j].z); acc[5] += w1[j][1] * bf_hi(raw[j].z); acc[6] += w1[j][2] * bf_lo(raw[j].w); acc[7] += w1[j][3] * bf_hi(raw[j].w);
    }
#pragma unroll
    for (int i = 0; i < 8; ++i) o[i] = silu_f(acc[i]);
}
DI void chunk_seg(int ck, int& g0, int& seg_lo, int& seg_hi) {
    const int b = ck / 66, cc = ck % 66; g0 = ck * 128;
    if (cc < 2) { seg_lo = b * RPB; seg_hi = seg_lo + CTXL; } else { seg_lo = b * RPB + CTXL; seg_hi = (b + 1) * RPB; }
}
DI void dt_scan_wave(const float* dtbuf, int g0, int col, float bias, float aneg, int dir, float* dts, float* acs, int lane) {
    float x0 = dtbuf[(size_t)(g0 + lane) * 16 + col] + bias, x1 = dtbuf[(size_t)(g0 + lane + 64) * 16 + col] + bias;
    const float d0 = x0 > 20.f ? x0 : log1pf(__expf(x0)), d1 = x1 > 20.f ? x1 : log1pf(__expf(x1));
    dts[lane] = d0; dts[lane + 64] = d1;
    float v0 = d0 * aneg, v1 = d1 * aneg;
    if (dir == 0) {
#pragma unroll
        for (int o = 1; o < 64; o <<= 1) { const float t0 = __shfl_up(v0, o), t1 = __shfl_up(v1, o); if (lane >= o) { v0 += t0; v1 += t1; } }
        const float tot = __shfl(v0, 63); v1 += tot;
    } else {
#pragma unroll
        for (int o = 1; o < 64; o <<= 1) { const float t0 = __shfl_down(v0, o), t1 = __shfl_down(v1, o); if (lane + o < 64) { v0 += t0; v1 += t1; } }
        const float tot = __shfl(v1, 0); v0 += tot;
    }
    acs[lane] = v0; acs[lane + 64] = v1;
}

DI void gmlp_unit(const Args& a, int l, int ck, int hh, unsigned char* sm) {
    const int tid = tidx(), wave = tid >> 6, lane = tid & 63, r = lane & 31, h = lane >> 5, wm = wave >> 1, wn = wave & 1;
    const bf16_t* proj = (const bf16_t*)(a.ws + WS_PROJ); unsigned char* mix = (unsigned char*)(a.ws + WS_MIX);
    unsigned char* Asp = sm;
    unsigned char* VT = sm + 128 * 272;
    const int g0 = ck * 128;
    __syncthreads();
    { const float* gv = a.g_v + l * 512 + hh * 128; const float* bv = a.b_v + l * 512 + hh * 128; const float* vst = (const float*)(a.ws + WS_KV + (size_t)MR * 2816);
      const int sr_ = tid >> 2, dq = (tid & 3) * 32;
      const f32x4 s0 = *(const f32x4*)(vst + (size_t)(g0 + sr_) * 16), s1 = *(const f32x4*)(vst + (size_t)(g0 + sr_) * 16 + 4), q0 = *(const f32x4*)(vst + (size_t)(g0 + sr_) * 16 + 8), q1 = *(const f32x4*)(vst + (size_t)(g0 + sr_) * 16 + 12);
      const float mu = (((s0[0] + s0[1]) + (s0[2] + s0[3])) + ((s1[0] + s1[1]) + (s1[2] + s1[3]))) * (1.f / 512.f);
      const float var = (((q0[0] + q0[1]) + (q0[2] + q0[3])) + ((q1[0] + q1[1]) + (q1[2] + q1[3]))) * (1.f / 512.f) - mu * mu;
      const float rstd = rsqrtf(fmaxf(var, 0.f) + 1e-5f);
      const bf16_t* vrow = proj + (size_t)(g0 + sr_) * NP + PC_GM + 512 + hh * 128 + dq;
#pragma unroll
      for (int i = 0; i < 4; ++i) { const u32x4 raw = *(const u32x4*)(vrow + i * 8); const unsigned w4[4] = {raw.x, raw.y, raw.z, raw.w};
          const f32x4 ga = *(const f32x4*)(gv + dq + i * 8), gb = *(const f32x4*)(gv + dq + i * 8 + 4), ba = *(const f32x4*)(bv + dq + i * 8), bb = *(const f32x4*)(bv + dq + i * 8 + 4);
#pragma unroll
          for (int j = 0; j < 8; ++j) { const float vv = (j & 1) ? bf_hi(w4[j >> 1]) : bf_lo(w4[j >> 1]); const float gj = j < 4 ? ga[j] : gb[j - 4], bj = j < 4 ? ba[j] : bb[j - 4];
              *(bf16_t*)(VT + xswz_off(dq + i * 8 + j, sr_, 272)) = f2bf((vv - mu) * rstd * gj + bj); } } }
    const float* wsp = a.w_sp + ((size_t)l * 4 + hh) * 128 * 128;
#pragma unroll
    for (int i = 0; i < 8; ++i) { const int idx = tid + i * 512, t = idx >> 5, s4 = (idx & 31) * 4; const f32x4 w = *(const f32x4*)(wsp + t * 128 + s4);
        u32x2 p; p.x = cvtpk(w[0], w[1]); p.y = cvtpk(w[2], w[3]); *(u32x2*)(Asp + t * 272 + s4 * 2) = p; }
    __syncthreads();
    f32x16 acc[1][2];
#pragma unroll
    for (int j = 0; j < 2; ++j)
#pragma unroll
        for (int q = 0; q < 16; ++q) acc[0][j][q] = 0.f;
    mma_lds_x<1, 2, 8, true, false, true>(Asp + wm * 32 * 272, 272, 0, VT + wn * 64 * 272, 272, wn * 64, acc, r, h);
    const int t = wm * 32 + r; const float bsp = a.b_sp[((size_t)l * 4 + hh) * 128 + t];
#pragma unroll
    for (int ni = 0; ni < 2; ++ni)
#pragma unroll
        for (int q = 0; q < 4; ++q) {
            const int d = wn * 64 + ni * 32 + 8 * q + 4 * h;
            const u32x2 uu = *(const u32x2*)(proj + (size_t)(g0 + t) * NP + PC_GM + hh * 128 + d);
            const float o0 = bf_lo(uu.x) * (acc[0][ni][4 * q] + bsp), o1 = bf_hi(uu.x) * (acc[0][ni][4 * q + 1] + bsp), o2 = bf_lo(uu.y) * (acc[0][ni][4 * q + 2] + bsp), o3 = bf_hi(uu.y) * (acc[0][ni][4 * q + 3] + bsp);
            *(unsigned*)(mix + (size_t)(g0 + t) * DM + hh * 128 + d) = pk_mix(o0, o1, o2, o3);
        }
}
DI void ssd_state_unit(const Args& a, int l, int ck, int hh, unsigned char* sm) {
    const int tid = tidx(), wave = tid >> 6, lane = tid & 63, r = lane & 31, h = lane >> 5, wm = wave >> 1, wn = wave & 1;
    const bf16_t* proj = (const bf16_t*)(a.ws + WS_PROJ); const float* dtbuf = (const float*)(a.ws + WS_DT);
    unsigned char* XT2 = sm;
    unsigned char* BT = sm + 128 * 272;
    float* sc = (float*)(sm + 2 * 128 * 272);
    int g0, seg_lo, seg_hi; chunk_seg(ck, g0, seg_lo, seg_hi);
    __syncthreads();
    if (wave < 2) { const int dir = wave; dt_scan_wave(dtbuf, g0, dir * 8 + hh, a.dt_bias[(l * 2 + dir) * 8 + hh], -__expf(a.a_log[(l * 2 + dir) * 8 + hh]), dir, sc + dir * 128, sc + 256 + dir * 128, lane); }
    __syncthreads();
    const float* cw = a.conv_w + (size_t)l * 5 * 1024; const float* cb = a.conv_b + (size_t)l * 1024;
    const float af_last = sc[256 + 127], ab_first = sc[256 + 128 + 0];
#pragma unroll 1
    for (int i = 0; i < 2; ++i) {
        const int idx = tid + i * 512, lrow = idx >> 3, c0 = (idx & 7) * 8; float o[8];
        conv8(proj, g0 + lrow, seg_lo, seg_hi, hh * 64 + c0, cw, cb, o);
        const float wf = sc[lrow] * __expf(af_last - sc[256 + lrow]), wb = sc[128 + lrow] * __expf(ab_first - sc[256 + 128 + lrow]);
#pragma unroll
        for (int j = 0; j < 8; ++j) { *(bf16_t*)(XT2 + (c0 + j) * 272 + lrow * 2) = f2bf(o[j] * wf); *(bf16_t*)(XT2 + (64 + c0 + j) * 272 + lrow * 2) = f2bf(o[j] * wb); }
    }
#pragma unroll 1
    for (int i = 0; i < 4; ++i) {
        const int idx = tid + i * 512, lrow = idx >> 4, c0 = (idx & 15) * 8; float o[8];
        conv8(proj, g0 + lrow, seg_lo, seg_hi, 512 + (hh >> 2) * 128 + c0, cw, cb, o);
#pragma unroll
        for (int j = 0; j < 8; ++j) *(bf16_t*)(BT + (c0 + j) * 272 + lrow * 2) = f2bf(o[j]);
    }
    __syncthreads();
    f32x16 acc[1][2];
#pragma unroll
    for (int j = 0; j < 2; ++j)
#pragma unroll
        for (int q = 0; q < 16; ++q) acc[0][j][q] = 0.f;
    mma_lds<1, 2, 8, true>(XT2 + wm * 32 * 272, 272, BT + wn * 64 * 272, 272, acc, r, h);
    const int m = wm * 32 + r, dir = m >> 6, p = m & 63;
    float* st = (float*)(a.ws + WS_ST) + ((size_t)(ck * 8 + hh) * 2 + dir) * 8192 + p * 128;
#pragma unroll
    for (int ni = 0; ni < 2; ++ni)
#pragma unroll
        for (int q = 0; q < 4; ++q) { const int n = wn * 64 + ni * 32 + 8 * q + 4 * h;
            *(f32x4*)(st + n) = (f32x4){acc[0][ni][4 * q], acc[0][ni][4 * q + 1], acc[0][ni][4 * q + 2], acc[0][ni][4 * q + 3]}; }
    if (tid < 2) ((float*)(a.ws + WS_DEC))[(ck * 8 + hh) * 2 + tid] = __expf(tid == 0 ? af_last : ab_first);
}
struct EpiRowScale { bf16_t* out; size_t ldo; int row0, col0; const float* rs;
    DI void operator()(f32x16 (&acc)[2][2], int wm, int wn, int r, int h) const {
#pragma unroll
        for (int mi = 0; mi < 2; ++mi) { const int rl = wm * 64 + mi * 32 + r; const float s = rs[rl];
#pragma unroll
            for (int ni = 0; ni < 2; ++ni)
#pragma unroll
                for (int q = 0; q < 4; ++q) { const int col = col0 + wn * 64 + ni * 32 + 8 * q + 4 * h;
                    u32x2 w; w.x = cvtpk(acc[mi][ni][4 * q] * s, acc[mi][ni][4 * q + 1] * s); w.y = cvtpk(acc[mi][ni][4 * q + 2] * s, acc[mi][ni][4 * q + 3] * s);
                    *(u32x2*)(out + (size_t)(row0 + rl) * ldo + col) = w; } }
    } };
DI void rms_gemm_tile(unsigned char* sm, const bf16_t* A  , int K, const bf16_t* Bt, bf16_t* out, size_t ldo, int row0, int col0) {
    const int tid = tidx(); float* rs = (float*)(sm + GT_BYTES);
    __syncthreads();
    { const int row = tid >> 1, half = tid & 1; const bf16_t* p = A + (size_t)row * NP + half * (K >> 1); float ss = 0.f;
      for (int k = 0; k < (K >> 1); k += 8) { const u32x4 w = *(const u32x4*)(p + k);
          ss += bf_lo(w.x) * bf_lo(w.x) + bf_hi(w.x) * bf_hi(w.x) + bf_lo(w.y) * bf_lo(w.y) + bf_hi(w.y) * bf_hi(w.y) + bf_lo(w.z) * bf_lo(w.z) + bf_hi(w.z) * bf_hi(w.z) + bf_lo(w.w) * bf_lo(w.w) + bf_hi(w.w) * bf_hi(w.w); }
      ss += __shfl_xor(ss, 1);
      if (half == 0) rs[row] = rsqrtf(ss / (float)K + 1e-6f); }
    gemm_tile<true>(sm, ARowLin{A, NP}, Bt, (size_t)K, K, EpiRowScale{out, ldo, row0, col0, rs});
}
DI void krope_rows(const Args& a) {
    const bf16_t* proj = (const bf16_t*)(a.ws + WS_PROJ); unsigned char* krr = (unsigned char*)(a.ws + WS_KRR);
    for (int i = blockIdx.x * 512 + tidx(); i < MR * 32; i += gridDim.x * 512) {
        const int g = i >> 5, pr = i & 31, axis = pr >> 4, ii = pr & 15, rr = g % RPB;
        const float x1 = bf2f(proj[(size_t)g * NP + PC_KR + axis * 32 + ii]), x2 = bf2f(proj[(size_t)g * NP + PC_KR + axis * 32 + 16 + ii]);
        float o1 = x1, o2 = x2;
        if (rr >= CTXL) { const int t = rr - CTXL; const float pos = (float)(axis ? (t & 63) : (t >> 6)); const float ang = pos * exp2f(-(float)ii * 0.83048202372184059f);
            const float c = __cosf(ang), s = __sinf(ang); o1 = x1 * c - x2 * s; o2 = x2 * c + x1 * s; }
        const unsigned pk = (unsigned)__builtin_amdgcn_cvt_pk_fp8_f32(o1, o2, 0, false);
        krr[(size_t)g * 64 + axis * 32 + ii] = (unsigned char)pk; krr[(size_t)g * 64 + axis * 32 + 16 + ii] = (unsigned char)(pk >> 8);
    }
}
DI void ph_mixers1(const Args& a, int l, unsigned char* sm) {
    const bf16_t* proj = (const bf16_t*)(a.ws + WS_PROJ);
    { const float* rss = (const float*)(a.ws + WS_RSS);
      g8::DenseSched Sq{(const bf16_t*)((const unsigned char*)(a.ws + WS_KV) + (size_t)MR * 2048), (const bf16_t*)(a.ws + WS_WQB + (size_t)l * WSTRIDE), 384, 384, 6, (l == 0 ? 66 : 64) * 6, (int)gridDim.x, (int)blockIdx.x, l};
      __syncthreads();
      g8::gemm(sm, 384, 384, Sq, EpiRowScale8{(bf16_t*)(a.ws + WS_Q), 1536, rss, 1.f / 768.f, 0, 12});
      const bf16_t* kv8 = (const bf16_t*)((const unsigned char*)(a.ws + WS_KV) + (size_t)MR * 2880);
      g8::DenseSched Sk{kv8, (const bf16_t*)(a.ws + WS_WKVB + (size_t)l * WSTRIDE), 128, 128, 4, 66 * 4, (int)gridDim.x, (int)((blockIdx.x + 116) % gridDim.x), 0};
      __syncthreads();
      g8::gemm(sm, 128, 128, Sk, EpiKn8{(unsigned char*)(a.ws + WS_KV), rss});
      g8::DenseSched Sv{(const bf16_t*)(a.ws + WS_WKVB + (size_t)l * WSTRIDE) + 1024 * 128, kv8, 128, 128, 66, 4 * 66, (int)gridDim.x, (int)((blockIdx.x + 100) % gridDim.x), 0};
      __syncthreads();
      g8::gemm(sm, 128, 128, Sv, EpiVt8{(unsigned char*)(a.ws + WS_KV) + (size_t)MR * 1024, rss}); }
    const int nss = NCH * 8, ngm = NCH * 4, total = nss + ngm;
    for (int u0 = blockIdx.x; u0 < total; u0 += gridDim.x) {
        const int u = total - 1 - u0;
        if (u < nss) ssd_state_unit(a, l, u >> 3, u & 7, sm);
        else { const int v = u - nss; gmlp_unit(a, l, v >> 2, v & 3, sm); }
    }
    krope_rows(a);
}

DI void ssd_scan(const Args& a) {
    const float* ST = (const float*)(a.ws + WS_ST); const float* DEC = (const float*)(a.ws + WS_DEC); bf16_t* HP = (bf16_t*)(a.ws + WS_HP);
    for (int idx = blockIdx.x * 512 + tidx(); idx < NB * 8 * 2 * 8192; idx += gridDim.x * 512) {
        const int pn = idx & 8191, dir = (idx >> 13) & 1, hh = (idx >> 14) & 7, b = idx >> 17;
        float carry = 0.f;
#pragma unroll 6
        for (int s = 0; s < 66; ++s) {
            const int cc = dir == 0 ? s : (s < 2 ? 1 - s : 67 - s);
            const size_t base = (size_t)((b * 66 + cc) * 8 + hh) * 2 + dir;
            HP[base * 8192 + pn] = f2bf(carry);
            carry = carry * DEC[base] + __builtin_nontemporal_load(ST + base * 8192 + pn);
        }
    }
}

constexpr float ATT_SCALE = 0.07216878364870322f;
constexpr float ATT_THR = 0.5f, ATT_PEXP = 8.f;
constexpr int AF_KLD = 208, AF_VLD = 80, AF_KB = 64 * AF_KLD, AF_VB = 128 * AF_VLD, AF_K = 0, AF_V = 2 * AF_KB;
#define SBAR() __builtin_amdgcn_sched_barrier(0)
using g8::i32x4_t; using g8::i32x8_t;
#define AF_LD32(p) __builtin_shufflevector(*(const i32x4_t*)(p), *(const i32x4_t*)((p) + 16), 0, 1, 2, 3, 4, 5, 6, 7)
DI f32x16 mfma8(i32x8_t a, i32x8_t b, f32x16 c, int sc) { return __builtin_amdgcn_mfma_scale_f32_32x32x64_f8f6f4(a, b, c, 0, 0, 0, sc, 0, sc); }
DI void partialSM(f32x16& p0, f32x16& p1, float& m_reg, float& mn, float& alpha) {
    constexpr float C = ATT_SCALE * 1.4426950408889634f;
    float pmax = p0[0];
#pragma unroll
    for (int r = 1; r < 16; ++r) pmax = fmaxf(pmax, p0[r]);
#pragma unroll
    for (int r = 0; r < 16; ++r) pmax = fmaxf(pmax, p1[r]);
    { auto rr = __builtin_amdgcn_permlane32_swap(__float_as_uint(pmax), __float_as_uint(pmax), false, false);
      pmax = fmaxf(__uint_as_float(rr[0]), __uint_as_float(rr[1])); }
    if (__builtin_expect(__all(pmax - m_reg <= ATT_THR / ATT_SCALE), 1)) { mn = m_reg; alpha = 1.f; }
    else { mn = fmaxf(m_reg, pmax); alpha = __builtin_amdgcn_exp2f((m_reg - mn) * C); m_reg = mn; }
    const float mnC = ATT_PEXP - mn * C;
#pragma unroll
    for (int r = 0; r < 16; ++r) p0[r] = fmaf(p0[r], C, mnC);
#pragma unroll
    for (int r = 0; r < 16; ++r) p1[r] = fmaf(p1[r], C, mnC);
#pragma unroll
    for (int r = 0; r < 16; ++r) p0[r] = __builtin_amdgcn_exp2f(p0[r]);
}
DI void finishSM(f32x16& p0, f32x16& p1, float alpha, float& l_reg, i32x8_t& P) {
#pragma unroll
    for (int r = 0; r < 16; ++r) p1[r] = __builtin_amdgcn_exp2f(p1[r]);
    float ps = 0;
#pragma unroll
    for (int r = 0; r < 16; ++r) ps += p0[r];
#pragma unroll
    for (int r = 0; r < 16; ++r) ps += p1[r];
    asm volatile("" : "+v"(ps));
    l_reg = l_reg * alpha + ps;
#pragma unroll
    for (int w = 0; w < 4; ++w) { P[w] = (int)pk_fp8((f32x4){p0[4 * w], p0[4 * w + 1], p0[4 * w + 2], p0[4 * w + 3]}); P[4 + w] = (int)pk_fp8((f32x4){p1[4 * w], p1[4 * w + 1], p1[4 * w + 2], p1[4 * w + 3]}); }
}
DI void qkt(f32x16& p0, f32x16& p1, const unsigned char* K, const i32x8_t (&qf)[3], int r32, int hi, int sc1) {
    const unsigned char* k0 = K + r32 * AF_KLD + hi * 32; const unsigned char* k1 = k0 + 32 * AF_KLD;
#pragma unroll
    for (int r = 0; r < 16; ++r) { p0[r] = 0.f; p1[r] = 0.f; }
#pragma unroll
    for (int blk = 0; blk < 3; ++blk) { const i32x8_t a0 = AF_LD32(k0 + blk * 64), a1 = AF_LD32(k1 + blk * 64);
        p0 = mfma8(a0, qf[blk], p0, sc1); p1 = mfma8(a1, qf[blk], p1, sc1); }
}
DI void pv_d0(f32x16* o, const unsigned char* V, const i32x8_t P, int r32, int hi, int sc1) {
    const unsigned char* vb = V + r32 * AF_VLD + hi * 32;
#pragma unroll
    for (int d = 0; d < 4; ++d) { const i32x8_t av = AF_LD32(vb + d * 32 * AF_VLD); o[d] = mfma8(av, P, o[d], sc1); }
}
DI unsigned q8pack(unsigned w0, unsigned w1) { return pk_fp8((f32x4){bf_lo(w0), bf_hi(w0), bf_lo(w1), bf_hi(w1)}); }
DI void attn_unit(const Args& a, int qrow0, int krow0, int seq, int hh, int rope_t0, unsigned char* lds) {
    const bf16_t* Qg = (const bf16_t*)(a.ws + WS_Q); const unsigned char* KNg = (const unsigned char*)(a.ws + WS_KV); const unsigned char* VTg = KNg + (size_t)MR * 1024; const unsigned char* KRg = (const unsigned char*)(a.ws + WS_KRR);
    unsigned char* Og = (unsigned char*)(a.ws + WS_MIX);
    int tid_o = tidx();
    const int tid = tid_o, wid = tid >> 6, lane = tid & 63, r32 = lane & 31, hi = lane >> 5;
    int sc1 = 0x7f7f7f7f; asm volatile("" : "+s"(sc1));
    float m_reg = -1e30f, l_reg = 0; f32x16 o[4];
#pragma unroll
    for (int d = 0; d < 4; ++d)
#pragma unroll
        for (int r = 0; r < 16; ++r) o[d][r] = 0.f;
    i32x8_t qf[3];
    { const bf16_t* Qw = Qg + (size_t)(qrow0 + wid * 32 + r32) * 1536 + hh * 192 + hi * 32;
#pragma unroll
      for (int blk = 0; blk < 2; ++blk)
#pragma unroll
          for (int i = 0; i < 4; ++i) { const u32x4 w = *(const u32x4*)(Qw + blk * 64 + i * 8); qf[blk][2 * i] = (int)q8pack(w.x, w.y); qf[blk][2 * i + 1] = (int)q8pack(w.z, w.w); }
      const u32x4 xa = *(const u32x4*)(Qw + 128), xb = *(const u32x4*)(Qw + 136), ya = *(const u32x4*)(Qw + 144), yb = *(const u32x4*)(Qw + 152);
      const unsigned x1w[8] = {xa.x, xa.y, xa.z, xa.w, xb.x, xb.y, xb.z, xb.w}, x2w[8] = {ya.x, ya.y, ya.z, ya.w, yb.x, yb.y, yb.z, yb.w};
      const int t = rope_t0 + wid * 32 + r32; const float pos = rope_t0 >= 0 ? (float)(hi ? (t & 63) : (t >> 6)) : 0.f;
#pragma unroll
      for (int i = 0; i < 4; ++i) { f32x4 y1, y2;
#pragma unroll
          for (int j = 0; j < 4; ++j) { const int f = 4 * i + j; const unsigned w1 = x1w[f >> 1], w2 = x2w[f >> 1];
              const float u1 = (f & 1) ? bf_hi(w1) : bf_lo(w1), u2 = (f & 1) ? bf_hi(w2) : bf_lo(w2);
              const float ang = pos * exp2f(-(float)f * 0.83048202372184059f); const float c = __cosf(ang), sn = __sinf(ang);
              y1[j] = u1 * c - u2 * sn; y2[j] = u2 * c + u1 * sn; }
          qf[2][i] = (int)pk_fp8(y1); qf[2][4 + i] = (int)pk_fp8(y2); } }
    const int skey = tid >> 3, spart = tid & 7;
    const unsigned char* Kp = KNg + (size_t)krow0 * 1024 + hh * 128; const unsigned char* Krp = KRg + (size_t)krow0 * 64; const unsigned char* Vp = VTg + ((size_t)((krow0 >> 6) * 8 + hh) * 128) * 64;
    const unsigned koff = (unsigned)(skey * 1024 + spart * 16), kroff = (unsigned)(skey * 64 + spart * 8), voff = (unsigned)(tid * 16);
    unsigned char* kw = lds + AF_K + skey * AF_KLD + spart * 16; unsigned char* krw = lds + AF_K + skey * AF_KLD + 128 + spart * 8; unsigned char* vw = lds + AF_V + (tid >> 2) * AF_VLD + (tid & 3) * 16;
    u32x4 ks, vs; u32x2 kr;
#define SLOAD(k0) do { ks = *(const u32x4*)(Kp + (size_t)(k0) * 1024 + koff); kr = *(const u32x2*)(Krp + (size_t)(k0) * 64 + kroff); vs = *(const u32x4*)(Vp + (size_t)((k0) >> 6) * 65536 + voff); } while (0)
#define SWRITE(b) do { *(u32x4*)(kw + (b) * AF_KB) = ks; *(u32x2*)(krw + (b) * AF_KB) = kr; *(u32x4*)(vw + (b) * AF_VB) = vs; } while (0)
#define SWAIT() asm volatile("s_waitcnt vmcnt(0)" ::: "memory")
#define RESC(al) do { if (__any((al) < 1.f)) { _Pragma("unroll") for (int d = 0; d < 4; ++d) _Pragma("unroll") for (int r = 0; r < 16; ++r) o[d][r] *= (al); } } while (0)
    const unsigned char* K0 = lds + AF_K; const unsigned char* K1 = K0 + AF_KB; const unsigned char* V0 = lds + AF_V; const unsigned char* V1 = V0 + AF_VB;
    f32x16 pA0, pA1, pB0, pB1; float mnA, mnB, alA, alB; i32x8_t P; const int NT = seq / 64;
    __syncthreads();
    SLOAD(0); SWAIT(); SWRITE(0); __syncthreads();
    qkt(pA0, pA1, K0, qf, r32, hi, sc1); partialSM(pA0, pA1, m_reg, mnA, alA);
    SLOAD(64);
    SWAIT(); SWRITE(1); if (NT > 2) SLOAD(128); __syncthreads();
#pragma unroll 1
    for (int j = 1; j + 1 < NT; j += 2) {
        SBAR(); qkt(pB0, pB1, K1, qf, r32, hi, sc1);
        finishSM(pA0, pA1, alA, l_reg, P); SBAR();
        pv_d0(o, V0, P, r32, hi, sc1); partialSM(pB0, pB1, m_reg, mnB, alB);
        __syncthreads(); SWAIT(); SWRITE(0); SLOAD((j + 2) * 64);
        RESC(alB); __syncthreads();
        SBAR(); qkt(pA0, pA1, K0, qf, r32, hi, sc1);
        finishSM(pB0, pB1, alB, l_reg, P); SBAR();
        pv_d0(o, V1, P, r32, hi, sc1); partialSM(pA0, pA1, m_reg, mnA, alA);
        __syncthreads(); SWAIT(); SWRITE(1); if (j + 3 < NT) SLOAD((j + 3) * 64);
        RESC(alA); __syncthreads();
    }
    SBAR(); qkt(pB0, pB1, K1, qf, r32, hi, sc1);
    finishSM(pA0, pA1, alA, l_reg, P); SBAR();
    pv_d0(o, V0, P, r32, hi, sc1); partialSM(pB0, pB1, m_reg, mnB, alB);
    RESC(alB);
    finishSM(pB0, pB1, alB, l_reg, P); SBAR();
    pv_d0(o, V1, P, r32, hi, sc1);
    { auto rr = __builtin_amdgcn_permlane32_swap(__float_as_uint(l_reg), __float_as_uint(l_reg), false, false);
      l_reg = __uint_as_float(rr[0]) + __uint_as_float(rr[1]); }
    const float rl = __builtin_amdgcn_rcpf(l_reg) * MIXS;
    int obase = (qrow0 + wid * 32 + r32) * DM + 1024 + hh * 128 + 4 * hi;
    asm volatile("" : "+v"(obase));
    unsigned char* Ow = Og + obase;
#pragma unroll
    for (int d = 0; d < 4; ++d)
#pragma unroll
        for (int g = 0; g < 4; ++g) *(unsigned*)(Ow + d * 32 + 8 * g) = pk_fp8((f32x4){o[d][4 * g] * rl, o[d][4 * g + 1] * rl, o[d][4 * g + 2] * rl, o[d][4 * g + 3] * rl});
#undef SLOAD
#undef SWRITE
#undef SWAIT
#undef RESC
}
DI void ph_attn(const Args& a, int l, unsigned char* sm) {
    ssd_scan(a);
    const bool early = (((int)blockIdx.x >> 3) & 1) == 0;
    if (l == 0 && early) { ph_convert_experts(a, 0, sm); ph_convert(a, 1, sm); __syncthreads(); }
    const int nlat = NB * 8 * 32, total = nlat + (l == 0 ? NB * 8 : 0);
    for (int u = blockIdx.x; u < total; u += gridDim.x) {
        if (u < nlat) { const int b = u >> 8, w = u & 255, hh = w & 7, qb = w >> 3;
            attn_unit(a, b * RPB + CTXL + qb * 256, b * RPB, RPB, hh, qb * 256, sm); }
        else { const int v = u - nlat, b = v >> 3, hh = v & 7;
            attn_unit(a, b * RPB, b * RPB, CTXL, hh, -1, sm); }
    }
    if (l == 0 && !early) { __syncthreads(); ph_convert_experts(a, 0, sm); ph_convert(a, 1, sm); }
}

DI void ssd_out_unit(const Args& a, int l, int ck, int gg, unsigned char* sm) {
    const int tid = tidx(), wave = tid >> 6, lane = tid & 63, r = lane & 31, h = lane >> 5, wm = wave >> 1, wn = wave & 1;
    const bf16_t* proj = (const bf16_t*)(a.ws + WS_PROJ); const float* dtbuf = (const float*)(a.ws + WS_DT); const bf16_t* HP = (const bf16_t*)(a.ws + WS_HP);
    unsigned char* mix = (unsigned char*)(a.ws + WS_MIX);
    unsigned char* Cc = sm;
    unsigned char* BM = sm + 34816;
    unsigned char* XT = sm + 69632;
    unsigned char* Hf = sm + 87040;
    unsigned char* Hb = sm + 104448;
    float* sc = (float*)(sm + 121856);
    float* ssq = (float*)(sm + 121856 + 8192);
    int g0, seg_lo, seg_hi; chunk_seg(ck, g0, seg_lo, seg_hi);
    const float* cw = a.conv_w + (size_t)l * 5 * 1024; const float* cb = a.conv_b + (size_t)l * 1024;
    __syncthreads();
    { const int hl = wave >> 1, dir = wave & 1, hh = gg * 4 + hl;
      dt_scan_wave(dtbuf, g0, dir * 8 + hh, a.dt_bias[(l * 2 + dir) * 8 + hh], -__expf(a.a_log[(l * 2 + dir) * 8 + hh]), dir, sc + wave * 128, sc + 1024 + wave * 128, lane); }
#pragma unroll 1
    for (int i = 0; i < 8; ++i) {
        const int idx = tid + i * 512, isB = idx >> 11, rem = idx & 2047, lrow = rem >> 4, c0 = (rem & 15) * 8; float o[8];
        conv8(proj, g0 + lrow, seg_lo, seg_hi, (isB ? 512 : 768) + gg * 128 + c0, cw, cb, o);
        u32x4 w; w.x = cvtpk(o[0], o[1]); w.y = cvtpk(o[2], o[3]); w.z = cvtpk(o[4], o[5]); w.w = cvtpk(o[6], o[7]);
        *(u32x4*)((isB ? BM : Cc) + lrow * 272 + c0 * 2) = w;
    }
    __syncthreads();
    f32x16 G[1][2];
#pragma unroll
    for (int j = 0; j < 2; ++j)
#pragma unroll
        for (int q = 0; q < 16; ++q) G[0][j][q] = 0.f;
    mma_lds<1, 2, 8, true>(Cc + wm * 32 * 272, 272, BM + wn * 64 * 272, 272, G, r, h);
    const int lrow = wm * 32 + r;
    u32x2 yp0[4], yp1[4], yp2[4], yp3[4]; float ssl = 0.f;
#pragma unroll
    for (int q = 0; q < 4; ++q) { yp0[q] = (u32x2){0u, 0u}; yp1[q] = yp0[q]; yp2[q] = yp0[q]; yp3[q] = yp0[q]; }
#pragma unroll 1
    for (int hl = 0; hl < 4; ++hl) {
        const int hh = gg * 4 + hl;
        const float* dtf = sc + (hl * 2) * 128; const float* dtb = sc + (hl * 2 + 1) * 128; const float* acf = sc + 1024 + (hl * 2) * 128; const float* acb = sc + 1024 + (hl * 2 + 1) * 128;
        __syncthreads();
#pragma unroll 1
        for (int i = 0; i < 2; ++i) { const int idx = tid + i * 512, lr2 = idx >> 3, c0 = (idx & 7) * 8; float o[8];
            conv8(proj, g0 + lr2, seg_lo, seg_hi, hh * 64 + c0, cw, cb, o);
#pragma unroll
            for (int j = 0; j < 8; ++j) *(bf16_t*)(XT + (c0 + j) * 272 + lr2 * 2) = f2bf(o[j]); }
        { const bf16_t* hp = HP + ((size_t)(ck * 8 + hh) * 2) * 8192;
#pragma unroll
          for (int i = 0; i < 4; ++i) { const int idx = tid + i * 512, dir = idx >> 10, rem = idx & 1023, p = rem >> 4, n8 = (rem & 15) * 8;
              *(u32x4*)((dir ? Hb : Hf) + p * 272 + n8 * 2) = *(const u32x4*)(hp + (size_t)dir * 8192 + p * 128 + n8); } }
        { const float afl = acf[lrow], abl = acb[lrow];
#pragma unroll
          for (int ni = 0; ni < 2; ++ni)
#pragma unroll
              for (int q = 0; q < 4; ++q) { float mv[4];
#pragma unroll
                  for (int j = 0; j < 4; ++j) { const int s = wn * 64 + ni * 32 + 8 * q + 4 * h + j;
                      const float wf = (s <= lrow) ? __expf(afl - acf[s]) * dtf[s] : 0.f, wb = (s >= lrow) ? __expf(abl - acb[s]) * dtb[s] : 0.f;
                      mv[j] = G[0][ni][4 * q + j] * (wf + wb); }
                  u32x2 w; w.x = cvtpk(mv[0], mv[1]); w.y = cvtpk(mv[2], mv[3]);
                  *(u32x2*)(BM + lrow * 272 + (wn * 64 + ni * 32 + 8 * q + 4 * h) * 2) = w; } }
        __syncthreads();
        f32x16 a1[1][1], aF[1][1], aB[1][1];
#pragma unroll
        for (int q = 0; q < 16; ++q) { a1[0][0][q] = 0.f; aF[0][0][q] = 0.f; aB[0][0][q] = 0.f; }
        mma_lds<1, 1, 8, true>(BM + wm * 32 * 272, 272, XT + wn * 32 * 272, 272, a1, r, h);
        mma_lds<1, 1, 8, true>(Cc + wm * 32 * 272, 272, Hf + wn * 32 * 272, 272, aF, r, h);
        mma_lds<1, 1, 8, true>(Cc + wm * 32 * 272, 272, Hb + wn * 32 * 272, 272, aB, r, h);
        const float ef = __expf(acf[lrow]), eb = __expf(acb[lrow]), dsk = a.d_skip[l * 8 + hh];
#pragma unroll
        for (int q = 0; q < 4; ++q) {
            const int p0 = wn * 32 + 8 * q + 4 * h;
            const u32x2 zz = *(const u32x2*)(proj + (size_t)(g0 + lrow) * NP + PC_Z + hh * 64 + p0);
            const float zv[4] = {bf_lo(zz.x), bf_hi(zz.x), bf_lo(zz.y), bf_hi(zz.y)};
            float vv[4];
#pragma unroll
            for (int j = 0; j < 4; ++j) {
                const float xv = bf2f(*(const bf16_t*)(XT + (p0 + j) * 272 + lrow * 2));
                const float y = a1[0][0][4 * q + j] + ef * aF[0][0][4 * q + j] + eb * aB[0][0][4 * q + j] + dsk * xv;
                vv[j] = y * silu_f(zv[j]); ssl += vv[j] * vv[j];
            }
            u32x2 w; w.x = cvtpk(vv[0], vv[1]); w.y = cvtpk(vv[2], vv[3]);
            if (hl == 0) yp0[q] = w; else if (hl == 1) yp1[q] = w; else if (hl == 2) yp2[q] = w; else yp3[q] = w;
        }
    }
    ssq[lrow * 4 + wn * 2 + h] = ssl;
    __syncthreads();
    const float rstd = rsqrtf((ssq[lrow * 4] + ssq[lrow * 4 + 1] + ssq[lrow * 4 + 2] + ssq[lrow * 4 + 3]) * (1.f / 256.f) + 1e-6f);
#pragma unroll
    for (int hl = 0; hl < 4; ++hl)
#pragma unroll
        for (int q = 0; q < 4; ++q) {
            const int ch = gg * 256 + hl * 64 + wn * 32 + 8 * q + 4 * h;
            const f32x4 gs = *(const f32x4*)(a.g_ssm + l * 512 + ch);
            const u32x2 yv = hl == 0 ? yp0[q] : hl == 1 ? yp1[q] : hl == 2 ? yp2[q] : yp3[q];
            *(unsigned*)(mix + (size_t)(g0 + lrow) * DM + 512 + ch) = pk_mix(bf_lo(yv.x) * rstd * gs[0], bf_hi(yv.x) * rstd * gs[1], bf_lo(yv.y) * rstd * gs[2], bf_hi(yv.y) * rstd * gs[3]);
        }
}
DI void ph_ssd_out(const Args& a, int l, unsigned char* sm) {
    if (l == 0) { for (int u = blockIdx.x; u < NCH * 2; u += gridDim.x) ssd_out_unit(a, l, u >> 1, u & 1, sm); }
    else { for (int u = blockIdx.x; u < 256; u += gridDim.x) { const int lc = u >> 1; ssd_out_unit(a, l, (lc >> 6) * 66 + 2 + (lc & 63), u & 1, sm); } }
}

struct EpiOut { float* Y; const float* xres; const float* gate;     int row0, col0;
    DI void operator()(f32x16 (&acc)[2][2], int wm, int wn, int r, int h) const {
#pragma unroll
        for (int mi = 0; mi < 2; ++mi)
#pragma unroll
            for (int ni = 0; ni < 2; ++ni)
#pragma unroll
                for (int q = 0; q < 4; ++q) { const int row = row0 + wm * 64 + mi * 32 + r, col = col0 + wn * 64 + ni * 32 + 8 * q + 4 * h;
                    const f32x4 xr = *(const f32x4*)(xres + (size_t)row * DM + col), gt = *(const f32x4*)(gate + col);
                    f32x4 o; o[0] = DN_ALPHA * xr[0] + gt[0] * acc[mi][ni][4 * q]; o[1] = DN_ALPHA * xr[1] + gt[1] * acc[mi][ni][4 * q + 1];
                    o[2] = DN_ALPHA * xr[2] + gt[2] * acc[mi][ni][4 * q + 2]; o[3] = DN_ALPHA * xr[3] + gt[3] * acc[mi][ni][4 * q + 3];
                    *(f32x4*)(Y + (size_t)row * DM + col) = o; }
    } };
DI void ph_outproj(const Args& a, int l, unsigned char* sm) {
    g8::DenseSched S{(const bf16_t*)(a.ws + WS_MIX), (const bf16_t*)(a.ws + WS_WOUT + (size_t)l * WSTRIDE), 1024, 1024, 8, (l == 0 ? 66 : 64) * 8, (int)gridDim.x, (int)blockIdx.x, l};
    __syncthreads();
    g8::gemm(sm, 1024, 1024, S, EpiOut8{(bf16_t*)(a.ws + WS_Y), 1.f / (64.f * MIXS)});
}

DI void ph_ln1_router(const Args& a, int l, unsigned char* sm) {
    const int tid = tidx(), wave = tid >> 6, lane = tid & 63;
    bf16_t* Y = (bf16_t*)(a.ws + WS_XRES); const bf16_t* MO = (const bf16_t*)(a.ws + WS_Y); unsigned char* tok8 = (unsigned char*)(a.ws + WS_HB); const float* mod = (const float*)(a.ws + WS_MOD);
    const bf16_t* wrh = (const bf16_t*)(a.ws + WS_WRH + (size_t)l * WSTRIDE); const bf16_t* wrl = (const bf16_t*)(a.ws + WS_WRL + (size_t)l * WSTRIDE);
    int* gcnt = (int*)(a.ws + WS_CNT) + l * 64; ListEnt* list = (ListEnt*)(a.ws + WS_LIST); ListEnt* tslot = (ListEnt*)(a.ws + WS_TSLOT);
    constexpr int TLD = 2052;
    float* tokf = (float*)sm;
    float* part = (float*)(sm + 16 * TLD * 4);
    int* lcnt = (int*)(sm + 16 * TLD * 4 + 8192);
    int* lbase = lcnt + 64;
    int* ent0 = lbase + 64;
    const float* g1 = a.ln1_g + l * DM; const float* b1 = a.ln1_b + l * DM; const float* brt = a.b_router + l * 64;
    const int nunits = l == 0 ? MR / 16 : NB * SEQ / 16;
    __syncthreads();
    if (tid < 64) lcnt[tid] = 0;
    int nu = 0;
    for (int u = blockIdx.x; u < nunits && nu < 5; u += gridDim.x, ++nu) {
        const int g0 = l == 0 ? u * 16 : (u < 512 ? CTXL + u * 16 : RPB + CTXL + (u - 512) * 16);
        int* ent = ent0 + nu * 512;
        __syncthreads();
        if (tid < 128) { ent[tid * 4] = g0 + (tid >> 3); ent[tid * 4 + 1] = 0; ent[tid * 4 + 2] = 0; ent[tid * 4 + 3] = 0; }
        { const int rlA = wave * 2, gA = g0 + rlA, gB = gA + 1, bq = gA / RPB, rq = gA % RPB;
          const float* m = mod + ((size_t)l * 3 + (rq < CTXL ? 2 : bq)) * 12288;
          bf16_t* yA = Y + (size_t)gA * DM; bf16_t* yB = Y + (size_t)gB * DM; f32x4 vA[8], vB[8]; float sA = 0.f, sB = 0.f;
          const float* xinA = rq < CTXL ? a.ctx + ((size_t)(bq * CTXL + rq)) * DM : a.x + ((size_t)(bq * SEQ + rq - CTXL)) * DM; const float* xinB = xinA + DM;
#pragma unroll
          for (int j = 0; j < 8; ++j) { const int c = j * 256 + lane * 4; const f32x4 gt = *(const f32x4*)(m + 2 * DM + c);
              const u32x2 mA = __builtin_nontemporal_load((const u32x2*)(MO + (size_t)gA * DM + c)), mB = __builtin_nontemporal_load((const u32x2*)(MO + (size_t)gB * DM + c));
              f32x4 rA, rB;
              if (l == 0) { rA = __builtin_nontemporal_load((const f32x4*)(xinA + c)); rB = __builtin_nontemporal_load((const f32x4*)(xinB + c)); }
              else { const u32x2 wA = __builtin_nontemporal_load((const u32x2*)(yA + c)), wB = __builtin_nontemporal_load((const u32x2*)(yB + c)); rA = (f32x4){bf_lo(wA.x), bf_hi(wA.x), bf_lo(wA.y), bf_hi(wA.y)}; rB = (f32x4){bf_lo(wB.x), bf_hi(wB.x), bf_lo(wB.y), bf_hi(wB.y)}; }
              vA[j] = DN_ALPHA * rA + gt * (f32x4){bf_lo(mA.x), bf_hi(mA.x), bf_lo(mA.y), bf_hi(mA.y)};
              vB[j] = DN_ALPHA * rB + gt * (f32x4){bf_lo(mB.x), bf_hi(mB.x), bf_lo(mB.y), bf_hi(mB.y)}; }
#pragma unroll
          for (int j = 0; j < 8; ++j) { sA += (vA[j][0] + vA[j][1]) + (vA[j][2] + vA[j][3]); sB += (vB[j][0] + vB[j][1]) + (vB[j][2] + vB[j][3]); }
#pragma unroll
          for (int o = 32; o >= 1; o >>= 1) { sA += __shfl_xor(sA, o); sB += __shfl_xor(sB, o); }
          const float muA = sA * (1.f / 2048.f), muB = sB * (1.f / 2048.f); float qA = 0.f, qB = 0.f;
#pragma unroll
          for (int j = 0; j < 8; ++j) { const f32x4 dA = vA[j] - muA, dB = vB[j] - muB; qA += (dA[0] * dA[0] + dA[1] * dA[1]) + (dA[2] * dA[2] + dA[3] * dA[3]); qB += (dB[0] * dB[0] + dB[1] * dB[1]) + (dB[2] * dB[2] + dB[3] * dB[3]); }
#pragma unroll
          for (int o = 32; o >= 1; o >>= 1) { qA += __shfl_xor(qA, o); qB += __shfl_xor(qB, o); }
          const float rsA = rsqrtf(qA * (1.f / 2048.f) + 1e-5f), rsB = rsqrtf(qB * (1.f / 2048.f) + 1e-5f);
#pragma unroll
          for (int j = 0; j < 8; ++j) { const int c = j * 256 + lane * 4;
              const f32x4 gg = *(const f32x4*)(g1 + c), bb = *(const f32x4*)(b1 + c), sc = 1.f + *(const f32x4*)(m + 4 * DM + c), sh = *(const f32x4*)(m + 3 * DM + c);
              const f32x4 xA = (vA[j] - muA) * rsA * gg + bb, xB = (vB[j] - muB) * rsB * gg + bb;
              { u32x2 wA, wB; wA.x = cvtpk(xA[0], xA[1]); wA.y = cvtpk(xA[2], xA[3]); wB.x = cvtpk(xB[0], xB[1]); wB.y = cvtpk(xB[2], xB[3]); *(u32x2*)(yA + c) = wA; *(u32x2*)(yB + c) = wB; }
              const f32x4 tA = xA * sc + sh, tB = xB * sc + sh;
              *(unsigned*)(tok8 + (size_t)gA * DM + c) = pk_fp8(tA); *(unsigned*)(tok8 + (size_t)gB * DM + c) = pk_fp8(tB);
              *(f32x4*)(tokf + rlA * TLD + c) = tA; *(f32x4*)(tokf + (rlA + 1) * TLD + c) = tB; }
        }
        __syncthreads();
        { const int nb = wave & 3, kh = wave >> 2, rw = lane & 15, kq = lane >> 4;
          f32x4 acc = {0.f, 0.f, 0.f, 0.f};
          const float* ap = tokf + rw * TLD + kh * 1024 + kq * 8;
          const bf16_t* bh = wrh + (size_t)(nb * 16 + rw) * 2048 + kh * 1024 + kq * 8; const bf16_t* bl = wrl + (size_t)(nb * 16 + rw) * 2048 + kh * 1024 + kq * 8;
#pragma unroll 8
          for (int ks = 0; ks < 32; ++ks) {
              const f32x4 x0 = *(const f32x4*)(ap + ks * 32), x1 = *(const f32x4*)(ap + ks * 32 + 4);
              u32x4 hw; hw.x = cvtpk(x0[0], x0[1]); hw.y = cvtpk(x0[2], x0[3]); hw.z = cvtpk(x1[0], x1[1]); hw.w = cvtpk(x1[2], x1[3]);
              u32x4 lw; lw.x = cvtpk(x0[0] - bf_lo(hw.x), x0[1] - bf_hi(hw.x)); lw.y = cvtpk(x0[2] - bf_lo(hw.y), x0[3] - bf_hi(hw.y));
              lw.z = cvtpk(x1[0] - bf_lo(hw.z), x1[1] - bf_hi(hw.z)); lw.w = cvtpk(x1[2] - bf_lo(hw.w), x1[3] - bf_hi(hw.w));
              const bf16x8 ahi = *reinterpret_cast<bf16x8*>(&hw), alo = *reinterpret_cast<bf16x8*>(&lw);
              const bf16x8 bhi = *(const bf16x8*)(bh + ks * 32), blo = *(const bf16x8*)(bl + ks * 32);
              acc = __builtin_amdgcn_mfma_f32_16x16x32_bf16(ahi, bhi, acc, 0, 0, 0);
              acc = __builtin_amdgcn_mfma_f32_16x16x32_bf16(ahi, blo, acc, 0, 0, 0);
              acc = __builtin_amdgcn_mfma_f32_16x16x32_bf16(alo, bhi, acc, 0, 0, 0);
          }
#pragma unroll
          for (int j = 0; j < 4; ++j) part[(kh * 16 + kq * 4 + j) * 64 + nb * 16 + rw] = acc[j]; }
        __syncthreads();
#pragma unroll 1
        for (int rr2 = 0; rr2 < 2; ++rr2) {
            const int rl = wave * 2 + rr2, g = g0 + rl;
            const float logit = part[rl * 64 + lane] + part[(16 + rl) * 64 + lane];
            float score = 1.f / (1.f + __expf(-logit)); if (!(score >= 0.f && score <= 1.f)) score = 0.5f;
            const float bsd = score + brt[lane];
            int rk = 0;
#pragma unroll
            for (int j = 0; j < 8; ++j) { const int src = (lane & ~7) + j; const float o = __shfl(bsd, src); rk += (o > bsd || (o == bsd && src < lane)) ? 1 : 0; }
            float gs = rk < 2 ? bsd : 0.f; gs += __shfl_xor(gs, 1); gs += __shfl_xor(gs, 2); gs += __shfl_xor(gs, 4);
            int grk = 0; const int mygrp = lane >> 3;
#pragma unroll
            for (int j = 0; j < 8; ++j) { const float o = __shfl(gs, j * 8); grk += (o > gs || (o == gs && j < mygrp)) ? 1 : 0; }
            const bool elig = grk < 4; const float val = elig ? bsd : -INFINITY;
            int erk = 0;
#pragma unroll
            for (int j = 0; j < 64; ++j) { const float o = __int_as_float(__builtin_amdgcn_readlane(__float_as_int(val), j)); erk += (o > val || (o == val && j < lane)) ? 1 : 0; }
            const bool sel = elig && erk < 8;
            const float wsum = wave_sum(sel ? score : 0.f); const float wgt = score / wsum * 2.5f;
            if (sel) { const int lp = atomicAdd(&lcnt[lane], 1); int* e = ent + (rl * 8 + erk) * 4; e[0] = g; e[1] = lane; e[2] = __float_as_int(wgt); e[3] = lp; }
        }
    }
    __syncthreads();
    if (tid < 64) { const int c = lcnt[tid]; lbase[tid] = c ? atomicAdd(&gcnt[tid], c) : 0; }
    __syncthreads();
    for (int i = tid; i < nu * 128; i += 512) { const int* e = ent0 + i * 4; int pos = lbase[e[1] & 63] + e[3]; pos = pos < 0 ? 0 : (pos >= MR ? MR - 1 : pos);
        ListEnt le; le.row = e[0]; le.w = __int_as_float(e[2]); list[(size_t)e[1] * MR + pos] = le;
        ListEnt ts; ts.row = e[1] * 32768 + pos; ts.w = le.w; tslot[(size_t)e[0] * 8 + (i & 7)] = ts; }
}

DI void moe_offsets(const Args& a, int l, int* mtoff  ) {
    const int tid = tidx();
    if (tid < 64) { const int* gcnt = (const int*)(a.ws + WS_CNT) + l * 64;
        const int c = gcnt[tid], t = (c + 255) >> 8; int incl = t;
#pragma unroll
        for (int o = 1; o < 64; o <<= 1) { const int v = __shfl_up(incl, o); if (tid >= o) incl += v; }
        mtoff[tid] = incl - t; mtoff[72 + tid] = c;
        if (tid == 63) { const int cs = l == 0 ? MR : NB * SEQ; mtoff[64] = incl; mtoff[72 + 64] = cs; mtoff[NE1] = incl + ((cs + 255) >> 8); } }
    __syncthreads();
    if (tid < NE1) { unsigned char* etab = (unsigned char*)(mtoff + 144); const int hi = mtoff[tid + 1] < 1024 ? mtoff[tid + 1] : 1024; for (int m = mtoff[tid]; m < hi; ++m) etab[m] = (unsigned char)tid; }
    __syncthreads();
}
DI int moe_find(const int* mtoff, int mtg) { int e = 0;
#pragma unroll 1
    for (int j = 1; j < NE1; ++j) e = (mtoff[j] <= mtg) ? j : e;
    return e; }
struct ARowGather { const bf16_t* base; const int* rt; DI const bf16_t* operator()(int i) const { return base + (size_t)rt[i] * DM; } };
struct EpiGU { bf16_t* H; int slot0, col0;
    DI void operator()(f32x16 (&acc)[2][2], int wm, int wn, int r, int h) const {
#pragma unroll
        for (int mi = 0; mi < 2; ++mi)
#pragma unroll
            for (int q = 0; q < 4; ++q) { const int row = slot0 + wm * 64 + mi * 32 + r, col = col0 + wn * 32 + 8 * q + 4 * h; float o[4];
#pragma unroll
                for (int j = 0; j < 4; ++j) o[j] = silu_f(acc[mi][0][4 * q + j]) * acc[mi][1][4 * q + j];
                u32x2 w; w.x = cvtpk(o[0], o[1]); w.y = cvtpk(o[2], o[3]); *(u32x2*)(H + (size_t)row * 512 + col) = w; }
    } };
DI void ph_gateup(const Args& a, int l, unsigned char* sm) {
    int* mtoff = (int*)(sm + g8::STAGE_BYTES);
    __syncthreads(); moe_offsets(a, l, mtoff);
    MoeGUSched S{(const bf16_t*)(a.ws + WS_HB), (const bf16_t*)(a.ws + WS_WGU + (size_t)l * WSTRIDE), mtoff, (const int*)(a.ws + WS_CNT) + l * 64, (const ListEnt*)(a.ws + WS_LIST), mtoff[NE1] * 4, (int)gridDim.x, (int)blockIdx.x, l};
    g8::gemm(sm, 1024, 1024, S, EpiGU8{(unsigned char*)(a.ws + WS_H), 1.f / 64.f});
}
DI void ph_down(const Args& a, int l, unsigned char* sm) {
    int* mtoff = (int*)(sm + g8::STAGE_BYTES);
    __syncthreads(); moe_offsets(a, l, mtoff);
    MoeDownSched S{(const bf16_t*)(a.ws + WS_H), (const bf16_t*)(a.ws + WS_WDN + (size_t)l * WSTRIDE), mtoff, mtoff[NE1] * 8, (int)gridDim.x, (int)blockIdx.x};
    g8::gemm(sm, 256, 256, S, EpiDown8{(unsigned char*)(a.ws + WS_O), 1.f / 64.f});
}

DI void ph_ln2(const Args& a, int l, unsigned char* sm) {
    const int tid = tidx(), wave = tid >> 6, lane = tid & 63;
    int* mtoff = (int*)sm;
    __syncthreads(); moe_offsets(a, l, mtoff);
    const bf16_t* X1 = (const bf16_t*)(a.ws + WS_XRES); const unsigned char* O8 = (const unsigned char*)(a.ws + WS_O); const ListEnt* tslot = (const ListEnt*)(a.ws + WS_TSLOT);
    const float* mod = (const float*)(a.ws + WS_MOD); bf16_t* xres = (bf16_t*)(a.ws + WS_XRES); unsigned char* hb8 = (unsigned char*)(a.ws + WS_HB);
    const float* g2 = a.ln2_g + l * DM; const float* b2 = a.ln2_b + l * DM;
    const int nrows = l == 0 ? MR : NB * SEQ;
    for (int gi = blockIdx.x * 8 + wave; gi < nrows; gi += gridDim.x * 8) {
        const int g = l == 0 ? gi : (gi < SEQ ? CTXL + gi : RPB + CTXL + (gi - SEQ));
        const int b = g / RPB, rr = g % RPB;
        const float* m = mod + ((size_t)l * 3 + (rr < CTXL ? 2 : b)) * 12288;
#define LN2_C(j) ((((j) >> 2) << 10) + lane * 16 + (((j) & 3) << 2))
        const ListEnt mine = tslot[(size_t)g * 8 + (lane & 7)];
        f32x4 f[8];
        { const unsigned char* orow = O8 + ((size_t)mtoff[64] * 256 + gi) * DM + lane * 16;
          const u32x4 w0 = __builtin_nontemporal_load((const u32x4*)orow), w1 = __builtin_nontemporal_load((const u32x4*)(orow + 1024));
          f[0] = unpk_fp8(w0.x); f[1] = unpk_fp8(w0.y); f[2] = unpk_fp8(w0.z); f[3] = unpk_fp8(w0.w); f[4] = unpk_fp8(w1.x); f[5] = unpk_fp8(w1.y); f[6] = unpk_fp8(w1.z); f[7] = unpk_fp8(w1.w); }
#pragma unroll 4
        for (int k = 0; k < 8; ++k) {
            const int code = __builtin_amdgcn_readlane(mine.row, k); const float wk = __int_as_float(__builtin_amdgcn_readlane(__float_as_int(mine.w), k));
            int r_ = mtoff[(code >> 15) & 63] * 256 + (code & 32767); r_ = r_ >= HROWS ? HROWS - 1 : r_;
            const unsigned char* orow = O8 + (size_t)r_ * DM + lane * 16;
            const u32x4 w0 = __builtin_nontemporal_load((const u32x4*)orow), w1 = __builtin_nontemporal_load((const u32x4*)(orow + 1024));
            f[0] += wk * unpk_fp8(w0.x); f[1] += wk * unpk_fp8(w0.y); f[2] += wk * unpk_fp8(w0.z); f[3] += wk * unpk_fp8(w0.w);
            f[4] += wk * unpk_fp8(w1.x); f[5] += wk * unpk_fp8(w1.y); f[6] += wk * unpk_fp8(w1.z); f[7] += wk * unpk_fp8(w1.w);
        }
        float s = 0.f;
#pragma unroll
        for (int j = 0; j < 8; ++j) { const int c = LN2_C(j);
            const u32x2 xw = __builtin_nontemporal_load((const u32x2*)(X1 + (size_t)g * DM + c));
            f[j] = DN_ALPHA * (f32x4){bf_lo(xw.x), bf_hi(xw.x), bf_lo(xw.y), bf_hi(xw.y)} + *(const f32x4*)(m + 5 * DM + c) * f[j]; s += (f[j][0] + f[j][1]) + (f[j][2] + f[j][3]); }
        const float mu = wave_sum(s) * (1.f / 2048.f); float q = 0.f;
#pragma unroll
        for (int j = 0; j < 8; ++j) { const f32x4 d = f[j] - mu; q += (d[0] * d[0] + d[1] * d[1]) + (d[2] * d[2] + d[3] * d[3]); }
        const float rstd = rsqrtf(wave_sum(q) * (1.f / 2048.f) + 1e-5f);
        const float* mn = mod + ((size_t)3 + (rr < CTXL ? 2 : b)) * 12288;
        float* orow = a.out + ((size_t)b * SEQ + (rr - CTXL)) * DM;
#pragma unroll
        for (int j = 0; j < 8; ++j) { const int c = LN2_C(j);
            const f32x4 y = (f[j] - mu) * rstd * *(const f32x4*)(g2 + c) + *(const f32x4*)(b2 + c);
            if (l == 0) {
                { u32x2 yw; yw.x = cvtpk(y[0], y[1]); yw.y = cvtpk(y[2], y[3]); *(u32x2*)(xres + (size_t)g * DM + c) = yw; }
                const f32x4 t = y * (1.f + *(const f32x4*)(mn + DM + c)) + *(const f32x4*)(mn + c);
                *(unsigned*)(hb8 + (size_t)g * DM + c) = pk_fp8(t);
            } else *(f32x4*)(orow + c) = y;
        }
    }
}
#undef LN2_C

constexpr int NPH = 21;
__global__ void __launch_bounds__(512, 2) fwd(Args a) {
    extern __shared__ __attribute__((aligned(16))) unsigned char lds[];
    if (threadIdx.x == 0) *(uint4*)lds = make_uint4(0u, 0u, 0u, 0u);
    __syncthreads();
    XcdBarrier bar; bar.bar = (unsigned*)(a.ws + WS_BAR); bar.x = 0; bar.st = nullptr;
    const bool multi = (a.ph_hi - a.ph_lo) > 1;
    if (multi) bar = xcd_barrier_post((unsigned*)(a.ws + WS_BAR), (volatile LAS unsigned*)lds);
    unsigned char* sm = lds + SM0;
    const int lo = a.ph_lo, hi = a.ph_hi;
#ifndef PH_ENABLE
#define PH_ENABLE 0xFFFF
#endif
#define EN(t) (((PH_ENABLE) >> (t)) & 1)
#ifndef REPMASK
#define REPMASK 0
#endif
#define RP(t) (((REPMASK) >> (t)) & 1)
#define IN(k) (lo <= (k) && (k) < hi)
#if defined(__HIP_DEVICE_COMPILE__)
#define ASSUME_GLOBAL(p) __builtin_assume(!__builtin_amdgcn_is_shared((const __attribute__((address_space(0))) void*)(p)) && !__builtin_amdgcn_is_private((const __attribute__((address_space(0))) void*)(p)))
#else
#define ASSUME_GLOBAL(p) ((void)0)
#endif
#define GAS __attribute__((address_space(1)))
#define CAS __attribute__((address_space(4)))
#define GP(f) b.f = (decltype(b.f))(GAS void*)(void*)b.f
#if !defined(__HIP_DEVICE_COMPILE__)
#define LA(b) Args b = a
#else
#define LA(b) Args b; { const CAS Args* kp_ = (const CAS Args*)__builtin_amdgcn_kernarg_segment_ptr(); asm volatile("" : "+s"(kp_)); b = *kp_; \
    GP(x); GP(c); GP(ctx); GP(c_ctx); GP(w_mod); GP(b_mod); GP(w_in); GP(g_q); GP(w_q_b); GP(g_kv); GP(w_kv_b); GP(conv_w); GP(conv_b); GP(a_log); GP(dt_bias); GP(d_skip); GP(g_ssm); GP(g_v); GP(b_v); \
    GP(w_sp); GP(b_sp); GP(w_out); GP(ln1_g); GP(ln1_b); GP(ln2_g); GP(ln2_b); GP(w_router); GP(b_router); GP(w_e_gate); GP(w_e_up); GP(w_e_down); GP(w_sh_gate); GP(w_sh_up); GP(w_sh_down); GP(out); GP(ws); }
#endif
#define SEAM(k) do { if (IN(k) && IN((k) + 1)) xcd_barrier(bar); } while (0)
    if (IN(0)) { if (EN(0)) { LA(b); ph_mod(b, sm); } if (EN(1)) { LA(b); ph_convert_dense(b, 0, sm); } }
    SEAM(0);
#pragma unroll 1
    for (int l = 0; l < 2; ++l) {
        const int pb = 1 + 10 * l;
        if (l == 0) { if (IN(pb + 0) && EN(2)) { LA(b); ph_modulate0(b); } SEAM(pb + 0); }
        if (IN(pb + 1) && EN(3)) { LA(b); ph_inproj(b, l, sm); if (RP(3)) { __syncthreads(); ph_inproj(b, l, sm); } }
        SEAM(pb + 1);
        if (IN(pb + 2) && EN(4)) { LA(b); ph_mixers1(b, l, sm); if (RP(4)) { __syncthreads(); ph_mixers1(b, l, sm); } }
        SEAM(pb + 2);
        if (IN(pb + 3) && EN(5)) { LA(b); ph_attn(b, l, sm); if (RP(5)) { __syncthreads(); ph_attn(b, l, sm); } }
        SEAM(pb + 3);
        if (IN(pb + 4) && EN(6)) { LA(b); ph_ssd_out(b, l, sm); if (RP(6)) { __syncthreads(); ph_ssd_out(b, l, sm); } }
        SEAM(pb + 4);
        if (IN(pb + 5) && EN(7)) { LA(b); ph_outproj(b, l, sm); if (RP(7)) { __syncthreads(); ph_outproj(b, l, sm); } }
        SEAM(pb + 5);
        if (IN(pb + 6) && EN(8)) { LA(b); ph_ln1_router(b, l, sm); }
        SEAM(pb + 6);
        if (IN(pb + 7) && EN(9)) { LA(b); ph_gateup(b, l, sm); if (RP(9)) { __syncthreads(); ph_gateup(b, l, sm); } }
        SEAM(pb + 7);
        if (IN(pb + 8) && EN(10)) { LA(b); ph_down(b, l, sm); if (RP(10)) { __syncthreads(); ph_down(b, l, sm); } }
        SEAM(pb + 8);
        if (IN(pb + 9) && EN(11)) { LA(b); ph_ln2(b, l, sm); if (RP(11)) { __syncthreads(); ph_ln2(b, l, sm); } }
        SEAM(pb + 9);
    }
#undef IN
#undef SEAM
}


#ifdef DBG_NANCHK
__global__ void chk_kernel(const void* p, size_t n, int is_bf16, unsigned* flags, int idx) {
    bool bad = false;
    for (size_t i = (size_t)blockIdx.x * blockDim.x + threadIdx.x; i < n; i += (size_t)gridDim.x * blockDim.x) {
        float v = is_bf16 ? __uint_as_float(((unsigned)((const unsigned short*)p)[i]) << 16) : ((const float*)p)[i];
        if (!(fabsf(v) < 1e30f)) bad = true;
    }
    if (bad) atomicOr(&flags[idx], 1u);
}
__global__ void chk_rows(const unsigned short* p, int rows, int cols, unsigned* res) {
    for (int r = blockIdx.x; r < rows; r += gridDim.x) { bool bad = false;
        for (int c = threadIdx.x; c < cols; c += blockDim.x) { const float v = __uint_as_float(((unsigned)p[(size_t)r * cols + c]) << 16); if (!(fabsf(v) < 1e30f)) bad = true; }
        if (__syncthreads_or(bad ? 1 : 0)) { if (threadIdx.x == 0) { atomicMin(&res[0], (unsigned)r); atomicAdd(&res[1], 1u); } } }
}
__global__ void chk_final2(float* out, size_t n, const unsigned* res, const int* gcnt) {
    int tot = 0; for (int e = 0; e < 64; ++e) tot += (gcnt[e] + 255) >> 8;
    float V = DBG_WHICH == 0 ? (float)res[0] : DBG_WHICH == 1 ? (float)res[1] : (float)tot * 256.f;
    for (size_t i = (size_t)blockIdx.x * blockDim.x + threadIdx.x; i < n; i += (size_t)gridDim.x * blockDim.x) out[i] = (i == 0) ? V : 0.f;
}
__global__ void chk_final(float* out, size_t n, const unsigned* flags) {
    int first = 90;
    for (int i = 89; i >= 0; --i) if (flags[i]) first = i;
    const float V = 100.f * (1.f + (float)first);
    for (size_t i = (size_t)blockIdx.x * blockDim.x + threadIdx.x; i < n; i += (size_t)gridDim.x * blockDim.x) out[i] = (i == 0) ? V : 0.f;
}
#endif
extern "C" void kernel_launch(void* const* d_in, const int* in_sizes, int n_in, void* d_out, int out_size, void* d_ws, size_t ws_size, hipStream_t stream) {
    static int grid = 0;
    if (grid == 0) {
        if (n_in != 34 || out_size != NB * SEQ * DM || ws_size < WS_END) { fprintf(stderr, "kernel_launch: unexpected shapes (n_in %d, out %d, ws %zu, need %zu)\n", n_in, out_size, ws_size, (size_t)WS_END); grid = -1; return; }
        int dev = 0, cus = 0, per_cu = 0;
        if (hipGetDevice(&dev) != hipSuccess || hipDeviceGetAttribute(&cus, hipDeviceAttributeMultiprocessorCount, dev) != hipSuccess) { grid = -1; return; }
        if (hipFuncSetAttribute((const void*)fwd, hipFuncAttributeMaxDynamicSharedMemorySize, LDS_BYTES) != hipSuccess) { fprintf(stderr, "kernel_launch: hipFuncSetAttribute failed\n"); grid = -1; return; }
        if (hipOccupancyMaxActiveBlocksPerMultiprocessor(&per_cu, (const void*)fwd, 512, LDS_BYTES) != hipSuccess || per_cu < 1) fprintf(stderr, "kernel_launch: occupancy query says %d\n", per_cu);
        (void)hipGetLastError();
        grid = cus;
    }
    if (grid < 0) return;
    (void)hipMemsetAsync(d_ws, 0, ZERO_BYTES, stream);
    Args a{};
    const float** pp = (const float**)&a;
    for (int i = 0; i < 34; ++i) pp[i] = (const float*)d_in[i];
    a.out = (float*)d_out; a.ws = (unsigned char*)d_ws;
#if N_LAUNCH_MODE == 1
#ifdef DBG_NANCHK
    unsigned* flags = (unsigned*)((unsigned char*)d_ws + WS_CNT + 4096);
    unsigned char* W = (unsigned char*)d_ws;
#define CHK(off, n, isb) hipLaunchKernelGGL(chk_kernel, dim3(1024), dim3(256), 0, stream, (const void*)(W + (off)), (size_t)(n), isb, flags, p)
#endif
    for (int p = 0; p < NPH; ++p) { a.ph_lo = p; a.ph_hi = p + 1; hipLaunchKernelGGL(fwd, dim3(grid), dim3(512), LDS_BYTES, stream, a);
#ifdef DBG_NANCHK
        const int k = p == 0 ? -1 : (p - 1) % 10, l = p == 0 ? 0 : (p - 1) / 10, o = 20 * l;
#undef CHK
#define CHK(off, n, isb, idx) hipLaunchKernelGGL(chk_kernel, dim3(1024), dim3(256), 0, stream, (const void*)(W + (off)), (size_t)(n), isb, flags, idx)
        if (p == 0) CHK(WS_MOD, 2 * 3 * 12288, 0, 1);
        if (p == 0) { CHK(WS_WGU, (size_t)NE1 * 1024 * 2048, 1, 2); CHK(WS_WDN, (size_t)NE1 * 2048 * 512, 1, 3); }
        if (k == 1) { CHK(WS_PROJ, (size_t)MR * NP, 1, o + 4); CHK(WS_DT, (size_t)MR * 16, 0, o + 5); }
        if (k == 2) { CHK(WS_Q, (size_t)MR * 1536, 1, o + 6); CHK(WS_KV, (size_t)MR * 2048, 1, o + 7); CHK(WS_KRR, (size_t)MR * 64, 1, o + 8); CHK(WS_ST, (size_t)NCH * 16 * 8192, 0, o + 9); CHK(WS_DEC, (size_t)NCH * 16, 0, o + 10); }
        if (k == 3) { CHK(WS_HP, (size_t)NCH * 16 * 8192, 1, o + 11); }
        if (k == 4 && l == 0) { CHK(WS_MIX, (size_t)MR * DM, 1, o + 12); }
        if (k == 5) { CHK(WS_Y, (size_t)MR * DM, 0, o + 13); }
        if (k == 6) { CHK(WS_Y, (size_t)MR * DM, 0, o + 14); CHK(WS_HB, (size_t)MR * DM, 1, o + 15); }
        if (k == 7) { CHK(WS_H, (size_t)150000 * 512, 1, o + 16); }
        if (k == DBG_K && l == 0) { hipMemsetAsync(flags + 100, 0x7f, 4, stream); hipLaunchKernelGGL(chk_rows, dim3(2048), dim3(256), 0, stream, (const unsigned short*)(W + WS_O), DBG_ROWS, 2048, flags + 100);
            hipLaunchKernelGGL(chk_final2, dim3(1024), dim3(256), 0, stream, (float*)d_out, (size_t)out_size, (const unsigned*)(flags + 100), (const int*)(W + WS_CNT)); break; }
        if (k == 9 && l == 0) { CHK(WS_XRES, (size_t)MR * DM, 0, o + 18); CHK(WS_HB, (size_t)MR * DM, 1, o + 19); }
#endif
    }
#if 0
    hipLaunchKernelGGL(chk_final, dim3(1024), dim3(256), 0, stream, (float*)d_out, (size_t)out_size, (const unsigned*)flags);
#endif
#else
    a.ph_lo = 0; a.ph_hi = NPH; hipLaunchKernelGGL(fwd, dim3(grid), dim3(512), LDS_BYTES, stream, a);
#endif
    const hipError_t le = hipPeekAtLastError();
    if (le != hipSuccess) fprintf(stderr, "kernel_launch: launch failed: %s\n", hipGetErrorName(le));
}
```

```cpp
#include <hip/hip_runtime.h>
#include <cstdio>
#include <cstdint>

#ifndef DBG_WHICH
#define DBG_WHICH 1
#define DBG_K 8
#define DBG_ROWS 32
#endif
#ifndef N_LAUNCH_MODE
#define N_LAUNCH_MODE 0
#endif

#define DI __device__ __forceinline__
typedef unsigned short bf16_t;
typedef short bf16x8 __attribute__((ext_vector_type(8)));
typedef short s16x4 __attribute__((ext_vector_type(4)));
typedef float f32x16 __attribute__((ext_vector_type(16)));
typedef float f32x4 __attribute__((ext_vector_type(4)));
typedef unsigned u32x4 __attribute__((ext_vector_type(4)));
typedef unsigned u32x2 __attribute__((ext_vector_type(2)));

constexpr int DM = 2048, NB = 2, SEQ = 8192, CTXL = 256, RPB = CTXL + SEQ, MR = NB * RPB;
constexpr int NCH = MR / 128;
constexpr int NP = 3840;
constexpr int PC_GM = 0, PC_Q = 1024, PC_Z = 1792, PC_XBC = 2304, PC_KV = 3328, PC_KR = 3584, PC_DT = 3648;
constexpr int IN_W = 3664;
constexpr int NEXP = 64, NE1 = 65;
constexpr float DN_ALPHA = 1.4142135623730951f;
constexpr int HROWS = 172032;

constexpr size_t al256(size_t x) { return (x + 255) / 256 * 256; }
constexpr size_t WS_BAR = 0;
constexpr size_t WS_CNT = 16384;
constexpr size_t WS_MOD = 32768;
constexpr size_t ZERO_BYTES = 32768;
constexpr size_t WS_MODP = WS_MOD + (size_t)2 * 3 * 12288 * 4;
constexpr size_t WS_RSS = WS_MODP + (size_t)4 * 2 * 3 * 12288 * 4;
constexpr size_t WS_WIN = al256(WS_RSS + (size_t)MR * 16 * 4);
constexpr size_t WS_WQB = WS_WIN + (size_t)NP * 2048 * 2;
constexpr size_t WS_WKVB = WS_WQB + (size_t)1536 * 768 * 2;
constexpr size_t WS_WOUT = WS_WKVB + (size_t)2048 * 256 * 2;
constexpr size_t WS_WGU = WS_WOUT + (size_t)2048 * 2048 * 2;
constexpr size_t WS_WDN = WS_WGU + (size_t)NE1 * 1024 * 2048 * 2;
constexpr size_t WS_WRH = WS_WDN + (size_t)NE1 * 2048 * 512 * 2;
constexpr size_t WS_WRL = WS_WRH + (size_t)64 * 2048 * 2;
constexpr size_t WS_XRES = WS_WRL + (size_t)64 * 2048 * 2;
constexpr size_t WS_HB = WS_XRES + (size_t)MR * DM * 4;
constexpr size_t WS_Y = WS_HB + (size_t)MR * DM * 2;
constexpr size_t WS_H = WS_Y + (size_t)MR * DM * 4;
constexpr size_t WS_LIST = WS_H + (size_t)HROWS * 512 * 2;
constexpr size_t WS_TSLOT = WS_LIST + (size_t)64 * MR * 8;
constexpr size_t WS_O = al256(WS_TSLOT + (size_t)MR * 8 * 8);
constexpr size_t WS_PROJ = WS_O;
constexpr size_t WS_DT = WS_PROJ + (size_t)MR * NP * 2;
constexpr size_t WS_Q = WS_DT + (size_t)MR * 16 * 4;
constexpr size_t WS_KV = WS_Q + (size_t)MR * 1536 * 2;
constexpr size_t WS_KRR = WS_KV + (size_t)MR * 2048 * 2;
constexpr size_t WS_ST = WS_KRR + (size_t)MR * 64 * 2;
constexpr size_t WS_HP = WS_ST + (size_t)NCH * 16 * 8192 * 4;
constexpr size_t WS_DEC = WS_HP + (size_t)NCH * 16 * 8192 * 2;
constexpr size_t WS_MIX = al256(WS_DEC + (size_t)NCH * 16 * 4);
constexpr size_t WS_MIXEND = WS_MIX + (size_t)MR * DM * 2;
constexpr size_t WS_OEND = WS_O + (size_t)HROWS * 2048 * 2;
constexpr size_t WS_W1 = al256(WS_OEND > WS_MIXEND ? WS_OEND : WS_MIXEND);
constexpr size_t WSTRIDE = WS_W1 - WS_WIN;
constexpr size_t WS_END = WS_W1 + (WS_XRES - WS_WIN);

constexpr int LDS_BYTES = 156 * 1024;
constexpr int SM0 = 256;

#define XB_TMO      128
#define XB_XCNT(j)  (256  + 64 * (j))
#define XB_XSUB(j)  (1280 + 64 * (j))
#define XB_XGEN(j)  (2304 + 64 * (j))
#define XB_TOP      3328
#define XB_TOPGEN   3392
#define XCD_BAR_WORDS 3456
#define XB_SPIN_CAP (1u << 18)
#define LAS __attribute__((address_space(3)))

__device__ __forceinline__ unsigned xb_ld(unsigned* p)              { return __hip_atomic_load(p, __ATOMIC_RELAXED, __HIP_MEMORY_SCOPE_AGENT); }
__device__ __forceinline__ unsigned xb_add(unsigned* p, unsigned v) { return __hip_atomic_fetch_add(p, v, __ATOMIC_RELAXED, __HIP_MEMORY_SCOPE_AGENT); }
__device__ __forceinline__ unsigned xb_xcc_id() { return (unsigned)__builtin_amdgcn_s_getreg((3 << 11) | 20) & 0xFu; }
#define XB_SPIN(cond, bar) do { unsigned _sp = 0; while (cond) { __builtin_amdgcn_s_sleep(1); \
    if ((++_sp & 255u) == 0u) { if (xb_ld(&(bar)[XB_TMO])) break; if (_sp > XB_SPIN_CAP) { atomicAdd(&(bar)[XB_TMO], 1u); break; } } } } while (0)

struct XcdBarrier { unsigned* bar; unsigned x; volatile LAS unsigned* st; };

__device__ __forceinline__ XcdBarrier xcd_barrier_post(unsigned* bar, volatile LAS unsigned* st) {
    XcdBarrier b; b.bar = bar; b.x = xb_xcc_id(); b.st = st;
    if (threadIdx.x == 0) (void)xb_add(&bar[XB_XCNT(b.x)], 1u);
    return b;
}
__device__ __forceinline__ void xcd_barrier_complete(unsigned* bar, unsigned x, unsigned& nloc, unsigned& nx) {
    const unsigned G = gridDim.x * gridDim.y * gridDim.z;
    unsigned sum, cnt, mine, sp = 0u;
    for (;;) {
        sum = 0u; cnt = 0u; mine = 0u;
#pragma unroll
        for (unsigned j = 0; j < 16; ++j) { const unsigned c = xb_ld(&bar[XB_XCNT(j)]); sum += c; cnt += (c > 0u) ? 1u : 0u; mine = (j == x) ? c : mine; }
        if (sum == G) break;
        __builtin_amdgcn_s_sleep(1);
        if ((++sp & 255u) == 0u) { if (xb_ld(&bar[XB_TMO])) break; if (sp > XB_SPIN_CAP) { atomicAdd(&bar[XB_TMO], 1u); break; } }
    }
    nloc = mine > 0u ? mine : 1u; nx = cnt > 0u ? cnt : 1u;
}
__device__ __forceinline__ void xcd_barrier(const XcdBarrier& b) {
    asm volatile("s_waitcnt vmcnt(0)" ::: "memory");
    __syncthreads();
    if (threadIdx.x == 0) {
        unsigned* bar = b.bar;
        __builtin_amdgcn_s_waitcnt(0);
        unsigned nloc = b.st[0], nx = b.st[1];
        if (nloc == 0u) { xcd_barrier_complete(bar, b.x, nloc, nx); b.st[0] = nloc; b.st[1] = nx; }
        const unsigned old = xb_add(&bar[XB_XSUB(b.x)], 1u);
        const unsigned gen = old / nloc;
        if (old + 1u == (gen + 1u) * nloc) {
            __builtin_amdgcn_fence(__ATOMIC_RELEASE, "agent");
            asm volatile("s_waitcnt vmcnt(0)" ::: "memory");
            const unsigned og = xb_add(&bar[XB_TOP], 1u);
            const unsigned tg = og / nx;
            if (og + 1u == (tg + 1u) * nx) xb_add(&bar[XB_TOPGEN], 1u);
            else XB_SPIN(xb_ld(&bar[XB_TOPGEN]) == tg, bar);
            __builtin_amdgcn_fence(__ATOMIC_ACQUIRE, "agent");
            xb_add(&bar[XB_XGEN(b.x)], 1u);
            asm volatile("s_waitcnt vmcnt(0)" ::: "memory");
        } else {
            XB_SPIN(xb_ld(&bar[XB_XGEN(b.x)]) == gen, bar);
            __builtin_amdgcn_fence(__ATOMIC_ACQUIRE, "agent");
            asm volatile("s_waitcnt vmcnt(0)" ::: "memory");
        }
    }
    __syncthreads();
}

typedef __bf16 bf16x2_t __attribute__((ext_vector_type(2)));
typedef float f32x2_t __attribute__((ext_vector_type(2)));
DI unsigned cvtpk(float lo, float hi) { f32x2_t v = {lo, hi}; bf16x2_t b = __builtin_convertvector(v, bf16x2_t); return __builtin_bit_cast(unsigned, b); }
DI unsigned pk_fp8(f32x4 v) { int w = __float_as_int(v[0]);
    w = __builtin_amdgcn_cvt_pk_fp8_f32(v[0], v[1], w, false); w = __builtin_amdgcn_cvt_pk_fp8_f32(v[2], v[3], w, true); return (unsigned)w; }
constexpr float MIXS = 16.f;
DI unsigned pk_mix(float a0, float a1, float a2, float a3) { const f32x4 v = {__builtin_amdgcn_fmed3f(a0 * MIXS, -448.f, 448.f), __builtin_amdgcn_fmed3f(a1 * MIXS, -448.f, 448.f), __builtin_amdgcn_fmed3f(a2 * MIXS, -448.f, 448.f), __builtin_amdgcn_fmed3f(a3 * MIXS, -448.f, 448.f)}; return pk_fp8(v); }
DI f32x4 unpk_fp8(unsigned w) { const f32x2_t lo = __builtin_amdgcn_cvt_pk_f32_fp8((int)w, false), hi = __builtin_amdgcn_cvt_pk_f32_fp8((int)w, true); return (f32x4){lo[0], lo[1], hi[0], hi[1]}; }
DI float bf_lo(unsigned w) { return __uint_as_float(w << 16); }
DI float bf_hi(unsigned w) { return __uint_as_float(w & 0xffff0000u); }
DI float bf2f(bf16_t b) { return __uint_as_float(((unsigned)b) << 16); }
DI bf16_t f2bf(float f) { return (bf16_t)(cvtpk(f, 0.f) & 0xffffu); }
DI float silu_f(float x) { return x * __builtin_amdgcn_rcpf(1.f + __expf(-x)); }
DI float gelu_f(float v) {
    const float av = fabsf(v), t = __builtin_amdgcn_rcpf(av * 0.2316418882f + 1.0f);
    float q = t * 0.5307027145f + (-0.7265760135f); q = q * t + 0.7107068705f; q = q * t + (-0.142248368f); q = q * t + 0.127414796f; q = q * t;
    const float e = __builtin_amdgcn_exp2f((v * v) * (-0.72134752044f));
    const float m = v * (q * e);
    return v < 0.f ? m : v - m;
}
DI int crow(int r, int hi) { return (r & 3) + 8 * (r >> 2) + 4 * hi; }
DI int tidx() { int t = threadIdx.x; asm volatile("" : "+v"(t)); return t; }
DI float wave_sum(float v) { for (int o = 32; o >= 1; o >>= 1) v += __shfl_xor(v, o); return v; }

struct Args {
    const float *x, *c, *ctx, *c_ctx, *w_mod, *b_mod, *w_in, *g_q, *w_q_b, *g_kv, *w_kv_b, *conv_w, *conv_b, *a_log, *dt_bias, *d_skip,
                *g_ssm, *g_v, *b_v, *w_sp, *b_sp, *w_out, *ln1_g, *ln1_b, *ln2_g, *ln2_b, *w_router, *b_router, *w_e_gate, *w_e_up,
                *w_e_down, *w_sh_gate, *w_sh_up, *w_sh_down;
    float* out; unsigned char* ws; int ph_lo, ph_hi;
};

template <int MI, int NI, int KS, bool SWAP>
DI void mma_lds(const unsigned char* As, int lda, const unsigned char* Bs, int ldb, f32x16 (&acc)[MI][NI], int r, int h) {
#pragma unroll
    for (int ks = 0; ks < KS; ++ks) {
        bf16x8 a[MI], b[NI];
#pragma unroll
        for (int mi = 0; mi < MI; ++mi) a[mi] = *(const bf16x8*)(As + (mi * 32 + r) * lda + (ks * 16 + h * 8) * 2);
#pragma unroll
        for (int ni = 0; ni < NI; ++ni) b[ni] = *(const bf16x8*)(Bs + (ni * 32 + r) * ldb + (ks * 16 + h * 8) * 2);
#pragma unroll
        for (int mi = 0; mi < MI; ++mi)
#pragma unroll
            for (int ni = 0; ni < NI; ++ni)
                acc[mi][ni] = SWAP ? __builtin_amdgcn_mfma_f32_32x32x16_bf16(b[ni], a[mi], acc[mi][ni], 0, 0, 0)
                                   : __builtin_amdgcn_mfma_f32_32x32x16_bf16(a[mi], b[ni], acc[mi][ni], 0, 0, 0);
    }
}

#define XSWZ(R, kb) ((((kb) ^ (((R) >> 3) & 15))) << 4)
template <int MI, int NI, int KS, bool SWAP, bool SWZA, bool SWZB>
DI void mma_lds_x(const unsigned char* As, int lda, int rowA0, const unsigned char* Bs, int ldb, int rowB0, f32x16 (&acc)[MI][NI], int r, int h) {
#pragma unroll
    for (int ks = 0; ks < KS; ++ks) {
        bf16x8 a[MI], b[NI];
#pragma unroll
        for (int mi = 0; mi < MI; ++mi) a[mi] = *(const bf16x8*)(As + (mi * 32 + r) * lda + (SWZA ? XSWZ(rowA0 + mi * 32 + r, ks * 2 + h) : (ks * 16 + h * 8) * 2));
#pragma unroll
        for (int ni = 0; ni < NI; ++ni) b[ni] = *(const bf16x8*)(Bs + (ni * 32 + r) * ldb + (SWZB ? XSWZ(rowB0 + ni * 32 + r, ks * 2 + h) : (ks * 16 + h * 8) * 2));
#pragma unroll
        for (int mi = 0; mi < MI; ++mi)
#pragma unroll
            for (int ni = 0; ni < NI; ++ni)
                acc[mi][ni] = SWAP ? __builtin_amdgcn_mfma_f32_32x32x16_bf16(b[ni], a[mi], acc[mi][ni], 0, 0, 0)
                                   : __builtin_amdgcn_mfma_f32_32x32x16_bf16(a[mi], b[ni], acc[mi][ni], 0, 0, 0);
    }
}
DI int xswz_off(int R, int s, int ld) { return R * ld + XSWZ(R, s >> 3) + (s & 7) * 2; }

constexpr int GT_LD = 144;
constexpr int GT_BYTES = (256 + 128) * GT_LD;
template <bool SWAP, class AR, class EP>
DI void gemm_tile(unsigned char* sm, const AR& arow, const bf16_t* Bt, size_t ldb, int K, const EP& ep) {
    const int tid = tidx(), wave = tid >> 6, lane = tid & 63, r = lane & 31, h = lane >> 5, wm = wave >> 1, wn = wave & 1;
    unsigned char* As = sm; unsigned char* Bs = sm + 256 * GT_LD;
    const int lr = tid >> 3, kc = (tid & 7) * 8;
    const bf16_t* ap[4]; const bf16_t* bp[2];
#pragma unroll
    for (int i = 0; i < 4; ++i) ap[i] = arow(lr + 64 * i) + kc;
#pragma unroll
    for (int i = 0; i < 2; ++i) bp[i] = Bt + (size_t)(lr + 64 * i) * ldb + kc;
    u32x4 ra[4], rb[2];
#pragma unroll
    for (int i = 0; i < 4; ++i) ra[i] = *(const u32x4*)(ap[i]);
#pragma unroll
    for (int i = 0; i < 2; ++i) rb[i] = *(const u32x4*)(bp[i]);
    f32x16 acc[2][2];
#pragma unroll
    for (int i = 0; i < 2; ++i)
#pragma unroll
        for (int j = 0; j < 2; ++j)
#pragma unroll
            for (int q = 0; q < 16; ++q) acc[i][j][q] = 0.f;
    const int nk = K >> 6;
    for (int kt = 0; kt < nk; ++kt) {
        __syncthreads();
#pragma unroll
        for (int i = 0; i < 4; ++i) *(u32x4*)(As + (lr + 64 * i) * GT_LD + kc * 2) = ra[i];
#pragma unroll
        for (int i = 0; i < 2; ++i) *(u32x4*)(Bs + (lr + 64 * i) * GT_LD + kc * 2) = rb[i];
        __syncthreads();
        if (kt + 1 < nk) {
#pragma unroll
            for (int i = 0; i < 4; ++i) ra[i] = *(const u32x4*)(ap[i] + (kt + 1) * 64);
#pragma unroll
            for (int i = 0; i < 2; ++i) rb[i] = *(const u32x4*)(bp[i] + (kt + 1) * 64);
        }
        mma_lds<2, 2, 4, SWAP>(As + wm * 64 * GT_LD, GT_LD, Bs + wn * 64 * GT_LD, GT_LD, acc, r, h);
    }
    ep(acc, wm, wn, r, h);
}


namespace g8 {
typedef int i32x4_t __attribute__((ext_vector_type(4)));
typedef int i32x8_t __attribute__((ext_vector_type(8)));
constexpr int BM = 256, BK = 64, HALF = 128, HTB = HALF * BK * 2, STAGE_BYTES = 8 * HTB;
DI int lds_byte(int r, int c) { const int st = (r >> 4) * 2 + (c >> 5), rr = r & 15, cc = c & 31, ob = rr * 64 + cc * 2; return st * 1024 + (ob ^ (((ob >> 9) & 1) << 5)); }
DI void stage_rc(int b, int& R, int& C) { const int st = b / 1024, sb = b % 1024, swz = sb ^ (((sb >> 9) & 1) << 5); R = (st >> 1) * 16 + swz / 64; C = (st & 1) * 32 + (swz % 64) / 2; }
DI int perm32(int rho) { const int n = rho >> 4, i = rho & 15; return 8 * (i >> 2) + 4 * n + (i & 3); }
struct Unit { const char* Ab; const char* Bb; int p0, p1, p2; };
template <class Epi, class Sched>
DI void gemm(unsigned char* lds_generic, const int K, const int ldb  , const Sched& S, const Epi& E) {
    LAS unsigned char* lds = (LAS unsigned char*)lds_generic;
    const int tid = tidx(), wid = __builtin_amdgcn_readfirstlane(tid >> 6), lane = tid & 63, wr = wid >> 2, wc = wid & 3, fr = lane & 15, fq = lane >> 4;
    const int nt = K / BK;
    int R0, C0, R1, C1; stage_rc(tid * 16, R0, C0); stage_rc(tid * 16 + 8192, R1, C1);
    unsigned voffB[2];
    { int Rb[2]; const int Rs[2] = {R0, R1};
#pragma unroll
      for (int i = 0; i < 2; ++i) { const int R = Rs[i], x = R & 31;
          Rb[i] = Epi::ADJ16 ? 64 * (R >> 5) + 16 * ((x >> 2) & 3) + 4 * (x >> 4) + (x & 3) : (Epi::PERM ? (R & ~31) + perm32(x) : R); }
      voffB[0] = (unsigned)(Rb[0] * ldb + C0) * 2u; voffB[1] = (unsigned)(Rb[1] * ldb + C1) * 2u; }
    const size_t hstepB = (size_t)(Epi::ADJ16 ? 8 : HALF) * ldb * 2;
    const unsigned ldsw = (unsigned)wid * 1024u;
    const int aoff = lds_byte(wr * 64 + fr, fq * 8), boff = lds_byte(wc * 32 + fr, fq * 8);
#define G8_SA(b, h) (((b) * 2 + (h)) * HTB)
#define G8_SB(b, h) ((4 + (b) * 2 + (h)) * HTB)
#define G8_STA(bufoff, U, AO, h, kb) do { _Pragma("unroll") for (int _i = 0; _i < 2; ++_i) \
        __builtin_amdgcn_global_load_lds((const unsigned*)((U).Ab + (kb) + (AO)[h][_i]), (LAS unsigned*)(lds + (bufoff) + ldsw + _i * 8192), 16, 0, 0); } while (0)
#define G8_STB(bufoff, U, h, kb) do { _Pragma("unroll") for (int _i = 0; _i < 2; ++_i) \
        __builtin_amdgcn_global_load_lds((const unsigned*)((U).Bb + (kb) + (h) * hstepB + voffB[_i]), (LAS unsigned*)(lds + (bufoff) + ldsw + _i * 8192), 16, 0, 0); } while (0)
#define G8_LD8(addr) __builtin_shufflevector(*(const LAS i32x4_t*)(addr), *(const LAS i32x4_t*)((addr) + 1024), 0, 1, 2, 3, 4, 5, 6, 7)
#define G8_LDA(dst, b, h) do { _Pragma("unroll") for (int m = 0; m < 4; ++m) dst[m] = G8_LD8(lds + G8_SA(b, h) + aoff + m * 2048); } while (0)
#define G8_LDB(dst, b, h) do { _Pragma("unroll") for (int n = 0; n < 2; ++n) dst[n] = G8_LD8(lds + G8_SB(b, h) + boff + n * 2048); } while (0)
#define G8_LO(x) __builtin_bit_cast(bf16x8, __builtin_shufflevector(x, x, 0, 1, 2, 3))
#define G8_HI(x) __builtin_bit_cast(bf16x8, __builtin_shufflevector(x, x, 4, 5, 6, 7))
#define G8_MMA(ai, bj, At, Bt) do { __builtin_amdgcn_s_setprio(1); \
        if constexpr (Epi::FP8) { _Pragma("unroll") for (int m = 0; m < 4; ++m) _Pragma("unroll") for (int n = 0; n < 2; ++n) \
            asm volatile("v_mfma_scale_f32_16x16x128_f8f6f4 %0, %1, %2, %0, %4, %3 op_sel_hi:[0,0,0]" : "+v"(acc[ai][bj][m][n]) : "v"(Bt[n]), "v"(At[m]), "v"(fp8_unit_scale), "v"(fp8_w_scale)); } \
        else { _Pragma("unroll") for (int m = 0; m < 4; ++m) _Pragma("unroll") for (int n = 0; n < 2; ++n) { \
            acc[ai][bj][m][n] = __builtin_amdgcn_mfma_f32_16x16x32_bf16(G8_LO(Bt[n]), G8_LO(At[m]), acc[ai][bj][m][n], 0, 0, 0); \
            acc[ai][bj][m][n] = __builtin_amdgcn_mfma_f32_16x16x32_bf16(G8_HI(Bt[n]), G8_HI(At[m]), acc[ai][bj][m][n], 0, 0, 0); } } \
        __builtin_amdgcn_s_setprio(0); } while (0)
#define G8_WAIT_V(n) asm volatile("s_waitcnt vmcnt(" #n ")" ::: "memory")
#define G8_WAIT_L(n) asm volatile("s_waitcnt lgkmcnt(" #n ")" ::: "memory")
#define G8_BAR __builtin_amdgcn_s_barrier()
#define G8_SCHED __builtin_amdgcn_sched_barrier(0)
    Unit cur, nxt; int ui = 0; unsigned aoC[2][2], aoN[2][2];
    if (!Sched::GATHER) { S.lane_offsets(aoC, R0, C0, R1, C1); }
    if (!S.next(0, cur, aoC, R0, C0, R1, C1)) return;
    f32x4 acc[2][2][4][2];
#pragma unroll
    for (int a = 0; a < 2; ++a)
#pragma unroll
        for (int b = 0; b < 2; ++b)
#pragma unroll
            for (int m = 0; m < 4; ++m)
#pragma unroll
                for (int n = 0; n < 2; ++n) acc[a][b][m][n] = (f32x4){0.f, 0.f, 0.f, 0.f};
    i32x8_t At[4], B0[2], B1[2];
    int fp8_unit_scale = 0x7f7f7f7f, fp8_w_scale = Epi::WSC * 0x01010101; asm volatile("" : "+v"(fp8_unit_scale), "+v"(fp8_w_scale));
    G8_STB(G8_SB(0, 0), cur, 0, 0); G8_STA(G8_SA(0, 0), cur, aoC, 0, 0); G8_STB(G8_SB(0, 1), cur, 1, 0); G8_STA(G8_SA(0, 1), cur, aoC, 1, 0);
    if (wr == 1) G8_BAR;
    G8_WAIT_V(4); G8_BAR;
    G8_STB(G8_SB(1, 0), cur, 0, 128); G8_STA(G8_SA(1, 0), cur, aoC, 0, 128); G8_STB(G8_SB(1, 1), cur, 1, 128);
    G8_WAIT_V(6); G8_BAR;
    for (;;) {
        const bool has_next = S.next(ui + 1, nxt, aoN, R0, C0, R1, C1);
        if (!has_next) { nxt = cur; if (Sched::GATHER) { aoN[0][0] = aoC[0][0]; aoN[0][1] = aoC[0][1]; aoN[1][0] = aoC[1][0]; aoN[1][1] = aoC[1][1]; } }
#pragma unroll 1
        for (int t = 0; t < nt; t += 2) {
            const bool last = (t == nt - 2);
            const size_t k1 = (size_t)(t + 1) * 128, k2 = last ? 0 : (size_t)(t + 2) * 128, k3 = k2 + 128;
            Unit U2; U2.Ab = last ? nxt.Ab : cur.Ab; U2.Bb = last ? nxt.Bb : cur.Bb; unsigned ao2[2][2];
            if (Sched::GATHER) { ao2[0][0] = last ? aoN[0][0] : aoC[0][0]; ao2[0][1] = last ? aoN[0][1] : aoC[0][1]; ao2[1][0] = last ? aoN[1][0] : aoC[1][0]; ao2[1][1] = last ? aoN[1][1] : aoC[1][1]; }
            else { ao2[0][0] = aoC[0][0]; ao2[0][1] = aoC[0][1]; ao2[1][0] = aoC[1][0]; ao2[1][1] = aoC[1][1]; }
            G8_LDB(B0, 0, 0); G8_SCHED; G8_LDA(At, 0, 0); G8_STA(G8_SA(1, 1), cur, aoC, 1, k1);
            G8_WAIT_L(8); G8_BAR; G8_WAIT_L(0); G8_MMA(0, 0, At, B0); G8_BAR; G8_SCHED;
            G8_LDB(B1, 0, 1); G8_STB(G8_SB(0, 0), U2, 0, k2);
            G8_BAR; G8_WAIT_L(0); G8_MMA(0, 1, At, B1); G8_BAR;
            G8_LDA(At, 0, 1); G8_STA(G8_SA(0, 0), U2, ao2, 0, k2);
            G8_BAR; G8_WAIT_L(0); G8_MMA(1, 0, At, B0); G8_BAR; G8_SCHED;
            G8_STB(G8_SB(0, 1), U2, 1, k2);
            G8_WAIT_V(6); G8_BAR; G8_MMA(1, 1, At, B1); G8_BAR;
            G8_LDB(B0, 1, 0); G8_SCHED; G8_LDA(At, 1, 0); G8_STA(G8_SA(0, 1), U2, ao2, 1, k2);
            G8_WAIT_L(8); G8_BAR; G8_WAIT_L(0); G8_MMA(0, 0, At, B0); G8_BAR; G8_SCHED;
            G8_LDB(B1, 1, 1); G8_STB(G8_SB(1, 0), U2, 0, k3);
            G8_BAR; G8_WAIT_L(0); G8_MMA(0, 1, At, B1); G8_BAR;
            G8_LDA(At, 1, 1); G8_STA(G8_SA(1, 0), U2, ao2, 0, k3);
            G8_BAR; G8_WAIT_L(0); G8_MMA(1, 0, At, B0); G8_BAR; G8_SCHED;
            G8_STB(G8_SB(1, 1), U2, 1, k3);
            G8_WAIT_V(6); G8_BAR; G8_MMA(1, 1, At, B1); G8_BAR;
        }
        if constexpr (Epi::FP8) {
#define G8_F8(a, b) "+v"(acc[a][b][0][0]), "+v"(acc[a][b][0][1]), "+v"(acc[a][b][1][0]), "+v"(acc[a][b][1][1]), "+v"(acc[a][b][2][0]), "+v"(acc[a][b][2][1]), "+v"(acc[a][b][3][0]), "+v"(acc[a][b][3][1])
            asm volatile("s_nop 15\n\ts_nop 15" : G8_F8(0, 0), G8_F8(0, 1)); asm volatile("" : G8_F8(1, 0), G8_F8(1, 1));
#undef G8_F8
            __builtin_amdgcn_sched_barrier(0); }
        E(acc, cur, wr, wc, fr, fq);
        if (!has_next) break;
#pragma unroll
        for (int a = 0; a < 2; ++a)
#pragma unroll
            for (int b = 0; b < 2; ++b)
#pragma unroll
                for (int m = 0; m < 4; ++m)
#pragma unroll
                    for (int n = 0; n < 2; ++n) acc[a][b][m][n] = (f32x4){0.f, 0.f, 0.f, 0.f};
        cur = nxt; ++ui;
        if (Sched::GATHER) { aoC[0][0] = aoN[0][0]; aoC[0][1] = aoN[0][1]; aoC[1][0] = aoN[1][0]; aoC[1][1] = aoN[1][1]; }
    }
    G8_WAIT_V(0);
    if (wr == 0) G8_BAR;
    G8_BAR;
#undef G8_SA
#undef G8_SB
#undef G8_STA
#undef G8_STB
#undef G8_LDA
#undef G8_LDB
#undef G8_MMA
#undef G8_LO
#undef G8_HI
#undef G8_LD8
#undef G8_WAIT_V
#undef G8_WAIT_L
#undef G8_BAR
#undef G8_SCHED
}
struct DenseSched { static constexpr bool GATHER = false; const bf16_t* A; const bf16_t* Bt; int lda, ldb, nN, total, G, c, skipctx;
    DI void lane_offsets(unsigned (&ao)[2][2], int R0, int C0, int R1, int C1) const {
        ao[0][0] = (unsigned)(R0 * lda + C0) * 2u; ao[0][1] = (unsigned)(R1 * lda + C1) * 2u; ao[1][0] = (unsigned)((R0 + 128) * lda + C0) * 2u; ao[1][1] = (unsigned)((R1 + 128) * lda + C1) * 2u; }
    DI bool next(int i, Unit& u, unsigned (&ao)[2][2], int R0, int C0, int R1, int C1) const {
        const int L = i * G + c; if (L >= total) return false;
        int wgid = L; { const int q = total / 8, r = total % 8, xcd = wgid % 8, off = wgid / 8; wgid = (xcd < r ? xcd * (q + 1) : r * (q + 1) + (xcd - r) * q) + off; }
        const int nM = total / nN, nig = 8 * nN, gid = wgid / nig, fm = gid * 8, gsz = (nM - fm) < 8 ? (nM - fm) : 8;
        int pm = fm + ((wgid % nig) % gsz); const int pn = (wgid % nig) / gsz;
        if (skipctx) pm += 1 + (pm >= 32 ? 1 : 0);
        u.Ab = (const char*)(A + (size_t)pm * 256 * lda); u.Bb = (const char*)(Bt + (size_t)pn * 256 * ldb);
        u.p0 = pm; u.p1 = pn; u.p2 = 0; return true; } };
}

struct EpiInproj8 { static constexpr int WSC = 121; static constexpr bool PERM = true, ADJ16 = false, FP8 = true; bf16_t* proj; float* dtb; float* rowss; float inv; unsigned char* q8; float* vst;
    DI void operator()(const f32x4 (&acc)[2][2][4][2], const g8::Unit& u, int wr, int wc, int fr, int fq) const {
        const int pn = __builtin_amdgcn_readfirstlane(u.p1), row0 = u.p0 * 256 + wr * 64 + fr, colb = pn * 256 + wc * 32 + 8 * fq;
        const bool isq = (pn >= 4 && pn <= 6), iskv = (pn == 13), isv = (pn == 2 || pn == 3), isg = pn < 4, isdt = pn == 14;
#pragma unroll
        for (int ai = 0; ai < 2; ++ai)
#pragma unroll
            for (int m = 0; m < 4; ++m) { const int row = row0 + ai * 128 + m * 16; float ss = 0.f, sv = 0.f;
#pragma unroll
                for (int bj = 0; bj < 2; ++bj) { const int col = colb + bj * 128; f32x4 v0 = acc[ai][bj][m][0], v1 = acc[ai][bj][m][1];
                    if (isg) {
#pragma unroll
                        for (int j = 0; j < 4; ++j) { v0[j] = gelu_f(v0[j]); v1[j] = gelu_f(v1[j]); } }
                    u32x4 w; w.x = cvtpk(v0[0], v0[1]); w.y = cvtpk(v0[2], v0[3]); w.z = cvtpk(v1[0], v1[1]); w.w = cvtpk(v1[2], v1[3]);
                    *(u32x4*)(proj + (size_t)row * NP + col) = w;
                    if (isq) { u32x2 w8; w8.x = pk_fp8(v0); w8.y = pk_fp8(v1); *(u32x2*)(q8 + (size_t)row * 768 + (col - PC_Q)) = w8; }
                    if (isdt && col >= PC_DT && col < PC_DT + 16) { *(f32x4*)(dtb + (size_t)row * 16 + (col - PC_DT)) = v0; *(f32x4*)(dtb + (size_t)row * 16 + (col - PC_DT) + 4) = v1; }
                    ss += (v0[0] * v0[0] + v0[1] * v0[1]) + (v0[2] * v0[2] + v0[3] * v0[3]) + (v1[0] * v1[0] + v1[1] * v1[1]) + (v1[2] * v1[2] + v1[3] * v1[3]);
                    sv += ((v0[0] + v0[1]) + (v0[2] + v0[3])) + ((v1[0] + v1[1]) + (v1[2] + v1[3])); }
                if (isq || iskv) { ss += __shfl_xor(ss, 16); ss += __shfl_xor(ss, 32); if (fq == 0) rowss[(size_t)row * 16 + (iskv ? 12 : (pn - 4) * 4) + wc] = ss; }
                if (isv) { ss += __shfl_xor(ss, 16); ss += __shfl_xor(ss, 32); sv += __shfl_xor(sv, 16); sv += __shfl_xor(sv, 32); if (fq == 0) { vst[(size_t)row * 16 + (pn - 2) * 4 + wc] = sv; vst[(size_t)row * 16 + 8 + (pn - 2) * 4 + wc] = ss; } }
                __builtin_amdgcn_sched_barrier(0); }
    } };


struct EpiRowScale8 { static constexpr int WSC = 121; static constexpr bool PERM = true, ADJ16 = false, FP8 = true; bf16_t* out; int ldo; const float* rss; float invK; int s0, ns;
    DI void operator()(const f32x4 (&acc)[2][2][4][2], const g8::Unit& u, int wr, int wc, int fr, int fq) const {
        const int row0 = u.p0 * 256 + wr * 64 + fr, colb = u.p1 * 256 + wc * 32 + 8 * fq;
#pragma unroll
        for (int ai = 0; ai < 2; ++ai)
#pragma unroll
            for (int m = 0; m < 4; ++m) { const int row = row0 + ai * 128 + m * 16; float ssum = 0.f;
                { const f32x4* rp = (const f32x4*)(rss + (size_t)row * 16 + s0); for (int t = 0; t < ns; t += 4) { const f32x4 pv = rp[t >> 2]; ssum += (pv[0] + pv[1]) + (pv[2] + pv[3]); } }
                const float sc = rsqrtf(ssum * invK + 1e-6f);
#pragma unroll
                for (int bj = 0; bj < 2; ++bj) { const f32x4 v0 = acc[ai][bj][m][0] * sc, v1 = acc[ai][bj][m][1] * sc;
                    u32x4 w; w.x = cvtpk(v0[0], v0[1]); w.y = cvtpk(v0[2], v0[3]); w.z = cvtpk(v1[0], v1[1]); w.w = cvtpk(v1[2], v1[3]);
                    *(u32x4*)(out + (size_t)row * ldo + colb + bj * 128) = w; } }
    } };
struct EpiKn8 { static constexpr int WSC = 127; static constexpr bool PERM = true, ADJ16 = false, FP8 = false; unsigned char* out; const float* rss;
    DI void operator()(const f32x4 (&acc)[2][2][4][2], const g8::Unit& u, int wr, int wc, int fr, int fq) const {
        const int row0 = u.p0 * 256 + wr * 64 + fr, colb = u.p1 * 256 + wc * 32 + 8 * fq;
#pragma unroll
        for (int ai = 0; ai < 2; ++ai)
#pragma unroll
            for (int m = 0; m < 4; ++m) { const int row = row0 + ai * 128 + m * 16;
                const f32x4 pv = *(const f32x4*)(rss + (size_t)row * 16 + 12); const float sc = rsqrtf(((pv[0] + pv[1]) + (pv[2] + pv[3])) * (1.f / 256.f) + 1e-6f);
#pragma unroll
                for (int bj = 0; bj < 2; ++bj) { u32x2 w; w.x = pk_fp8(acc[ai][bj][m][0] * sc); w.y = pk_fp8(acc[ai][bj][m][1] * sc);
                    *(u32x2*)(out + (size_t)row * 1024 + colb + bj * 128) = w; } }
    } };
struct EpiVt8 { static constexpr int WSC = 127; static constexpr bool PERM = true, ADJ16 = false, FP8 = false; unsigned char* vt; const float* rss;
    DI void operator()(const f32x4 (&acc)[2][2][4][2], const g8::Unit& u, int wr, int wc, int fr, int fq) const {
        const int f0 = u.p0 * 256 + wr * 64 + fr, tokb = u.p1 * 256 + wc * 32 + 8 * fq;
#pragma unroll
        for (int bj = 0; bj < 2; ++bj) { const int tok0 = tokb + bj * 128; f32x4 s0, s1;
#pragma unroll
            for (int t = 0; t < 8; ++t) { const f32x4 pv = *(const f32x4*)(rss + (size_t)(tok0 + t) * 16 + 12); const float sc = rsqrtf(((pv[0] + pv[1]) + (pv[2] + pv[3])) * (1.f / 256.f) + 1e-6f);
                if (t < 4) s0[t] = sc; else s1[t - 4] = sc; }
            const int kap = tok0 & 63; unsigned char* tb = vt + (size_t)(tok0 >> 6) * 65536 + (kap >> 5) * 16 + ((kap & 31) >> 3) * 4;
#pragma unroll
            for (int ai = 0; ai < 2; ++ai)
#pragma unroll
                for (int m = 0; m < 4; ++m) { const int f = f0 + ai * 128 + m * 16; unsigned char* p = tb + (size_t)f * 64;
                    *(unsigned*)p = pk_fp8(acc[ai][bj][m][0] * s0); *(unsigned*)(p + 32) = pk_fp8(acc[ai][bj][m][1] * s1); } }
    } };
struct EpiOut8 { static constexpr int WSC = 117; static constexpr bool PERM = true, ADJ16 = false, FP8 = true; bf16_t* M; float inv;
    DI void operator()(const f32x4 (&acc)[2][2][4][2], const g8::Unit& u, int wr, int wc, int fr, int fq) const {
        const int row0 = u.p0 * 256 + wr * 64 + fr, colb = u.p1 * 256 + wc * 32 + 8 * fq;
#pragma unroll
        for (int ai = 0; ai < 2; ++ai)
#pragma unroll
            for (int m = 0; m < 4; ++m) { const size_t ro = (size_t)(row0 + ai * 128 + m * 16) * DM;
#pragma unroll
                for (int bj = 0; bj < 2; ++bj) { const f32x4 v0 = acc[ai][bj][m][0], v1 = acc[ai][bj][m][1];
                    u32x4 w; w.x = cvtpk(v0[0], v0[1]); w.y = cvtpk(v0[2], v0[3]); w.z = cvtpk(v1[0], v1[1]); w.w = cvtpk(v1[2], v1[3]);
                    *(u32x4*)(M + ro + colb + bj * 128) = w; } }
    } };
DI int moe_unit(int i, int G, int c, int total) {
    if (G & 7) { const int L = i * G + c; return L < total ? L : -1; }
    const int x = c & 7, slot = c >> 3, ns = G >> 3, q = total >> 3, r = total & 7;
    const int start = x * q + (x < r ? x : r), len = q + (x < r ? 1 : 0), k = i * ns + slot;
    return k < len ? start + k : -1;
}
struct MoeDownSched { static constexpr bool GATHER = false; const bf16_t* H; const bf16_t* W; const int* mtoff; int total, G, c;
    DI void lane_offsets(unsigned (&ao)[2][2], int R0, int C0, int R1, int C1) const {
        ao[0][0] = (unsigned)(R0 * 256 + C0) * 2u; ao[0][1] = (unsigned)(R1 * 256 + C1) * 2u; ao[1][0] = (unsigned)((R0 + 128) * 256 + C0) * 2u; ao[1][1] = (unsigned)((R1 + 128) * 256 + C1) * 2u; }
    DI bool next(int i, g8::Unit& u, unsigned (&ao)[2][2], int R0, int C0, int R1, int C1) const {
        const int L = moe_unit(i, G, c, total); if (L < 0) return false;
        const int pn = L & 7, mtg = L >> 3; const int e = ((const unsigned char*)(mtoff + 144))[mtg];
        u.Ab = (const char*)(H + (size_t)mtg * 256 * 256); u.Bb = (const char*)(W + ((size_t)e * 2048 + pn * 256) * 256);
        u.p0 = mtg; u.p1 = pn; u.p2 = e; return true; } };
struct EpiDown8 { static constexpr int WSC = 121; static constexpr bool PERM = true, ADJ16 = true, FP8 = true; unsigned char* O; float inv;
    DI void operator()(const f32x4 (&acc)[2][2][4][2], const g8::Unit& u, int wr, int wc, int fr, int fq) const {
        const int row0 = u.p0 * 256 + wr * 64 + fr, colb = u.p1 * 256 + wc * 64 + 16 * fq;
#pragma unroll
        for (int ai = 0; ai < 2; ++ai)
#pragma unroll
            for (int m = 0; m < 4; ++m) { u32x4 w; w.x = pk_fp8(acc[ai][0][m][0]); w.y = pk_fp8(acc[ai][0][m][1]); w.z = pk_fp8(acc[ai][1][m][0]); w.w = pk_fp8(acc[ai][1][m][1]);
                *(u32x4*)(O + (size_t)(row0 + ai * 128 + m * 16) * DM + colb) = w; }
    } };
struct ListEnt { int row; float w; };
struct MoeGUSched { static constexpr bool GATHER = true; const bf16_t* tok; const bf16_t* W; const int* mtoff; const int* gcnt; const ListEnt* list; int total, G, c, l;
    DI void lane_offsets(unsigned (&ao)[2][2], int, int, int, int) const {}
    DI bool next(int i, g8::Unit& u, unsigned (&ao)[2][2], int R0, int C0, int R1, int C1) const {
        const int L = moe_unit(i, G, c, total); if (L < 0) return false;
        const int pn = L & 3, mtg = L >> 2; const int e = ((const unsigned char*)(mtoff + 144))[mtg];
        const int mt = mtg - mtoff[e], cnt = mtoff[72 + e];
        const int Rr[2] = {R0, R1}, Cc[2] = {C0, C1};
#pragma unroll
        for (int h = 0; h < 2; ++h)
#pragma unroll
            for (int q = 0; q < 2; ++q) { const int pos = mt * 256 + h * 128 + Rr[q]; const int pc = pos < cnt ? pos : 0;
                int row = list[(size_t)(e < 64 ? e : 0) * MR + pc].row;
                const int srow = l == 0 ? pc : (pc < SEQ ? CTXL + pc : RPB + CTXL + (pc - SEQ));
                row = e < 64 ? row : srow; row = pos < cnt ? row : 0;
                row = (row < 0 || row >= MR) ? 0 : row;
                ao[h][q] = (unsigned)(row * 1024 + Cc[q]) * 2u; }
        u.Ab = (const char*)tok; u.Bb = (const char*)(W + ((size_t)e * 1024 + pn * 256) * 1024);
        u.p0 = mtg; u.p1 = pn; u.p2 = e; return true; } };
struct EpiGU8 { static constexpr int WSC = 121; static constexpr bool PERM = true, ADJ16 = false, FP8 = true; unsigned char* H; float inv;
    DI void operator()(const f32x4 (&acc)[2][2][4][2], const g8::Unit& u, int wr, int wc, int fr, int fq) const {
        const int row0 = u.p0 * 256 + wr * 64 + fr, colb = u.p1 * 128 + wc * 32 + 8 * fq;
#pragma unroll
        for (int ai = 0; ai < 2; ++ai)
#pragma unroll
            for (int m = 0; m < 4; ++m) { float o[8];
#pragma unroll
                for (int n = 0; n < 2; ++n)
#pragma unroll
                    for (int j = 0; j < 4; ++j) o[n * 4 + j] = silu_f(acc[ai][0][m][n][j]) * acc[ai][1][m][n][j];
                u32x2 w; w.x = pk_fp8((f32x4){o[0], o[1], o[2], o[3]}); w.y = pk_fp8((f32x4){o[4], o[5], o[6], o[7]});
                *(u32x2*)(H + (size_t)(row0 + ai * 128 + m * 16) * 512 + colb) = w; }
    } };

DI void ph_mod(const Args& a, unsigned char* sm) {
    const int tid = tidx(), wave = tid >> 6, lane = tid & 63;
    float* sv = (float*)sm;
    float* red = (float*)(sm + 8192);
    float* modp = (float*)(a.ws + WS_MODP);
    for (int u = blockIdx.x; u < 2 * 48 * 4; u += gridDim.x) {
        const int kb = u & 3, cb = (u >> 2) % 48, l = u / 192;
        __syncthreads();
        for (int i = tid; i < 3 * 512; i += 512) { const int rr = i >> 9, k = i & 511; const float c = (rr < 2) ? a.c[rr * DM + kb * 512 + k] : a.c_ctx[kb * 512 + k]; sv[i] = silu_f(c); }
        __syncthreads();
        const float* W = a.w_mod + ((size_t)l * DM + kb * 512 + wave * 64) * 12288 + cb * 256 + lane * 4;
        float acc[3][4];
#pragma unroll
        for (int i = 0; i < 3; ++i)
#pragma unroll
            for (int j = 0; j < 4; ++j) acc[i][j] = 0.f;
#pragma unroll 8
        for (int k = 0; k < 64; ++k) {
            const f32x4 w = __builtin_nontemporal_load((const f32x4*)(W + (size_t)k * 12288));
#pragma unroll
            for (int rr = 0; rr < 3; ++rr) { const float s = sv[rr * 512 + wave * 64 + k];
#pragma unroll
                for (int j = 0; j < 4; ++j) acc[rr][j] += s * w[j]; }
        }
#pragma unroll
        for (int rr = 0; rr < 3; ++rr)
#pragma unroll
            for (int j = 0; j < 4; ++j) red[(wave * 3 + rr) * 256 + lane * 4 + j] = acc[rr][j];
        __syncthreads();
        for (int i = tid; i < 768; i += 512) {
            const int rr = i >> 8, c = i & 255; float s = 0.f;
#pragma unroll
            for (int w = 0; w < 8; ++w) s += red[(w * 3 + rr) * 256 + c];
            if (kb == 0) s += a.b_mod[(size_t)l * 12288 + cb * 256 + c];
            modp[(((size_t)kb * 2 + l) * 3 + rr) * 12288 + cb * 256 + c] = s;
        }
    }
}

template <class Map>
DI void convT(unsigned char* sm, bf16_t* dst, int N, int K, const Map map, const float* ksc) {
    const int tid = tidx(); const int nkt = K >> 7; const int ntiles = (N >> 6) * nkt;
    unsigned* T = (unsigned*)sm;
    const size_t ld = (size_t)Map::LD;
    const int n4 = (tid & 15) * 4, kr = tid >> 4;
    f32x4 v[4]; bool ok = true;
    auto load_tile = [&](int t) {
        const int n0 = (t / nkt) << 6, k0 = (t % nkt) << 7;
        const float* src = map(n0 + n4); ok = src != nullptr; if (!ok) src = map(0);
        const float* p = src + (size_t)(k0 + kr) * ld;
#pragma unroll
        for (int i = 0; i < 4; ++i) v[i] = __builtin_nontemporal_load((const f32x4*)(p + (size_t)(32 * i) * ld));
        if (!ok) {
#pragma unroll
            for (int i = 0; i < 4; ++i) v[i] = (f32x4){0.f, 0.f, 0.f, 0.f}; }
        if (ksc) {
#pragma unroll
            for (int i = 0; i < 4; ++i) v[i] *= ksc[k0 + kr + 32 * i]; }
    };
    int t = blockIdx.x;
    if (t < ntiles) load_tile(t);
    for (; t < ntiles; t += gridDim.x) {
        const int n0 = (t / nkt) << 6, k0 = (t % nkt) << 7;
        __syncthreads();
#pragma unroll
        for (int i = 0; i < 4; ++i) { const int k = kr + 32 * i; u32x2 w; w.x = cvtpk(v[i][0], v[i][1]); w.y = cvtpk(v[i][2], v[i][3]);
            *(u32x2*)(T + k * 32 + ((n4 >> 1) ^ (4 * ((k >> 3) & 7)))) = w; }
        if (t + (int)gridDim.x < ntiles) load_tile(t + gridDim.x);
        __syncthreads();
#pragma unroll
        for (int i = 0; i < 2; ++i) { const int idx = tid + i * 512, nr = idx >> 4, kc = idx & 15;
            const unsigned short* Th = (const unsigned short*)T + (size_t)(kc * 8) * 64 + ((((nr >> 1) ^ (4 * (kc & 7))) << 1) | (nr & 1));
            u32x4 w; w.x = (unsigned)Th[0] | ((unsigned)Th[64] << 16); w.y = (unsigned)Th[128] | ((unsigned)Th[192] << 16); w.z = (unsigned)Th[256] | ((unsigned)Th[320] << 16); w.w = (unsigned)Th[384] | ((unsigned)Th[448] << 16);
            *(u32x4*)(dst + (size_t)(n0 + nr) * K + k0 + kc * 8) = w; }
    }
}
template <class Map, bool NULLOK = false>
DI void convT8(unsigned char* sm, unsigned char* dst, int N, int K, const Map map, float scale, const float* ksc = nullptr) {
    const int tid = tidx(); const int nkt = K >> 7; const int ntiles = (N >> 6) * nkt; const int G = (int)gridDim.x;
    unsigned* T = (unsigned*)sm;
    const size_t ld = (size_t)Map::LD;
    const int n4 = (tid & 15) * 4, kr = tid >> 4;
    f32x4 va[4], vb[4]; float sa = scale, sb = scale;
    auto load_tile = [&](int t, f32x4 (&v)[4], float& sc) {
        const int n0 = (t / nkt) << 6, k0 = (t % nkt) << 7;
        const float* src = map(n0 + n4); sc = scale;
        if (NULLOK) { if (src == nullptr) { src = map(0); sc = 0.f; } }
        const float* p = src + (size_t)(k0 + kr) * ld;
#pragma unroll
        for (int i = 0; i < 4; ++i) v[i] = __builtin_nontemporal_load((const f32x4*)(p + (size_t)(32 * i) * ld));
    };
    auto put_tile = [&](unsigned* Tt, const f32x4 (&v)[4], float sc, int t) {
        const int k0 = (t % nkt) << 7;
#pragma unroll
        for (int i = 0; i < 4; ++i) { const int k = kr + 32 * i; const float si = ksc ? sc * ksc[k0 + k] : sc; Tt[k * 16 + ((n4 >> 2) ^ ((k >> 4) & 7))] = pk_fp8(v[i] * si); }
    };
    auto get_tile = [&](const unsigned* Tt, int t) {
        const int n0 = (t / nkt) << 6, k0 = (t % nkt) << 7;
        const int nr = tid >> 3, kc = tid & 7; const unsigned char* Tb = (const unsigned char*)Tt + (size_t)(kc * 16) * 64 + ((((nr >> 2) ^ kc) << 2) | (nr & 3));
        unsigned w[4];
#pragma unroll
        for (int q = 0; q < 4; ++q) w[q] = (unsigned)Tb[(4 * q) * 64] | ((unsigned)Tb[(4 * q + 1) * 64] << 8) | ((unsigned)Tb[(4 * q + 2) * 64] << 16) | ((unsigned)Tb[(4 * q + 3) * 64] << 24);
        *(u32x4*)(dst + (size_t)(n0 + nr) * K + k0 + kc * 16) = (u32x4){w[0], w[1], w[2], w[3]};
    };
    int t = blockIdx.x;
    if (t < ntiles) load_tile(t, va, sa);
    if (t + G < ntiles) load_tile(t + G, vb, sb);
    for (; t < ntiles; t += 2 * G) {
        const bool hasb = t + G < ntiles;
        __syncthreads();
        put_tile(T, va, sa, t); if (hasb) put_tile(T + 2048, vb, sb, t + G);
        if (t + 2 * G < ntiles) load_tile(t + 2 * G, va, sa);
        if (t + 3 * G < ntiles) load_tile(t + 3 * G, vb, sb);
        __syncthreads();
        get_tile(T, t); if (hasb) get_tile(T + 2048, t + G);
    }
}
template <int LDV> struct MapPlain { static constexpr int LD = LDV; const float* base; DI const float* operator()(int n) const { return base + n; } };
struct MapIn { static constexpr int LD = IN_W; const float* base; DI const float* operator()(int n) const { int oc = n; if (n >= 3328 && n < 3648) oc = n + 16; else if (n >= 3648 && n < 3664) oc = n - 320; return n < 3664 ? base + oc : nullptr; } };
struct MapKVB { static constexpr int LD = 2048; const float* base;
    DI const float* operator()(int n) const { const int m = n & 1023; return base + ((m >> 7) * 256 + (n >> 10) * 128 + (m & 127)); } };
struct MapGU { static constexpr int LD = 512; const float *eg, *eu, *sg, *su;
    DI const float* operator()(int n) const { const int e = n >> 10, np = n & 1023, pn = np >> 8, isup = (np >> 7) & 1, j = pn * 128 + (np & 127);
        const float* be = isup ? eu : eg; const float* bs = isup ? su : sg;
        return e < 64 ? be + (size_t)e * 2048 * 512 + j : bs + j; } };
struct MapDN { static constexpr int LD = 2048; const float *ed, *sd;
    DI const float* operator()(int n) const { const int e = n >> 11, c = n & 2047; return (e < 64 ? ed + (size_t)e * 512 * 2048 : sd) + c; } };
DI void conv_router(const Args& a, int l) {
    bf16_t* hi = (bf16_t*)(a.ws + WS_WRH + (size_t)l * WSTRIDE); bf16_t* lo = (bf16_t*)(a.ws + WS_WRL + (size_t)l * WSTRIDE);
    const float* w = a.w_router + (size_t)l * 2048 * 64;
    for (int i = blockIdx.x * 512 + tidx(); i < 2048 * 64; i += gridDim.x * 512) {
        const int k = i >> 6, n = i & 63; const float v = w[i]; const bf16_t hb = f2bf(v); const float rem = v - bf2f(hb);
        hi[n * 2048 + k] = hb; lo[n * 2048 + k] = f2bf(rem);
    }
}
DI void ph_convert_dense(const Args& a, int l, unsigned char* sm) {
    convT8<MapIn, true>(sm, (unsigned char*)(a.ws + WS_WIN + (size_t)l * WSTRIDE), NP, 2048, MapIn{a.w_in + (size_t)l * 2048 * IN_W}, 64.f);
    convT8(sm, (unsigned char*)(a.ws + WS_WQB + (size_t)l * WSTRIDE), 1536, 768, MapPlain<1536>{a.w_q_b + (size_t)l * 768 * 1536}, 64.f, a.g_q + l * 768);
    convT(sm, (bf16_t*)(a.ws + WS_WKVB + (size_t)l * WSTRIDE), 2048, 256, MapKVB{a.w_kv_b + (size_t)l * 256 * 2048}, a.g_kv + l * 256);
    convT8(sm, (unsigned char*)(a.ws + WS_WOUT + (size_t)l * WSTRIDE), 2048, 2048, MapPlain<2048>{a.w_out + (size_t)l * 2048 * 2048}, 64.f);
    conv_router(a, l);
}
DI void ph_convert_experts(const Args& a, int l, unsigned char* sm) {
    convT8(sm, (unsigned char*)(a.ws + WS_WGU + (size_t)l * WSTRIDE), NE1 * 1024, 2048, MapGU{a.w_e_gate + (size_t)l * 64 * 2048 * 512, a.w_e_up + (size_t)l * 64 * 2048 * 512, a.w_sh_gate + (size_t)l * 2048 * 512, a.w_sh_up + (size_t)l * 2048 * 512}, 64.f);
    convT8(sm, (unsigned char*)(a.ws + WS_WDN + (size_t)l * WSTRIDE), NE1 * 2048, 512, MapDN{a.w_e_down + (size_t)l * 64 * 512 * 2048, a.w_sh_down + (size_t)l * 512 * 2048}, 64.f);
}
DI void ph_convert(const Args& a, int l, unsigned char* sm) { ph_convert_dense(a, l, sm); ph_convert_experts(a, l, sm); }

DI void ph_modulate0(const Args& a) {
    const float* modp = (const float*)(a.ws + WS_MODP);
    { float* modw = (float*)(a.ws + WS_MOD);
      for (int i = blockIdx.x * 512 + tidx(); i < 2 * 3 * 12288; i += gridDim.x * 512) modw[i] = ((modp[i] + modp[73728 + i]) + modp[2 * 73728 + i]) + modp[3 * 73728 + i]; }
    unsigned char* hb8 = (unsigned char*)(a.ws + WS_HB);
    for (size_t i = (size_t)blockIdx.x * 512 + tidx(); i < (size_t)MR * 256; i += (size_t)gridDim.x * 512) {
        const int g = (int)(i >> 8), c8 = (int)(i & 255) * 8, b = g / RPB, rr = g % RPB;
        const float* src = rr < CTXL ? a.ctx + ((size_t)(b * CTXL + rr)) * DM : a.x + ((size_t)(b * SEQ + rr - CTXL)) * DM;
        const float* m = modp + (size_t)(rr < CTXL ? 2 : b) * 12288;
        const f32x4 v0 = __builtin_nontemporal_load((const f32x4*)(src + c8)), v1 = __builtin_nontemporal_load((const f32x4*)(src + c8 + 4));
#define MSUM(off) (((*(const f32x4*)(m + (off)) + *(const f32x4*)(m + 73728 + (off))) + *(const f32x4*)(m + 2 * 73728 + (off))) + *(const f32x4*)(m + 3 * 73728 + (off)))
        const f32x4 sh0 = MSUM(c8), sh1 = MSUM(c8 + 4), sc0 = MSUM(DM + c8), sc1 = MSUM(DM + c8 + 4);
#undef MSUM
        const f32x4 h0 = v0 * (1.f + sc0) + sh0, h1 = v1 * (1.f + sc1) + sh1;
        u32x2 w; w.x = pk_fp8(h0); w.y = pk_fp8(h1);
        *(u32x2*)(hb8 + (size_t)g * DM + c8) = w;
    }
}

struct ARowLin { const bf16_t* base; size_t ld; DI const bf16_t* operator()(int i) const { return base + (size_t)i * ld; } };
struct EpiInproj { bf16_t* proj; float* dtb; int row0, col0;
    DI void operator()(f32x16 (&acc)[2][2], int wm, int wn, int r, int h) const {
#pragma unroll
        for (int mi = 0; mi < 2; ++mi)
#pragma unroll
            for (int ni = 0; ni < 2; ++ni)
#pragma unroll
                for (int q = 0; q < 4; ++q) {
                    const int row = row0 + wm * 64 + mi * 32 + r, col = col0 + wn * 64 + ni * 32 + 8 * q + 4 * h;
                    float v0 = acc[mi][ni][4 * q], v1 = acc[mi][ni][4 * q + 1], v2 = acc[mi][ni][4 * q + 2], v3 = acc[mi][ni][4 * q + 3];
                    if (col < 1024) { v0 = gelu_f(v0); v1 = gelu_f(v1); v2 = gelu_f(v2); v3 = gelu_f(v3); }
                    u32x2 w; w.x = cvtpk(v0, v1); w.y = cvtpk(v2, v3);
                    *(u32x2*)(proj + (size_t)row * NP + col) = w;
                    if (col >= PC_DT && col < PC_DT + 16) *(f32x4*)(dtb + (size_t)row * 16 + (col - PC_DT)) = (f32x4){v0, v1, v2, v3};
                }
    } };
DI void ph_inproj(const Args& a, int l, unsigned char* sm) {
    g8::DenseSched S{(const bf16_t*)(a.ws + WS_HB), (const bf16_t*)(a.ws + WS_WIN + (size_t)l * WSTRIDE), 1024, 1024, NP / 256, (MR / 256) * (NP / 256), (int)gridDim.x, (int)blockIdx.x, 0};
    EpiInproj8 E{(bf16_t*)(a.ws + WS_PROJ), (float*)(a.ws + WS_DT), (float*)(a.ws + WS_RSS), 1.f / 64.f, (unsigned char*)(a.ws + WS_KV) + (size_t)MR * 2048, (float*)(a.ws + WS_KV + (size_t)MR * 2816)};
    __syncthreads();
    g8::gemm(sm, 1024, 1024, S, E);
}

DI void conv8(const bf16_t* proj, int g, int seg_lo, int seg_hi, int c0, const float* cw, const float* cb, float (&o)[8]) {
    const f32x4 b0 = *(const f32x4*)(cb + c0), b1 = *(const f32x4*)(cb + c0 + 4);
    float acc[8] = {b0[0], b0[1], b0[2], b0[3], b1[0], b1[1], b1[2], b1[3]};
    u32x4 raw[5]; f32x4 w0[5], w1[5];
#pragma unroll
    for (int j = 0; j < 5; ++j) {
        const int gg = g + j - 2; const bool in = gg >= seg_lo && gg < seg_hi; const int gc = in ? gg : g; const float mk = in ? 1.f : 0.f;
        raw[j] = *(const u32x4*)(proj + (size_t)gc * NP + PC_XBC + c0);
        w0[j] = *(const f32x4*)(cw + j * 1024 + c0) * mk; w1[j] = *(const f32x4*)(cw + j * 1024 + c0 + 4) * mk;
    }
#pragma unroll
    for (int j = 0; j < 5; ++j) {
        acc[0] += w0[j][0] * bf_lo(raw[j].x); acc[1] += w0[j][1] * bf_hi(raw[j].x); acc[2] += w0[j][2] * bf_lo(raw[j].y); acc[3] += w0[j][3] * bf_hi(raw[j].y);
        acc[4] += w1[j][0] * bf_lo(raw[j].z); acc[5] += w1[j][1] * bf_hi(raw[j].z); acc[6] += w1[j][2] * bf_lo(raw[j].w); acc[7] += w1[j][3] * bf_hi(raw[j].w);
    }
#pragma unroll
    for (int i = 0; i < 8; ++i) o[i] = silu_f(acc[i]);
}
DI void chunk_seg(int ck, int& g0, int& seg_lo, int& seg_hi) {
    const int b = ck / 66, cc = ck % 66; g0 = ck * 128;
    if (cc < 2) { seg_lo = b * RPB; seg_hi = seg_lo + CTXL; } else { seg_lo = b * RPB + CTXL; seg_hi = (b + 1) * RPB; }
}
DI void dt_scan_wave(const float* dtbuf, int g0, int col, float bias, float aneg, int dir, float* dts, float* acs, int lane) {
    float x0 = dtbuf[(size_t)(g0 + lane) * 16 + col] + bias, x1 = dtbuf[(size_t)(g0 + lane + 64) * 16 + col] + bias;
    const float d0 = x0 > 20.f ? x0 : log1pf(__expf(x0)), d1 = x1 > 20.f ? x1 : log1pf(__expf(x1));
    dts[lane] = d0; dts[lane + 64] = d1;
    float v0 = d0 * aneg, v1 = d1 * aneg;
    if (dir == 0) {
#pragma unroll
        for (int o = 1; o < 64; o <<= 1) { const float t0 = __shfl_up(v0, o), t1 = __shfl_up(v1, o); if (lane >= o) { v0 += t0; v1 += t1; } }
        const float tot = __shfl(v0, 63); v1 += tot;
    } else {
#pragma unroll
        for (int o = 1; o < 64; o <<= 1) { const float t0 = __shfl_down(v0, o), t1 = __shfl_down(v1, o); if (lane + o < 64) { v0 += t0; v1 += t1; } }
        const float tot = __shfl(v1, 0); v0 += tot;
    }
    acs[lane] = v0; acs[lane + 64] = v1;
}

DI void gmlp_unit(const Args& a, int l, int ck, int hh, unsigned char* sm) {
    const int tid = tidx(), wave = tid >> 6, lane = tid & 63, r = lane & 31, h = lane >> 5, wm = wave >> 1, wn = wave & 1;
    const bf16_t* proj = (const bf16_t*)(a.ws + WS_PROJ); unsigned char* mix = (unsigned char*)(a.ws + WS_MIX);
    unsigned char* Asp = sm;
    unsigned char* VT = sm + 128 * 272;
    const int g0 = ck * 128;
    __syncthreads();
    { const float* gv = a.g_v + l * 512 + hh * 128; const float* bv = a.b_v + l * 512 + hh * 128; const float* vst = (const float*)(a.ws + WS_KV + (size_t)MR * 2816);
      const int sr_ = tid >> 2, dq = (tid & 3) * 32;
      const f32x4 s0 = *(const f32x4*)(vst + (size_t)(g0 + sr_) * 16), s1 = *(const f32x4*)(vst + (size_t)(g0 + sr_) * 16 + 4), q0 = *(const f32x4*)(vst + (size_t)(g0 + sr_) * 16 + 8), q1 = *(const f32x4*)(vst + (size_t)(g0 + sr_) * 16 + 12);
      const float mu = (((s0[0] + s0[1]) + (s0[2] + s0[3])) + ((s1[0] + s1[1]) + (s1[2] + s1[3]))) * (1.f / 512.f);
      const float var = (((q0[0] + q0[1]) + (q0[2] + q0[3])) + ((q1[0] + q1[1]) + (q1[2] + q1[3]))) * (1.f / 512.f) - mu * mu;
      const float rstd = rsqrtf(fmaxf(var, 0.f) + 1e-5f);
      const bf16_t* vrow = proj + (size_t)(g0 + sr_) * NP + PC_GM + 512 + hh * 128 + dq;
#pragma unroll
      for (int i = 0; i < 4; ++i) { const u32x4 raw = *(const u32x4*)(vrow + i * 8); const unsigned w4[4] = {raw.x, raw.y, raw.z, raw.w};
          const f32x4 ga = *(const f32x4*)(gv + dq + i * 8), gb = *(const f32x4*)(gv + dq + i * 8 + 4), ba = *(const f32x4*)(bv + dq + i * 8), bb = *(const f32x4*)(bv + dq + i * 8 + 4);
#pragma unroll
          for (int j = 0; j < 8; ++j) { const float vv = (j & 1) ? bf_hi(w4[j >> 1]) : bf_lo(w4[j >> 1]); const float gj = j < 4 ? ga[j] : gb[j - 4], bj = j < 4 ? ba[j] : bb[j - 4];
              *(bf16_t*)(VT + xswz_off(dq + i * 8 + j, sr_, 272)) = f2bf((vv - mu) * rstd * gj + bj); } } }
    const float* wsp = a.w_sp + ((size_t)l * 4 + hh) * 128 * 128;
#pragma unroll
    for (int i = 0; i < 8; ++i) { const int idx = tid + i * 512, t = idx >> 5, s4 = (idx & 31) * 4; const f32x4 w = *(const f32x4*)(wsp + t * 128 + s4);
        u32x2 p; p.x = cvtpk(w[0], w[1]); p.y = cvtpk(w[2], w[3]); *(u32x2*)(Asp + t * 272 + s4 * 2) = p; }
    __syncthreads();
    f32x16 acc[1][2];
#pragma unroll
    for (int j = 0; j < 2; ++j)
#pragma unroll
        for (int q = 0; q < 16; ++q) acc[0][j][q] = 0.f;
    mma_lds_x<1, 2, 8, true, false, true>(Asp + wm * 32 * 272, 272, 0, VT + wn * 64 * 272, 272, wn * 64, acc, r, h);
    const int t = wm * 32 + r; const float bsp = a.b_sp[((size_t)l * 4 + hh) * 128 + t];
#pragma unroll
    for (int ni = 0; ni < 2; ++ni)
#pragma unroll
        for (int q = 0; q < 4; ++q) {
            const int d = wn * 64 + ni * 32 + 8 * q + 4 * h;
            const u32x2 uu = *(const u32x2*)(proj + (size_t)(g0 + t) * NP + PC_GM + hh * 128 + d);
            const float o0 = bf_lo(uu.x) * (acc[0][ni][4 * q] + bsp), o1 = bf_hi(uu.x) * (acc[0][ni][4 * q + 1] + bsp), o2 = bf_lo(uu.y) * (acc[0][ni][4 * q + 2] + bsp), o3 = bf_hi(uu.y) * (acc[0][ni][4 * q + 3] + bsp);
            *(unsigned*)(mix + (size_t)(g0 + t) * DM + hh * 128 + d) = pk_mix(o0, o1, o2, o3);
        }
}
DI void ssd_state_unit(const Args& a, int l, int ck, int hh, unsigned char* sm) {
    const int tid = tidx(), wave = tid >> 6, lane = tid & 63, r = lane & 31, h = lane >> 5, wm = wave >> 1, wn = wave & 1;
    const bf16_t* proj = (const bf16_t*)(a.ws + WS_PROJ); const float* dtbuf = (const float*)(a.ws + WS_DT);
    unsigned char* XT2 = sm;
    unsigned char* BT = sm + 128 * 272;
    float* sc = (float*)(sm + 2 * 128 * 272);
    int g0, seg_lo, seg_hi; chunk_seg(ck, g0, seg_lo, seg_hi);
    __syncthreads();
    if (wave < 2) { const int dir = wave; dt_scan_wave(dtbuf, g0, dir * 8 + hh, a.dt_bias[(l * 2 + dir) * 8 + hh], -__expf(a.a_log[(l * 2 + dir) * 8 + hh]), dir, sc + dir * 128, sc + 256 + dir * 128, lane); }
    __syncthreads();
    const float* cw = a.conv_w + (size_t)l * 5 * 1024; const float* cb = a.conv_b + (size_t)l * 1024;
    const float af_last = sc[256 + 127], ab_first = sc[256 + 128 + 0];
#pragma unroll 1
    for (int i = 0; i < 2; ++i) {
        const int idx = tid + i * 512, lrow = idx >> 3, c0 = (idx & 7) * 8; float o[8];
        conv8(proj, g0 + lrow, seg_lo, seg_hi, hh * 64 + c0, cw, cb, o);
        const float wf = sc[lrow] * __expf(af_last - sc[256 + lrow]), wb = sc[128 + lrow] * __expf(ab_first - sc[256 + 128 + lrow]);
#pragma unroll
        for (int j = 0; j < 8; ++j) { *(bf16_t*)(XT2 + (c0 + j) * 272 + lrow * 2) = f2bf(o[j] * wf); *(bf16_t*)(XT2 + (64 + c0 + j) * 272 + lrow * 2) = f2bf(o[j] * wb); }
    }
#pragma unroll 1
    for (int i = 0; i < 4; ++i) {
        const int idx = tid + i * 512, lrow = idx >> 4, c0 = (idx & 15) * 8; float o[8];
        conv8(proj, g0 + lrow, seg_lo, seg_hi, 512 + (hh >> 2) * 128 + c0, cw, cb, o);
#pragma unroll
        for (int j = 0; j < 8; ++j) *(bf16_t*)(BT + (c0 + j) * 272 + lrow * 2) = f2bf(o[j]);
    }
    __syncthreads();
    f32x16 acc[1][2];
#pragma unroll
    for (int j = 0; j < 2; ++j)
#pragma unroll
        for (int q = 0; q < 16; ++q) acc[0][j][q] = 0.f;
    mma_lds<1, 2, 8, true>(XT2 + wm * 32 * 272, 272, BT + wn * 64 * 272, 272, acc, r, h);
    const int m = wm * 32 + r, dir = m >> 6, p = m & 63;
    float* st = (float*)(a.ws + WS_ST) + ((size_t)(ck * 8 + hh) * 2 + dir) * 8192 + p * 128;
#pragma unroll
    for (int ni = 0; ni < 2; ++ni)
#pragma unroll
        for (int q = 0; q < 4; ++q) { const int n = wn * 64 + ni * 32 + 8 * q + 4 * h;
            *(f32x4*)(st + n) = (f32x4){acc[0][ni][4 * q], acc[0][ni][4 * q + 1], acc[0][ni][4 * q + 2], acc[0][ni][4 * q + 3]}; }
    if (tid < 2) ((float*)(a.ws + WS_DEC))[(ck * 8 + hh) * 2 + tid] = __expf(tid == 0 ? af_last : ab_first);
}
struct EpiRowScale { bf16_t* out; size_t ldo; int row0, col0; const float* rs;
    DI void operator()(f32x16 (&acc)[2][2], int wm, int wn, int r, int h) const {
#pragma unroll
        for (int mi = 0; mi < 2; ++mi) { const int rl = wm * 64 + mi * 32 + r; const float s = rs[rl];
#pragma unroll
            for (int ni = 0; ni < 2; ++ni)
#pragma unroll
                for (int q = 0; q < 4; ++q) { const int col = col0 + wn * 64 + ni * 32 + 8 * q + 4 * h;
                    u32x2 w; w.x = cvtpk(acc[mi][ni][4 * q] * s, acc[mi][ni][4 * q + 1] * s); w.y = cvtpk(acc[mi][ni][4 * q + 2] * s, acc[mi][ni][4 * q + 3] * s);
                    *(u32x2*)(out + (size_t)(row0 + rl) * ldo + col) = w; } }
    } };
DI void rms_gemm_tile(unsigned char* sm, const bf16_t* A  , int K, const bf16_t* Bt, bf16_t* out, size_t ldo, int row0, int col0) {
    const int tid = tidx(); float* rs = (float*)(sm + GT_BYTES);
    __syncthreads();
    { const int row = tid >> 1, half = tid & 1; const bf16_t* p = A + (size_t)row * NP + half * (K >> 1); float ss = 0.f;
      for (int k = 0; k < (K >> 1); k += 8) { const u32x4 w = *(const u32x4*)(p + k);
          ss += bf_lo(w.x) * bf_lo(w.x) + bf_hi(w.x) * bf_hi(w.x) + bf_lo(w.y) * bf_lo(w.y) + bf_hi(w.y) * bf_hi(w.y) + bf_lo(w.z) * bf_lo(w.z) + bf_hi(w.z) * bf_hi(w.z) + bf_lo(w.w) * bf_lo(w.w) + bf_hi(w.w) * bf_hi(w.w); }
      ss += __shfl_xor(ss, 1);
      if (half == 0) rs[row] = rsqrtf(ss / (float)K + 1e-6f); }
    gemm_tile<true>(sm, ARowLin{A, NP}, Bt, (size_t)K, K, EpiRowScale{out, ldo, row0, col0, rs});
}
DI void krope_rows(const Args& a) {
    const bf16_t* proj = (const bf16_t*)(a.ws + WS_PROJ); unsigned char* krr = (unsigned char*)(a.ws + WS_KRR);
    for (int i = blockIdx.x * 512 + tidx(); i < MR * 32; i += gridDim.x * 512) {
        const int g = i >> 5, pr = i & 31, axis = pr >> 4, ii = pr & 15, rr = g % RPB;
        const float x1 = bf2f(proj[(size_t)g * NP + PC_KR + axis * 32 + ii]), x2 = bf2f(proj[(size_t)g * NP + PC_KR + axis * 32 + 16 + ii]);
        float o1 = x1, o2 = x2;
        if (rr >= CTXL) { const int t = rr - CTXL; const float pos = (float)(axis ? (t & 63) : (t >> 6)); const float ang = pos * exp2f(-(float)ii * 0.83048202372184059f);
            const float c = __cosf(ang), s = __sinf(ang); o1 = x1 * c - x2 * s; o2 = x2 * c + x1 * s; }
        const unsigned pk = (unsigned)__builtin_amdgcn_cvt_pk_fp8_f32(o1, o2, 0, false);
        krr[(size_t)g * 64 + axis * 32 + ii] = (unsigned char)pk; krr[(size_t)g * 64 + axis * 32 + 16 + ii] = (unsigned char)(pk >> 8);
    }
}
DI void ph_mixers1(const Args& a, int l, unsigned char* sm) {
    const bf16_t* proj = (const bf16_t*)(a.ws + WS_PROJ);
    { const float* rss = (const float*)(a.ws + WS_RSS);
      g8::DenseSched Sq{(const bf16_t*)((const unsigned char*)(a.ws + WS_KV) + (size_t)MR * 2048), (const bf16_t*)(a.ws + WS_WQB + (size_t)l * WSTRIDE), 384, 384, 6, (l == 0 ? 66 : 64) * 6, (int)gridDim.x, (int)blockIdx.x, l};
      __syncthreads();
      g8::gemm(sm, 384, 384, Sq, EpiRowScale8{(bf16_t*)(a.ws + WS_Q), 1536, rss, 1.f / 768.f, 0, 12});
      g8::DenseSched Sk{proj + PC_KV, (const bf16_t*)(a.ws + WS_WKVB + (size_t)l * WSTRIDE), NP, 256, 4, 66 * 4, (int)gridDim.x, (int)((blockIdx.x + 116) % gridDim.x), 0};
      __syncthreads();
      g8::gemm(sm, 256, 256, Sk, EpiKn8{(unsigned char*)(a.ws + WS_KV), rss});
      g8::DenseSched Sv{(const bf16_t*)(a.ws + WS_WKVB + (size_t)l * WSTRIDE) + 1024 * 256, proj + PC_KV, 256, NP, 66, 4 * 66, (int)gridDim.x, (int)((blockIdx.x + 100) % gridDim.x), 0};
      __syncthreads();
      g8::gemm(sm, 256, NP, Sv, EpiVt8{(unsigned char*)(a.ws + WS_KV) + (size_t)MR * 1024, rss}); }
    const int nss = NCH * 8, ngm = l == 0 ? 0 : NCH * 4, total = nss + ngm;
    for (int u0 = blockIdx.x; u0 < total; u0 += gridDim.x) {
        const int u = total - 1 - u0;
        if (u < nss) ssd_state_unit(a, l, u >> 3, u & 7, sm);
        else { const int v = u - nss; gmlp_unit(a, l, v >> 2, v & 3, sm); }
    }
    krope_rows(a);
}

DI void ssd_scan(const Args& a) {
    const float* ST = (const float*)(a.ws + WS_ST); const float* DEC = (const float*)(a.ws + WS_DEC); bf16_t* HP = (bf16_t*)(a.ws + WS_HP);
    for (int idx = blockIdx.x * 512 + tidx(); idx < NB * 8 * 2 * 8192; idx += gridDim.x * 512) {
        const int pn = idx & 8191, dir = (idx >> 13) & 1, hh = (idx >> 14) & 7, b = idx >> 17;
        float carry = 0.f;
#pragma unroll 6
        for (int s = 0; s < 66; ++s) {
            const int cc = dir == 0 ? s : (s < 2 ? 1 - s : 67 - s);
            const size_t base = (size_t)((b * 66 + cc) * 8 + hh) * 2 + dir;
            HP[base * 8192 + pn] = f2bf(carry);
            carry = carry * DEC[base] + __builtin_nontemporal_load(ST + base * 8192 + pn);
        }
    }
}

constexpr float ATT_SCALE = 0.07216878364870322f;
constexpr float ATT_THR = 0.5f, ATT_PEXP = 8.f;
constexpr int AF_KLD = 208, AF_VLD = 80, AF_KB = 64 * AF_KLD, AF_VB = 128 * AF_VLD, AF_K = 0, AF_V = 2 * AF_KB;
#define SBAR() __builtin_amdgcn_sched_barrier(0)
using g8::i32x4_t; using g8::i32x8_t;
#define AF_LD32(p) __builtin_shufflevector(*(const i32x4_t*)(p), *(const i32x4_t*)((p) + 16), 0, 1, 2, 3, 4, 5, 6, 7)
DI f32x16 mfma8(i32x8_t a, i32x8_t b, f32x16 c, int sc) { return __builtin_amdgcn_mfma_scale_f32_32x32x64_f8f6f4(a, b, c, 0, 0, 0, sc, 0, sc); }
DI void partialSM(f32x16& p0, f32x16& p1, float& m_reg, float& mn, float& alpha) {
    constexpr float C = ATT_SCALE * 1.4426950408889634f;
    float pmax = p0[0];
#pragma unroll
    for (int r = 1; r < 16; ++r) pmax = fmaxf(pmax, p0[r]);
#pragma unroll
    for (int r = 0; r < 16; ++r) pmax = fmaxf(pmax, p1[r]);
    { auto rr = __builtin_amdgcn_permlane32_swap(__float_as_uint(pmax), __float_as_uint(pmax), false, false);
      pmax = fmaxf(__uint_as_float(rr[0]), __uint_as_float(rr[1])); }
    if (__builtin_expect(__all(pmax - m_reg <= ATT_THR / ATT_SCALE), 1)) { mn = m_reg; alpha = 1.f; }
    else { mn = fmaxf(m_reg, pmax); alpha = __builtin_amdgcn_exp2f((m_reg - mn) * C); m_reg = mn; }
    const float mnC = ATT_PEXP - mn * C;
#pragma unroll
    for (int r = 0; r < 16; ++r) p0[r] = fmaf(p0[r], C, mnC);
#pragma unroll
    for (int r = 0; r < 16; ++r) p1[r] = fmaf(p1[r], C, mnC);
#pragma unroll
    for (int r = 0; r < 16; ++r) p0[r] = __builtin_amdgcn_exp2f(p0[r]);
}
DI void finishSM(f32x16& p0, f32x16& p1, float alpha, float& l_reg, i32x8_t& P) {
#pragma unroll
    for (int r = 0; r < 16; ++r) p1[r] = __builtin_amdgcn_exp2f(p1[r]);
    float ps = 0;
#pragma unroll
    for (int r = 0; r < 16; ++r) ps += p0[r];
#pragma unroll
    for (int r = 0; r < 16; ++r) ps += p1[r];
    asm volatile("" : "+v"(ps));
    l_reg = l_reg * alpha + ps;
#pragma unroll
    for (int w = 0; w < 4; ++w) { P[w] = (int)pk_fp8((f32x4){p0[4 * w], p0[4 * w + 1], p0[4 * w + 2], p0[4 * w + 3]}); P[4 + w] = (int)pk_fp8((f32x4){p1[4 * w], p1[4 * w + 1], p1[4 * w + 2], p1[4 * w + 3]}); }
}
DI void qkt(f32x16& p0, f32x16& p1, const unsigned char* K, const i32x8_t (&qf)[3], int r32, int hi, int sc1) {
    const unsigned char* k0 = K + r32 * AF_KLD + hi * 32; const unsigned char* k1 = k0 + 32 * AF_KLD;
#pragma unroll
    for (int r = 0; r < 16; ++r) { p0[r] = 0.f; p1[r] = 0.f; }
#pragma unroll
    for (int blk = 0; blk < 3; ++blk) { const i32x8_t a0 = AF_LD32(k0 + blk * 64), a1 = AF_LD32(k1 + blk * 64);
        p0 = mfma8(a0, qf[blk], p0, sc1); p1 = mfma8(a1, qf[blk], p1, sc1); }
}
DI void pv_d0(f32x16* o, const unsigned char* V, const i32x8_t P, int r32, int hi, int sc1) {
    const unsigned char* vb = V + r32 * AF_VLD + hi * 32;
#pragma unroll
    for (int d = 0; d < 4; ++d) { const i32x8_t av = AF_LD32(vb + d * 32 * AF_VLD); o[d] = mfma8(av, P, o[d], sc1); }
}
DI unsigned q8pack(unsigned w0, unsigned w1) { return pk_fp8((f32x4){bf_lo(w0), bf_hi(w0), bf_lo(w1), bf_hi(w1)}); }
DI void attn_unit(const Args& a, int qrow0, int krow0, int seq, int hh, int rope_t0, unsigned char* lds) {
    const bf16_t* Qg = (const bf16_t*)(a.ws + WS_Q); const unsigned char* KNg = (const unsigned char*)(a.ws + WS_KV); const unsigned char* VTg = KNg + (size_t)MR * 1024; const unsigned char* KRg = (const unsigned char*)(a.ws + WS_KRR);
    unsigned char* Og = (unsigned char*)(a.ws + WS_MIX);
    int tid_o = tidx();
    const int tid = tid_o, wid = tid >> 6, lane = tid & 63, r32 = lane & 31, hi = lane >> 5;
    int sc1 = 0x7f7f7f7f; asm volatile("" : "+s"(sc1));
    float m_reg = -1e30f, l_reg = 0; f32x16 o[4];
#pragma unroll
    for (int d = 0; d < 4; ++d)
#pragma unroll
        for (int r = 0; r < 16; ++r) o[d][r] = 0.f;
    i32x8_t qf[3];
    { const bf16_t* Qw = Qg + (size_t)(qrow0 + wid * 32 + r32) * 1536 + hh * 192 + hi * 32;
#pragma unroll
      for (int blk = 0; blk < 2; ++blk)
#pragma unroll
          for (int i = 0; i < 4; ++i) { const u32x4 w = *(const u32x4*)(Qw + blk * 64 + i * 8); qf[blk][2 * i] = (int)q8pack(w.x, w.y); qf[blk][2 * i + 1] = (int)q8pack(w.z, w.w); }
      const u32x4 xa = *(const u32x4*)(Qw + 128), xb = *(const u32x4*)(Qw + 136), ya = *(const u32x4*)(Qw + 144), yb = *(const u32x4*)(Qw + 152);
      const unsigned x1w[8] = {xa.x, xa.y, xa.z, xa.w, xb.x, xb.y, xb.z, xb.w}, x2w[8] = {ya.x, ya.y, ya.z, ya.w, yb.x, yb.y, yb.z, yb.w};
      const int t = rope_t0 + wid * 32 + r32; const float pos = rope_t0 >= 0 ? (float)(hi ? (t & 63) : (t >> 6)) : 0.f;
#pragma unroll
      for (int i = 0; i < 4; ++i) { f32x4 y1, y2;
#pragma unroll
          for (int j = 0; j < 4; ++j) { const int f = 4 * i + j; const unsigned w1 = x1w[f >> 1], w2 = x2w[f >> 1];
              const float u1 = (f & 1) ? bf_hi(w1) : bf_lo(w1), u2 = (f & 1) ? bf_hi(w2) : bf_lo(w2);
              const float ang = pos * exp2f(-(float)f * 0.83048202372184059f); const float c = __cosf(ang), sn = __sinf(ang);
              y1[j] = u1 * c - u2 * sn; y2[j] = u2 * c + u1 * sn; }
          qf[2][i] = (int)pk_fp8(y1); qf[2][4 + i] = (int)pk_fp8(y2); } }
    const int skey = tid >> 3, spart = tid & 7;
    const unsigned char* Kp = KNg + (size_t)krow0 * 1024 + hh * 128; const unsigned char* Krp = KRg + (size_t)krow0 * 64; const unsigned char* Vp = VTg + ((size_t)((krow0 >> 6) * 8 + hh) * 128) * 64;
    const unsigned koff = (unsigned)(skey * 1024 + spart * 16), kroff = (unsigned)(skey * 64 + spart * 8), voff = (unsigned)(tid * 16);
    unsigned char* kw = lds + AF_K + skey * AF_KLD + spart * 16; unsigned char* krw = lds + AF_K + skey * AF_KLD + 128 + spart * 8; unsigned char* vw = lds + AF_V + (tid >> 2) * AF_VLD + (tid & 3) * 16;
    u32x4 ks, vs; u32x2 kr;
#define SLOAD(k0) do { ks = *(const u32x4*)(Kp + (size_t)(k0) * 1024 + koff); kr = *(const u32x2*)(Krp + (size_t)(k0) * 64 + kroff); vs = *(const u32x4*)(Vp + (size_t)((k0) >> 6) * 65536 + voff); } while (0)
#define SWRITE(b) do { *(u32x4*)(kw + (b) * AF_KB) = ks; *(u32x2*)(krw + (b) * AF_KB) = kr; *(u32x4*)(vw + (b) * AF_VB) = vs; } while (0)
#define SWAIT() asm volatile("s_waitcnt vmcnt(0)" ::: "memory")
#define RESC(al) do { if (__any((al) < 1.f)) { _Pragma("unroll") for (int d = 0; d < 4; ++d) _Pragma("unroll") for (int r = 0; r < 16; ++r) o[d][r] *= (al); } } while (0)
    const unsigned char* K0 = lds + AF_K; const unsigned char* K1 = K0 + AF_KB; const unsigned char* V0 = lds + AF_V; const unsigned char* V1 = V0 + AF_VB;
    f32x16 pA0, pA1, pB0, pB1; float mnA, mnB, alA, alB; i32x8_t P; const int NT = seq / 64;
    __syncthreads();
    SLOAD(0); SWAIT(); SWRITE(0); __syncthreads();
    qkt(pA0, pA1, K0, qf, r32, hi, sc1); partialSM(pA0, pA1, m_reg, mnA, alA);
    SLOAD(64);
    SWAIT(); SWRITE(1); if (NT > 2) SLOAD(128); __syncthreads();
#pragma unroll 1
    for (int j = 1; j + 1 < NT; j += 2) {
        SBAR(); qkt(pB0, pB1, K1, qf, r32, hi, sc1);
        finishSM(pA0, pA1, alA, l_reg, P); SBAR();
        pv_d0(o, V0, P, r32, hi, sc1); partialSM(pB0, pB1, m_reg, mnB, alB);
        __syncthreads(); SWAIT(); SWRITE(0); SLOAD((j + 2) * 64);
        RESC(alB); __syncthreads();
        SBAR(); qkt(pA0, pA1, K0, qf, r32, hi, sc1);
        finishSM(pB0, pB1, alB, l_reg, P); SBAR();
        pv_d0(o, V1, P, r32, hi, sc1); partialSM(pA0, pA1, m_reg, mnA, alA);
        __syncthreads(); SWAIT(); SWRITE(1); if (j + 3 < NT) SLOAD((j + 3) * 64);
        RESC(alA); __syncthreads();
    }
    SBAR(); qkt(pB0, pB1, K1, qf, r32, hi, sc1);
    finishSM(pA0, pA1, alA, l_reg, P); SBAR();
    pv_d0(o, V0, P, r32, hi, sc1); partialSM(pB0, pB1, m_reg, mnB, alB);
    RESC(alB);
    finishSM(pB0, pB1, alB, l_reg, P); SBAR();
    pv_d0(o, V1, P, r32, hi, sc1);
    { auto rr = __builtin_amdgcn_permlane32_swap(__float_as_uint(l_reg), __float_as_uint(l_reg), false, false);
      l_reg = __uint_as_float(rr[0]) + __uint_as_float(rr[1]); }
    const float rl = __builtin_amdgcn_rcpf(l_reg) * MIXS;
    int obase = (qrow0 + wid * 32 + r32) * DM + 1024 + hh * 128 + 4 * hi;
    asm volatile("" : "+v"(obase));
    unsigned char* Ow = Og + obase;
#pragma unroll
    for (int d = 0; d < 4; ++d)
#pragma unroll
        for (int g = 0; g < 4; ++g) *(unsigned*)(Ow + d * 32 + 8 * g) = pk_fp8((f32x4){o[d][4 * g] * rl, o[d][4 * g + 1] * rl, o[d][4 * g + 2] * rl, o[d][4 * g + 3] * rl});
#undef SLOAD
#undef SWRITE
#undef SWAIT
#undef RESC
}
DI void ph_attn(const Args& a, int l, unsigned char* sm) {
    ssd_scan(a);
    const bool early = (((int)blockIdx.x >> 3) & 1) == 0;
    if (l == 0 && early) { ph_convert_experts(a, 0, sm); ph_convert(a, 1, sm); __syncthreads(); }
    const int nlat = NB * 8 * 32, total = nlat + (l == 0 ? NB * 8 : 0);
    for (int u = blockIdx.x; u < total; u += gridDim.x) {
        if (u < nlat) { const int b = u >> 8, w = u & 255, hh = w & 7, qb = w >> 3;
            attn_unit(a, b * RPB + CTXL + qb * 256, b * RPB, RPB, hh, qb * 256, sm); }
        else { const int v = u - nlat, b = v >> 3, hh = v & 7;
            attn_unit(a, b * RPB, b * RPB, CTXL, hh, -1, sm); }
    }
    if (l == 0 && !early) { __syncthreads(); ph_convert_experts(a, 0, sm); ph_convert(a, 1, sm); }
}

DI void ssd_out_unit(const Args& a, int l, int ck, int gg, unsigned char* sm) {
    const int tid = tidx(), wave = tid >> 6, lane = tid & 63, r = lane & 31, h = lane >> 5, wm = wave >> 1, wn = wave & 1;
    const bf16_t* proj = (const bf16_t*)(a.ws + WS_PROJ); const float* dtbuf = (const float*)(a.ws + WS_DT); const bf16_t* HP = (const bf16_t*)(a.ws + WS_HP);
    unsigned char* mix = (unsigned char*)(a.ws + WS_MIX);
    unsigned char* Cc = sm;
    unsigned char* BM = sm + 34816;
    unsigned char* XT = sm + 69632;
    unsigned char* Hf = sm + 87040;
    unsigned char* Hb = sm + 104448;
    float* sc = (float*)(sm + 121856);
    float* ssq = (float*)(sm + 121856 + 8192);
    int g0, seg_lo, seg_hi; chunk_seg(ck, g0, seg_lo, seg_hi);
    const float* cw = a.conv_w + (size_t)l * 5 * 1024; const float* cb = a.conv_b + (size_t)l * 1024;
    __syncthreads();
    { const int hl = wave >> 1, dir = wave & 1, hh = gg * 4 + hl;
      dt_scan_wave(dtbuf, g0, dir * 8 + hh, a.dt_bias[(l * 2 + dir) * 8 + hh], -__expf(a.a_log[(l * 2 + dir) * 8 + hh]), dir, sc + wave * 128, sc + 1024 + wave * 128, lane); }
#pragma unroll 1
    for (int i = 0; i < 8; ++i) {
        const int idx = tid + i * 512, isB = idx >> 11, rem = idx & 2047, lrow = rem >> 4, c0 = (rem & 15) * 8; float o[8];
        conv8(proj, g0 + lrow, seg_lo, seg_hi, (isB ? 512 : 768) + gg * 128 + c0, cw, cb, o);
        u32x4 w; w.x = cvtpk(o[0], o[1]); w.y = cvtpk(o[2], o[3]); w.z = cvtpk(o[4], o[5]); w.w = cvtpk(o[6], o[7]);
        *(u32x4*)((isB ? BM : Cc) + lrow * 272 + c0 * 2) = w;
    }
    __syncthreads();
    f32x16 G[1][2];
#pragma unroll
    for (int j = 0; j < 2; ++j)
#pragma unroll
        for (int q = 0; q < 16; ++q) G[0][j][q] = 0.f;
    mma_lds<1, 2, 8, true>(Cc + wm * 32 * 272, 272, BM + wn * 64 * 272, 272, G, r, h);
    const int lrow = wm * 32 + r;
    u32x2 yp0[4], yp1[4], yp2[4], yp3[4]; float ssl = 0.f;
#pragma unroll
    for (int q = 0; q < 4; ++q) { yp0[q] = (u32x2){0u, 0u}; yp1[q] = yp0[q]; yp2[q] = yp0[q]; yp3[q] = yp0[q]; }
#pragma unroll 1
    for (int hl = 0; hl < 4; ++hl) {
        const int hh = gg * 4 + hl;
        const float* dtf = sc + (hl * 2) * 128; const float* dtb = sc + (hl * 2 + 1) * 128; const float* acf = sc + 1024 + (hl * 2) * 128; const float* acb = sc + 1024 + (hl * 2 + 1) * 128;
        __syncthreads();
#pragma unroll 1
        for (int i = 0; i < 2; ++i) { const int idx = tid + i * 512, lr2 = idx >> 3, c0 = (idx & 7) * 8; float o[8];
            conv8(proj, g0 + lr2, seg_lo, seg_hi, hh * 64 + c0, cw, cb, o);
#pragma unroll
            for (int j = 0; j < 8; ++j) *(bf16_t*)(XT + (c0 + j) * 272 + lr2 * 2) = f2bf(o[j]); }
        { const bf16_t* hp = HP + ((size_t)(ck * 8 + hh) * 2) * 8192;
#pragma unroll
          for (int i = 0; i < 4; ++i) { const int idx = tid + i * 512, dir = idx >> 10, rem = idx & 1023, p = rem >> 4, n8 = (rem & 15) * 8;
              *(u32x4*)((dir ? Hb : Hf) + p * 272 + n8 * 2) = *(const u32x4*)(hp + (size_t)dir * 8192 + p * 128 + n8); } }
        { const float afl = acf[lrow], abl = acb[lrow];
#pragma unroll
          for (int ni = 0; ni < 2; ++ni)
#pragma unroll
              for (int q = 0; q < 4; ++q) { float mv[4];
#pragma unroll
                  for (int j = 0; j < 4; ++j) { const int s = wn * 64 + ni * 32 + 8 * q + 4 * h + j;
                      const float wf = (s <= lrow) ? __expf(afl - acf[s]) * dtf[s] : 0.f, wb = (s >= lrow) ? __expf(abl - acb[s]) * dtb[s] : 0.f;
                      mv[j] = G[0][ni][4 * q + j] * (wf + wb); }
                  u32x2 w; w.x = cvtpk(mv[0], mv[1]); w.y = cvtpk(mv[2], mv[3]);
                  *(u32x2*)(BM + lrow * 272 + (wn * 64 + ni * 32 + 8 * q + 4 * h) * 2) = w; } }
        __syncthreads();
        f32x16 a1[1][1], aF[1][1], aB[1][1];
#pragma unroll
        for (int q = 0; q < 16; ++q) { a1[0][0][q] = 0.f; aF[0][0][q] = 0.f; aB[0][0][q] = 0.f; }
        mma_lds<1, 1, 8, true>(BM + wm * 32 * 272, 272, XT + wn * 32 * 272, 272, a1, r, h);
        mma_lds<1, 1, 8, true>(Cc + wm * 32 * 272, 272, Hf + wn * 32 * 272, 272, aF, r, h);
        mma_lds<1, 1, 8, true>(Cc + wm * 32 * 272, 272, Hb + wn * 32 * 272, 272, aB, r, h);
        const float ef = __expf(acf[lrow]), eb = __expf(acb[lrow]), dsk = a.d_skip[l * 8 + hh];
#pragma unroll
        for (int q = 0; q < 4; ++q) {
            const int p0 = wn * 32 + 8 * q + 4 * h;
            const u32x2 zz = *(const u32x2*)(proj + (size_t)(g0 + lrow) * NP + PC_Z + hh * 64 + p0);
            const float zv[4] = {bf_lo(zz.x), bf_hi(zz.x), bf_lo(zz.y), bf_hi(zz.y)};
            float vv[4];
#pragma unroll
            for (int j = 0; j < 4; ++j) {
                const float xv = bf2f(*(const bf16_t*)(XT + (p0 + j) * 272 + lrow * 2));
                const float y = a1[0][0][4 * q + j] + ef * aF[0][0][4 * q + j] + eb * aB[0][0][4 * q + j] + dsk * xv;
                vv[j] = y * silu_f(zv[j]); ssl += vv[j] * vv[j];
            }
            u32x2 w; w.x = cvtpk(vv[0], vv[1]); w.y = cvtpk(vv[2], vv[3]);
            if (hl == 0) yp0[q] = w; else if (hl == 1) yp1[q] = w; else if (hl == 2) yp2[q] = w; else yp3[q] = w;
        }
    }
    ssq[lrow * 4 + wn * 2 + h] = ssl;
    __syncthreads();
    const float rstd = rsqrtf((ssq[lrow * 4] + ssq[lrow * 4 + 1] + ssq[lrow * 4 + 2] + ssq[lrow * 4 + 3]) * (1.f / 256.f) + 1e-6f);
#pragma unroll
    for (int hl = 0; hl < 4; ++hl)
#pragma unroll
        for (int q = 0; q < 4; ++q) {
            const int ch = gg * 256 + hl * 64 + wn * 32 + 8 * q + 4 * h;
            const f32x4 gs = *(const f32x4*)(a.g_ssm + l * 512 + ch);
            const u32x2 yv = hl == 0 ? yp0[q] : hl == 1 ? yp1[q] : hl == 2 ? yp2[q] : yp3[q];
            *(unsigned*)(mix + (size_t)(g0 + lrow) * DM + 512 + ch) = pk_mix(bf_lo(yv.x) * rstd * gs[0], bf_hi(yv.x) * rstd * gs[1], bf_lo(yv.y) * rstd * gs[2], bf_hi(yv.y) * rstd * gs[3]);
        }
}
DI void ph_ssd_out(const Args& a, int l, unsigned char* sm) {
    if (l == 0) { for (int u = blockIdx.x; u < NCH * 2; u += gridDim.x) ssd_out_unit(a, l, u >> 1, u & 1, sm);
        const int G = (int)gridDim.x, skip = NCH * 2 - G > 0 && NCH * 2 - G < G ? NCH * 2 - G : 0;
        if ((int)blockIdx.x >= skip) for (int v = (int)blockIdx.x - skip; v < NCH * 4; v += G - skip) gmlp_unit(a, l, v >> 2, v & 3, sm); }
    else { for (int u = blockIdx.x; u < 256; u += gridDim.x) { const int lc = u >> 1; ssd_out_unit(a, l, (lc >> 6) * 66 + 2 + (lc & 63), u & 1, sm); } }
}

struct EpiOut { float* Y; const float* xres; const float* gate;     int row0, col0;
    DI void operator()(f32x16 (&acc)[2][2], int wm, int wn, int r, int h) const {
#pragma unroll
        for (int mi = 0; mi < 2; ++mi)
#pragma unroll
            for (int ni = 0; ni < 2; ++ni)
#pragma unroll
                for (int q = 0; q < 4; ++q) { const int row = row0 + wm * 64 + mi * 32 + r, col = col0 + wn * 64 + ni * 32 + 8 * q + 4 * h;
                    const f32x4 xr = *(const f32x4*)(xres + (size_t)row * DM + col), gt = *(const f32x4*)(gate + col);
                    f32x4 o; o[0] = DN_ALPHA * xr[0] + gt[0] * acc[mi][ni][4 * q]; o[1] = DN_ALPHA * xr[1] + gt[1] * acc[mi][ni][4 * q + 1];
                    o[2] = DN_ALPHA * xr[2] + gt[2] * acc[mi][ni][4 * q + 2]; o[3] = DN_ALPHA * xr[3] + gt[3] * acc[mi][ni][4 * q + 3];
                    *(f32x4*)(Y + (size_t)row * DM + col) = o; }
    } };
DI void ph_outproj(const Args& a, int l, unsigned char* sm) {
    g8::DenseSched S{(const bf16_t*)(a.ws + WS_MIX), (const bf16_t*)(a.ws + WS_WOUT + (size_t)l * WSTRIDE), 1024, 1024, 8, (l == 0 ? 66 : 64) * 8, (int)gridDim.x, (int)blockIdx.x, l};
    __syncthreads();
    g8::gemm(sm, 1024, 1024, S, EpiOut8{(bf16_t*)(a.ws + WS_Y), 1.f / (64.f * MIXS)});
}

DI void ph_ln1_router(const Args& a, int l, unsigned char* sm) {
    const int tid = tidx(), wave = tid >> 6, lane = tid & 63;
    bf16_t* Y = (bf16_t*)(a.ws + WS_XRES); const bf16_t* MO = (const bf16_t*)(a.ws + WS_Y); unsigned char* tok8 = (unsigned char*)(a.ws + WS_HB); const float* mod = (const float*)(a.ws + WS_MOD);
    const bf16_t* wrh = (const bf16_t*)(a.ws + WS_WRH + (size_t)l * WSTRIDE); const bf16_t* wrl = (const bf16_t*)(a.ws + WS_WRL + (size_t)l * WSTRIDE);
    int* gcnt = (int*)(a.ws + WS_CNT) + l * 64; ListEnt* list = (ListEnt*)(a.ws + WS_LIST); ListEnt* tslot = (ListEnt*)(a.ws + WS_TSLOT);
    constexpr int TLD = 2052;
    float* tokf = (float*)sm;
    float* part = (float*)(sm + 16 * TLD * 4);
    int* lcnt = (int*)(sm + 16 * TLD * 4 + 8192);
    int* lbase = lcnt + 64;
    int* ent0 = lbase + 64;
    const float* g1 = a.ln1_g + l * DM; const float* b1 = a.ln1_b + l * DM; const float* brt = a.b_router + l * 64;
    const int nunits = l == 0 ? MR / 16 : NB * SEQ / 16;
    __syncthreads();
    if (tid < 64) lcnt[tid] = 0;
    int nu = 0;
    for (int u = blockIdx.x; u < nunits && nu < 5; u += gridDim.x, ++nu) {
        const int g0 = l == 0 ? u * 16 : (u < 512 ? CTXL + u * 16 : RPB + CTXL + (u - 512) * 16);
        int* ent = ent0 + nu * 512;
        __syncthreads();
        if (tid < 128) { ent[tid * 4] = g0 + (tid >> 3); ent[tid * 4 + 1] = 0; ent[tid * 4 + 2] = 0; ent[tid * 4 + 3] = 0; }
        { const int rlA = wave * 2, gA = g0 + rlA, gB = gA + 1, bq = gA / RPB, rq = gA % RPB;
          const float* m = mod + ((size_t)l * 3 + (rq < CTXL ? 2 : bq)) * 12288;
          bf16_t* yA = Y + (size_t)gA * DM; bf16_t* yB = Y + (size_t)gB * DM; f32x4 vA[8], vB[8]; float sA = 0.f, sB = 0.f;
          const float* xinA = rq < CTXL ? a.ctx + ((size_t)(bq * CTXL + rq)) * DM : a.x + ((size_t)(bq * SEQ + rq - CTXL)) * DM; const float* xinB = xinA + DM;
#pragma unroll
          for (int j = 0; j < 8; ++j) { const int c = j * 256 + lane * 4; const f32x4 gt = *(const f32x4*)(m + 2 * DM + c);
              const u32x2 mA = __builtin_nontemporal_load((const u32x2*)(MO + (size_t)gA * DM + c)), mB = __builtin_nontemporal_load((const u32x2*)(MO + (size_t)gB * DM + c));
              f32x4 rA, rB;
              if (l == 0) { rA = __builtin_nontemporal_load((const f32x4*)(xinA + c)); rB = __builtin_nontemporal_load((const f32x4*)(xinB + c)); }
              else { const u32x2 wA = __builtin_nontemporal_load((const u32x2*)(yA + c)), wB = __builtin_nontemporal_load((const u32x2*)(yB + c)); rA = (f32x4){bf_lo(wA.x), bf_hi(wA.x), bf_lo(wA.y), bf_hi(wA.y)}; rB = (f32x4){bf_lo(wB.x), bf_hi(wB.x), bf_lo(wB.y), bf_hi(wB.y)}; }
              vA[j] = DN_ALPHA * rA + gt * (f32x4){bf_lo(mA.x), bf_hi(mA.x), bf_lo(mA.y), bf_hi(mA.y)};
              vB[j] = DN_ALPHA * rB + gt * (f32x4){bf_lo(mB.x), bf_hi(mB.x), bf_lo(mB.y), bf_hi(mB.y)}; }
#pragma unroll
          for (int j = 0; j < 8; ++j) { sA += (vA[j][0] + vA[j][1]) + (vA[j][2] + vA[j][3]); sB += (vB[j][0] + vB[j][1]) + (vB[j][2] + vB[j][3]); }
#pragma unroll
          for (int o = 32; o >= 1; o >>= 1) { sA += __shfl_xor(sA, o); sB += __shfl_xor(sB, o); }
          const float muA = sA * (1.f / 2048.f), muB = sB * (1.f / 2048.f); float qA = 0.f, qB = 0.f;
#pragma unroll
          for (int j = 0; j < 8; ++j) { const f32x4 dA = vA[j] - muA, dB = vB[j] - muB; qA += (dA[0] * dA[0] + dA[1] * dA[1]) + (dA[2] * dA[2] + dA[3] * dA[3]); qB += (dB[0] * dB[0] + dB[1] * dB[1]) + (dB[2] * dB[2] + dB[3] * dB[3]); }
#pragma unroll
          for (int o = 32; o >= 1; o >>= 1) { qA += __shfl_xor(qA, o); qB += __shfl_xor(qB, o); }
          const float rsA = rsqrtf(qA * (1.f / 2048.f) + 1e-5f), rsB = rsqrtf(qB * (1.f / 2048.f) + 1e-5f);
#pragma unroll
          for (int j = 0; j < 8; ++j) { const int c = j * 256 + lane * 4;
              const f32x4 gg = *(const f32x4*)(g1 + c), bb = *(const f32x4*)(b1 + c), sc = 1.f + *(const f32x4*)(m + 4 * DM + c), sh = *(const f32x4*)(m + 3 * DM + c);
              const f32x4 xA = (vA[j] - muA) * rsA * gg + bb, xB = (vB[j] - muB) * rsB * gg + bb;
              { u32x2 wA, wB; wA.x = cvtpk(xA[0], xA[1]); wA.y = cvtpk(xA[2], xA[3]); wB.x = cvtpk(xB[0], xB[1]); wB.y = cvtpk(xB[2], xB[3]); *(u32x2*)(yA + c) = wA; *(u32x2*)(yB + c) = wB; }
              const f32x4 tA = xA * sc + sh, tB = xB * sc + sh;
              *(unsigned*)(tok8 + (size_t)gA * DM + c) = pk_fp8(tA); *(unsigned*)(tok8 + (size_t)gB * DM + c) = pk_fp8(tB);
              *(f32x4*)(tokf + rlA * TLD + c) = tA; *(f32x4*)(tokf + (rlA + 1) * TLD + c) = tB; }
        }
        __syncthreads();
        { const int nb = wave & 3, kh = wave >> 2, rw = lane & 15, kq = lane >> 4;
          f32x4 acc = {0.f, 0.f, 0.f, 0.f};
          const float* ap = tokf + rw * TLD + kh * 1024 + kq * 8;
          const bf16_t* bh = wrh + (size_t)(nb * 16 + rw) * 2048 + kh * 1024 + kq * 8; const bf16_t* bl = wrl + (size_t)(nb * 16 + rw) * 2048 + kh * 1024 + kq * 8;
#pragma unroll 8
          for (int ks = 0; ks < 32; ++ks) {
              const f32x4 x0 = *(const f32x4*)(ap + ks * 32), x1 = *(const f32x4*)(ap + ks * 32 + 4);
              u32x4 hw; hw.x = cvtpk(x0[0], x0[1]); hw.y = cvtpk(x0[2], x0[3]); hw.z = cvtpk(x1[0], x1[1]); hw.w = cvtpk(x1[2], x1[3]);
              u32x4 lw; lw.x = cvtpk(x0[0] - bf_lo(hw.x), x0[1] - bf_hi(hw.x)); lw.y = cvtpk(x0[2] - bf_lo(hw.y), x0[3] - bf_hi(hw.y));
              lw.z = cvtpk(x1[0] - bf_lo(hw.z), x1[1] - bf_hi(hw.z)); lw.w = cvtpk(x1[2] - bf_lo(hw.w), x1[3] - bf_hi(hw.w));
              const bf16x8 ahi = *reinterpret_cast<bf16x8*>(&hw), alo = *reinterpret_cast<bf16x8*>(&lw);
              const bf16x8 bhi = *(const bf16x8*)(bh + ks * 32), blo = *(const bf16x8*)(bl + ks * 32);
              acc = __builtin_amdgcn_mfma_f32_16x16x32_bf16(ahi, bhi, acc, 0, 0, 0);
              acc = __builtin_amdgcn_mfma_f32_16x16x32_bf16(ahi, blo, acc, 0, 0, 0);
              acc = __builtin_amdgcn_mfma_f32_16x16x32_bf16(alo, bhi, acc, 0, 0, 0);
          }
#pragma unroll
          for (int j = 0; j < 4; ++j) part[(kh * 16 + kq * 4 + j) * 64 + nb * 16 + rw] = acc[j]; }
        __syncthreads();
#pragma unroll 1
        for (int rr2 = 0; rr2 < 2; ++rr2) {
            const int rl = wave * 2 + rr2, g = g0 + rl;
            const float logit = part[rl * 64 + lane] + part[(16 + rl) * 64 + lane];
            float score = 1.f / (1.f + __expf(-logit)); if (!(score >= 0.f && score <= 1.f)) score = 0.5f;
            const float bsd = score + brt[lane];
            int rk = 0;
#pragma unroll
            for (int j = 0; j < 8; ++j) { const int src = (lane & ~7) + j; const float o = __shfl(bsd, src); rk += (o > bsd || (o == bsd && src < lane)) ? 1 : 0; }
            float gs = rk < 2 ? bsd : 0.f; gs += __shfl_xor(gs, 1); gs += __shfl_xor(gs, 2); gs += __shfl_xor(gs, 4);
            int grk = 0; const int mygrp = lane >> 3;
#pragma unroll
            for (int j = 0; j < 8; ++j) { const float o = __shfl(gs, j * 8); grk += (o > gs || (o == gs && j < mygrp)) ? 1 : 0; }
            const bool elig = grk < 4; const float val = elig ? bsd : -INFINITY;
            int erk = 0;
#pragma unroll
            for (int j = 0; j < 64; ++j) { const float o = __int_as_float(__builtin_amdgcn_readlane(__float_as_int(val), j)); erk += (o > val || (o == val && j < lane)) ? 1 : 0; }
            const bool sel = elig && erk < 8;
            const float wsum = wave_sum(sel ? score : 0.f); const float wgt = score / wsum * 2.5f;
            if (sel) { const int lp = atomicAdd(&lcnt[lane], 1); int* e = ent + (rl * 8 + erk) * 4; e[0] = g; e[1] = lane; e[2] = __float_as_int(wgt); e[3] = lp; }
        }
    }
    __syncthreads();
    if (tid < 64) { const int c = lcnt[tid]; lbase[tid] = c ? atomicAdd(&gcnt[tid], c) : 0; }
    __syncthreads();
    for (int i = tid; i < nu * 128; i += 512) { const int* e = ent0 + i * 4; int pos = lbase[e[1] & 63] + e[3]; pos = pos < 0 ? 0 : (pos >= MR ? MR - 1 : pos);
        ListEnt le; le.row = e[0]; le.w = __int_as_float(e[2]); list[(size_t)e[1] * MR + pos] = le;
        ListEnt ts; ts.row = e[1] * 32768 + pos; ts.w = le.w; tslot[(size_t)e[0] * 8 + (i & 7)] = ts; }
}

DI void moe_offsets(const Args& a, int l, int* mtoff  ) {
    const int tid = tidx();
    if (tid < 64) { const int* gcnt = (const int*)(a.ws + WS_CNT) + l * 64;
        const int c = gcnt[tid], t = (c + 255) >> 8; int incl = t;
#pragma unroll
        for (int o = 1; o < 64; o <<= 1) { const int v = __shfl_up(incl, o); if (tid >= o) incl += v; }
        mtoff[tid] = incl - t; mtoff[72 + tid] = c;
        if (tid == 63) { const int cs = l == 0 ? MR : NB * SEQ; mtoff[64] = incl; mtoff[72 + 64] = cs; mtoff[NE1] = incl + ((cs + 255) >> 8); } }
    __syncthreads();
    if (tid < NE1) { unsigned char* etab = (unsigned char*)(mtoff + 144); const int hi = mtoff[tid + 1] < 1024 ? mtoff[tid + 1] : 1024; for (int m = mtoff[tid]; m < hi; ++m) etab[m] = (unsigned char)tid; }
    __syncthreads();
}
DI int moe_find(const int* mtoff, int mtg) { int e = 0;
#pragma unroll 1
    for (int j = 1; j < NE1; ++j) e = (mtoff[j] <= mtg) ? j : e;
    return e; }
struct ARowGather { const bf16_t* base; const int* rt; DI const bf16_t* operator()(int i) const { return base + (size_t)rt[i] * DM; } };
struct EpiGU { bf16_t* H; int slot0, col0;
    DI void operator()(f32x16 (&acc)[2][2], int wm, int wn, int r, int h) const {
#pragma unroll
        for (int mi = 0; mi < 2; ++mi)
#pragma unroll
            for (int q = 0; q < 4; ++q) { const int row = slot0 + wm * 64 + mi * 32 + r, col = col0 + wn * 32 + 8 * q + 4 * h; float o[4];
#pragma unroll
                for (int j = 0; j < 4; ++j) o[j] = silu_f(acc[mi][0][4 * q + j]) * acc[mi][1][4 * q + j];
                u32x2 w; w.x = cvtpk(o[0], o[1]); w.y = cvtpk(o[2], o[3]); *(u32x2*)(H + (size_t)row * 512 + col) = w; }
    } };
DI void ph_gateup(const Args& a, int l, unsigned char* sm) {
    int* mtoff = (int*)(sm + g8::STAGE_BYTES);
    __syncthreads(); moe_offsets(a, l, mtoff);
    MoeGUSched S{(const bf16_t*)(a.ws + WS_HB), (const bf16_t*)(a.ws + WS_WGU + (size_t)l * WSTRIDE), mtoff, (const int*)(a.ws + WS_CNT) + l * 64, (const ListEnt*)(a.ws + WS_LIST), mtoff[NE1] * 4, (int)gridDim.x, (int)blockIdx.x, l};
    g8::gemm(sm, 1024, 1024, S, EpiGU8{(unsigned char*)(a.ws + WS_H), 1.f / 64.f});
}
DI void ph_down(const Args& a, int l, unsigned char* sm) {
    int* mtoff = (int*)(sm + g8::STAGE_BYTES);
    __syncthreads(); moe_offsets(a, l, mtoff);
    MoeDownSched S{(const bf16_t*)(a.ws + WS_H), (const bf16_t*)(a.ws + WS_WDN + (size_t)l * WSTRIDE), mtoff, mtoff[NE1] * 8, (int)gridDim.x, (int)blockIdx.x};
    g8::gemm(sm, 256, 256, S, EpiDown8{(unsigned char*)(a.ws + WS_O), 1.f / 64.f});
}

DI void ph_ln2(const Args& a, int l, unsigned char* sm) {
    const int tid = tidx(), wave = tid >> 6, lane = tid & 63;
    int* mtoff = (int*)sm;
    __syncthreads(); moe_offsets(a, l, mtoff);
    const bf16_t* X1 = (const bf16_t*)(a.ws + WS_XRES); const unsigned char* O8 = (const unsigned char*)(a.ws + WS_O); const ListEnt* tslot = (const ListEnt*)(a.ws + WS_TSLOT);
    const float* mod = (const float*)(a.ws + WS_MOD); bf16_t* xres = (bf16_t*)(a.ws + WS_XRES); unsigned char* hb8 = (unsigned char*)(a.ws + WS_HB);
    const float* g2 = a.ln2_g + l * DM; const float* b2 = a.ln2_b + l * DM;
    const int nrows = l == 0 ? MR : NB * SEQ;
    for (int gi = blockIdx.x * 8 + wave; gi < nrows; gi += gridDim.x * 8) {
        const int g = l == 0 ? gi : (gi < SEQ ? CTXL + gi : RPB + CTXL + (gi - SEQ));
        const int b = g / RPB, rr = g % RPB;
        const float* m = mod + ((size_t)l * 3 + (rr < CTXL ? 2 : b)) * 12288;
#define LN2_C(j) ((((j) >> 2) << 10) + lane * 16 + (((j) & 3) << 2))
        const ListEnt mine = tslot[(size_t)g * 8 + (lane & 7)];
        f32x4 f[8];
        { const unsigned char* orow = O8 + ((size_t)mtoff[64] * 256 + gi) * DM + lane * 16;
          const u32x4 w0 = __builtin_nontemporal_load((const u32x4*)orow), w1 = __builtin_nontemporal_load((const u32x4*)(orow + 1024));
          f[0] = unpk_fp8(w0.x); f[1] = unpk_fp8(w0.y); f[2] = unpk_fp8(w0.z); f[3] = unpk_fp8(w0.w); f[4] = unpk_fp8(w1.x); f[5] = unpk_fp8(w1.y); f[6] = unpk_fp8(w1.z); f[7] = unpk_fp8(w1.w); }
#pragma unroll 4
        for (int k = 0; k < 8; ++k) {
            const int code = __builtin_amdgcn_readlane(mine.row, k); const float wk = __int_as_float(__builtin_amdgcn_readlane(__float_as_int(mine.w), k));
            int r_ = mtoff[(code >> 15) & 63] * 256 + (code & 32767); r_ = r_ >= HROWS ? HROWS - 1 : r_;
            const unsigned char* orow = O8 + (size_t)r_ * DM + lane * 16;
            const u32x4 w0 = __builtin_nontemporal_load((const u32x4*)orow), w1 = __builtin_nontemporal_load((const u32x4*)(orow + 1024));
            f[0] += wk * unpk_fp8(w0.x); f[1] += wk * unpk_fp8(w0.y); f[2] += wk * unpk_fp8(w0.z); f[3] += wk * unpk_fp8(w0.w);
            f[4] += wk * unpk_fp8(w1.x); f[5] += wk * unpk_fp8(w1.y); f[6] += wk * unpk_fp8(w1.z); f[7] += wk * unpk_fp8(w1.w);
        }
        float s = 0.f;
#pragma unroll
        for (int j = 0; j < 8; ++j) { const int c = LN2_C(j);
            const u32x2 xw = __builtin_nontemporal_load((const u32x2*)(X1 + (size_t)g * DM + c));
            f[j] = DN_ALPHA * (f32x4){bf_lo(xw.x), bf_hi(xw.x), bf_lo(xw.y), bf_hi(xw.y)} + *(const f32x4*)(m + 5 * DM + c) * f[j]; s += (f[j][0] + f[j][1]) + (f[j][2] + f[j][3]); }
        const float mu = wave_sum(s) * (1.f / 2048.f); float q = 0.f;
#pragma unroll
        for (int j = 0; j < 8; ++j) { const f32x4 d = f[j] - mu; q += (d[0] * d[0] + d[1] * d[1]) + (d[2] * d[2] + d[3] * d[3]); }
        const float rstd = rsqrtf(wave_sum(q) * (1.f / 2048.f) + 1e-5f);
        const float* mn = mod + ((size_t)3 + (rr < CTXL ? 2 : b)) * 12288;
        float* orow = a.out + ((size_t)b * SEQ + (rr - CTXL)) * DM;
#pragma unroll
        for (int j = 0; j < 8; ++j) { const int c = LN2_C(j);
            const f32x4 y = (f[j] - mu) * rstd * *(const f32x4*)(g2 + c) + *(const f32x4*)(b2 + c);
            if (l == 0) {
                { u32x2 yw; yw.x = cvtpk(y[0], y[1]); yw.y = cvtpk(y[2], y[3]); *(u32x2*)(xres + (size_t)g * DM + c) = yw; }
                const f32x4 t = y * (1.f + *(const f32x4*)(mn + DM + c)) + *(const f32x4*)(mn + c);
                *(unsigned*)(hb8 + (size_t)g * DM + c) = pk_fp8(t);
            } else *(f32x4*)(orow + c) = y;
        }
    }
}
#undef LN2_C

constexpr int NPH = 21;
__global__ void __launch_bounds__(512, 2) fwd(Args a) {
    extern __shared__ __attribute__((aligned(16))) unsigned char lds[];
    if (threadIdx.x == 0) *(uint4*)lds = make_uint4(0u, 0u, 0u, 0u);
    __syncthreads();
    XcdBarrier bar; bar.bar = (unsigned*)(a.ws + WS_BAR); bar.x = 0; bar.st = nullptr;
    const bool multi = (a.ph_hi - a.ph_lo) > 1;
    if (multi) bar = xcd_barrier_post((unsigned*)(a.ws + WS_BAR), (volatile LAS unsigned*)lds);
    unsigned char* sm = lds + SM0;
    const int lo = a.ph_lo, hi = a.ph_hi;
#ifndef PH_ENABLE
#define PH_ENABLE 0xFFFF
#endif
#define EN(t) (((PH_ENABLE) >> (t)) & 1)
#ifndef REPMASK
#define REPMASK 0
#endif
#define RP(t) (((REPMASK) >> (t)) & 1)
#define IN(k) (lo <= (k) && (k) < hi)
#if defined(__HIP_DEVICE_COMPILE__)
#define ASSUME_GLOBAL(p) __builtin_assume(!__builtin_amdgcn_is_shared((const __attribute__((address_space(0))) void*)(p)) && !__builtin_amdgcn_is_private((const __attribute__((address_space(0))) void*)(p)))
#else
#define ASSUME_GLOBAL(p) ((void)0)
#endif
#define GAS __attribute__((address_space(1)))
#define CAS __attribute__((address_space(4)))
#define GP(f) b.f = (decltype(b.f))(GAS void*)(void*)b.f
#if !defined(__HIP_DEVICE_COMPILE__)
#define LA(b) Args b = a
#else
#define LA(b) Args b; { const CAS Args* kp_ = (const CAS Args*)__builtin_amdgcn_kernarg_segment_ptr(); asm volatile("" : "+s"(kp_)); b = *kp_; \
    GP(x); GP(c); GP(ctx); GP(c_ctx); GP(w_mod); GP(b_mod); GP(w_in); GP(g_q); GP(w_q_b); GP(g_kv); GP(w_kv_b); GP(conv_w); GP(conv_b); GP(a_log); GP(dt_bias); GP(d_skip); GP(g_ssm); GP(g_v); GP(b_v); \
    GP(w_sp); GP(b_sp); GP(w_out); GP(ln1_g); GP(ln1_b); GP(ln2_g); GP(ln2_b); GP(w_router); GP(b_router); GP(w_e_gate); GP(w_e_up); GP(w_e_down); GP(w_sh_gate); GP(w_sh_up); GP(w_sh_down); GP(out); GP(ws); }
#endif
#define SEAM(k) do { if (IN(k) && IN((k) + 1)) xcd_barrier(bar); } while (0)
    if (IN(0)) { if (EN(0)) { LA(b); ph_mod(b, sm); } if (EN(1)) { LA(b); ph_convert_dense(b, 0, sm); } }
    SEAM(0);
#pragma unroll 1
    for (int l = 0; l < 2; ++l) {
        const int pb = 1 + 10 * l;
        if (l == 0) { if (IN(pb + 0) && EN(2)) { LA(b); ph_modulate0(b); } SEAM(pb + 0); }
        if (IN(pb + 1) && EN(3)) { LA(b); ph_inproj(b, l, sm); if (RP(3)) { __syncthreads(); ph_inproj(b, l, sm); } }
        SEAM(pb + 1);
        if (IN(pb + 2) && EN(4)) { LA(b); ph_mixers1(b, l, sm); if (RP(4)) { __syncthreads(); ph_mixers1(b, l, sm); } }
        SEAM(pb + 2);
        if (IN(pb + 3) && EN(5)) { LA(b); ph_attn(b, l, sm); if (RP(5)) { __syncthreads(); ph_attn(b, l, sm); } }
        SEAM(pb + 3);
        if (IN(pb + 4) && EN(6)) { LA(b); ph_ssd_out(b, l, sm); if (RP(6)) { __syncthreads(); ph_ssd_out(b, l, sm); } }
        SEAM(pb + 4);
        if (IN(pb + 5) && EN(7)) { LA(b); ph_outproj(b, l, sm); if (RP(7)) { __syncthreads(); ph_outproj(b, l, sm); } }
        SEAM(pb + 5);
        if (IN(pb + 6) && EN(8)) { LA(b); ph_ln1_router(b, l, sm); }
        SEAM(pb + 6);
        if (IN(pb + 7) && EN(9)) { LA(b); ph_gateup(b, l, sm); if (RP(9)) { __syncthreads(); ph_gateup(b, l, sm); } }
        SEAM(pb + 7);
        if (IN(pb + 8) && EN(10)) { LA(b); ph_down(b, l, sm); if (RP(10)) { __syncthreads(); ph_down(b, l, sm); } }
        SEAM(pb + 8);
        if (IN(pb + 9) && EN(11)) { LA(b); ph_ln2(b, l, sm); if (RP(11)) { __syncthreads(); ph_ln2(b, l, sm); } }
        SEAM(pb + 9);
    }
#undef IN
#undef SEAM
}


#ifdef DBG_NANCHK
__global__ void chk_kernel(const void* p, size_t n, int is_bf16, unsigned* flags, int idx) {
    bool bad = false;
    for (size_t i = (size_t)blockIdx.x * blockDim.x + threadIdx.x; i < n; i += (size_t)gridDim.x * blockDim.x) {
        float v = is_bf16 ? __uint_as_float(((unsigned)((const unsigned short*)p)[i]) << 16) : ((const float*)p)[i];
        if (!(fabsf(v) < 1e30f)) bad = true;
    }
    if (bad) atomicOr(&flags[idx], 1u);
}
__global__ void chk_rows(const unsigned short* p, int rows, int cols, unsigned* res) {
    for (int r = blockIdx.x; r < rows; r += gridDim.x) { bool bad = false;
        for (int c = threadIdx.x; c < cols; c += blockDim.x) { const float v = __uint_as_float(((unsigned)p[(size_t)r * cols + c]) << 16); if (!(fabsf(v) < 1e30f)) bad = true; }
        if (__syncthreads_or(bad ? 1 : 0)) { if (threadIdx.x == 0) { atomicMin(&res[0], (unsigned)r); atomicAdd(&res[1], 1u); } } }
}
__global__ void chk_final2(float* out, size_t n, const unsigned* res, const int* gcnt) {
    int tot = 0; for (int e = 0; e < 64; ++e) tot += (gcnt[e] + 255) >> 8;
    float V = DBG_WHICH == 0 ? (float)res[0] : DBG_WHICH == 1 ? (float)res[1] : (float)tot * 256.f;
    for (size_t i = (size_t)blockIdx.x * blockDim.x + threadIdx.x; i < n; i += (size_t)gridDim.x * blockDim.x) out[i] = (i == 0) ? V : 0.f;
}
__global__ void chk_final(float* out, size_t n, const unsigned* flags) {
    int first = 90;
    for (int i = 89; i >= 0; --i) if (flags[i]) first = i;
    const float V = 100.f * (1.f + (float)first);
    for (size_t i = (size_t)blockIdx.x * blockDim.x + threadIdx.x; i < n; i += (size_t)gridDim.x * blockDim.x) out[i] = (i == 0) ? V : 0.f;
}
#endif
extern "C" void kernel_launch(void* const* d_in, const int* in_sizes, int n_in, void* d_out, int out_size, void* d_ws, size_t ws_size, hipStream_t stream) {
    static int grid = 0;
    if (grid == 0) {
        if (n_in != 34 || out_size != NB * SEQ * DM || ws_size < WS_END) { fprintf(stderr, "kernel_launch: unexpected shapes (n_in %d, out %d, ws %zu, need %zu)\n", n_in, out_size, ws_size, (size_t)WS_END); grid = -1; return; }
        int dev = 0, cus = 0, per_cu = 0;
        if (hipGetDevice(&dev) != hipSuccess || hipDeviceGetAttribute(&cus, hipDeviceAttributeMultiprocessorCount, dev) != hipSuccess) { grid = -1; return; }
        if (hipFuncSetAttribute((const void*)fwd, hipFuncAttributeMaxDynamicSharedMemorySize, LDS_BYTES) != hipSuccess) { fprintf(stderr, "kernel_launch: hipFuncSetAttribute failed\n"); grid = -1; return; }
        if (hipOccupancyMaxActiveBlocksPerMultiprocessor(&per_cu, (const void*)fwd, 512, LDS_BYTES) != hipSuccess || per_cu < 1) fprintf(stderr, "kernel_launch: occupancy query says %d\n", per_cu);
        (void)hipGetLastError();
        grid = cus;
    }
    if (grid < 0) return;
    (void)hipMemsetAsync(d_ws, 0, ZERO_BYTES, stream);
    Args a{};
    const float** pp = (const float**)&a;
    for (int i = 0; i < 34; ++i) pp[i] = (const float*)d_in[i];
    a.out = (float*)d_out; a.ws = (unsigned char*)d_ws;
#if N_LAUNCH_MODE == 1
#ifdef DBG_NANCHK
    unsigned* flags = (unsigned*)((unsigned char*)d_ws + WS_CNT + 4096);
    unsigned char* W = (unsigned char*)d_ws;
#define CHK(off, n, isb) hipLaunchKernelGGL(chk_kernel, dim3(1024), dim3(256), 0, stream, (const void*)(W + (off)), (size_t)(n), isb, flags, p)
#endif
    for (int p = 0; p < NPH; ++p) { a.ph_lo = p; a.ph_hi = p + 1; hipLaunchKernelGGL(fwd, dim3(grid), dim3(512), LDS_BYTES, stream, a);
#ifdef DBG_NANCHK
        const int k = p == 0 ? -1 : (p - 1) % 10, l = p == 0 ? 0 : (p - 1) / 10, o = 20 * l;
#undef CHK
#define CHK(off, n, isb, idx) hipLaunchKernelGGL(chk_kernel, dim3(1024), dim3(256), 0, stream, (const void*)(W + (off)), (size_t)(n), isb, flags, idx)
        if (p == 0) CHK(WS_MOD, 2 * 3 * 12288, 0, 1);
        if (p == 0) { CHK(WS_WGU, (size_t)NE1 * 1024 * 2048, 1, 2); CHK(WS_WDN, (size_t)NE1 * 2048 * 512, 1, 3); }
        if (k == 1) { CHK(WS_PROJ, (size_t)MR * NP, 1, o + 4); CHK(WS_DT, (size_t)MR * 16, 0, o + 5); }
        if (k == 2) { CHK(WS_Q, (size_t)MR * 1536, 1, o + 6); CHK(WS_KV, (size_t)MR * 2048, 1, o + 7); CHK(WS_KRR, (size_t)MR * 64, 1, o + 8); CHK(WS_ST, (size_t)NCH * 16 * 8192, 0, o + 9); CHK(WS_DEC, (size_t)NCH * 16, 0, o + 10); }
        if (k == 3) { CHK(WS_HP, (size_t)NCH * 16 * 8192, 1, o + 11); }
        if (k == 4 && l == 0) { CHK(WS_MIX, (size_t)MR * DM, 1, o + 12); }
        if (k == 5) { CHK(WS_Y, (size_t)MR * DM, 0, o + 13); }
        if (k == 6) { CHK(WS_Y, (size_t)MR * DM, 0, o + 14); CHK(WS_HB, (size_t)MR * DM, 1, o + 15); }
        if (k == 7) { CHK(WS_H, (size_t)150000 * 512, 1, o + 16); }
        if (k == DBG_K && l == 0) { hipMemsetAsync(flags + 100, 0x7f, 4, stream); hipLaunchKernelGGL(chk_rows, dim3(2048), dim3(256), 0, stream, (const unsigned short*)(W + WS_O), DBG_ROWS, 2048, flags + 100);
            hipLaunchKernelGGL(chk_final2, dim3(1024), dim3(256), 0, stream, (float*)d_out, (size_t)out_size, (const unsigned*)(flags + 100), (const int*)(W + WS_CNT)); break; }
        if (k == 9 && l == 0) { CHK(WS_XRES, (size_t)MR * DM, 0, o + 18); CHK(WS_HB, (size_t)MR * DM, 1, o + 19); }
#endif
    }
#if 0
    hipLaunchKernelGGL(chk_final, dim3(1024), dim3(256), 0, stream, (float*)d_out, (size_t)out_size, (const unsigned*)flags);
#endif
#else
    a.ph_lo = 0; a.ph_hi = NPH; hipLaunchKernelGGL(fwd, dim3(grid), dim3(512), LDS_BYTES, stream, a);
#endif
    const hipError_t le = hipPeekAtLastError();
    if (le != hipSuccess) fprintf(stderr, "kernel_launch: launch failed: %s\n", hipGetErrorName(le));
}
```
